# Optimizing an MI355X kernel written in HIP

```python
import math
import jax
import jax.numpy as jnp
from jax import lax
import numpy as np

D_MODEL = 1024
BATCH = 16
SEQ = 2048
DEPTH = 2

F32 = jnp.float32
HEAD_DIM = 64
D_MIX = D_MODEL
GROUP_W = D_MIX // 4
POOL_WINDOWS = (2, 4, 8, 16)
POOL_GROUPS = 4
POOL_CH = GROUP_W // POOL_GROUPS
B_HEADS = GROUP_W // HEAD_DIM
B_KV_HEADS = 2
GRID_W = 64
ROPE_THETA = 10000.0
C_HEADS = GROUP_W // HEAD_DIM
C_QK_DIM = HEAD_DIM // 2
D_HEADS = GROUP_W // HEAD_DIM
D_KV_HEADS = 2
WINDOW = 128
Q_BLOCK = 128
D_FF = 2816
N_EXPERTS = 8
TOP_K = 2
D_FF_EXPERT = 3584
LN_EPS = 1e-5
RMS_EPS = 1e-6
DEEPNORM_ALPHA = (2 * DEPTH) ** 0.25
DEEPNORM_BETA = (8 * DEPTH) ** -0.25
N_DENSE = (DEPTH + 1) // 2
N_MOE = DEPTH // 2
COL_SIZES = (GROUP_W,
             B_HEADS * HEAD_DIM, B_KV_HEADS * HEAD_DIM, B_KV_HEADS * HEAD_DIM,
             C_HEADS * 2 * C_QK_DIM, C_HEADS * 2 * C_QK_DIM, C_HEADS * HEAD_DIM,
             D_HEADS * HEAD_DIM, D_KV_HEADS * HEAD_DIM, D_KV_HEADS * HEAD_DIM)
D_IN = sum(COL_SIZES)

kernel_name = 'hybrid_parallel_mixer_encoder'


def layer_norm(x, g, b):
    xf = x.astype(F32)
    mu = jnp.mean(xf, -1, keepdims=True)
    var = jnp.mean(jnp.square(xf - mu), -1, keepdims=True)
    return ((xf - mu) * lax.rsqrt(var + LN_EPS) * g.astype(F32) + b.astype(F32)).astype(x.dtype)


def rms_norm(x, g):
    xf = x.astype(F32)
    return (xf * lax.rsqrt(jnp.mean(xf * xf, -1, keepdims=True) + RMS_EPS) * g.astype(F32)).astype(x.dtype)


def split_columns(proj):
    parts, start = [], 0
    for w in COL_SIZES:
        parts.append(proj[..., start:start + w])
        start += w
    return parts


def alibi_slopes():
    n = C_HEADS + D_HEADS
    return 2.0 ** (-8.0 * jnp.arange(1, n + 1, dtype=F32) / n)


def axial_rope_tables(s):
    rows = s // GRID_W
    row = jnp.repeat(jnp.arange(rows, dtype=F32), GRID_W)
    col = (jnp.arange(s) % GRID_W).astype(F32)
    axis_dim = HEAD_DIM // 2
    inv_freq = ROPE_THETA ** (-jnp.arange(0, axis_dim, 2, dtype=F32) / axis_dim)
    ang = jnp.stack([row[:, None] * inv_freq, col[:, None] * inv_freq], axis=1)
    return jnp.cos(ang), jnp.sin(ang)


def apply_axial_rope(x, cos, sin):
    b, s, h, dh = x.shape
    xf = x.astype(F32).reshape(b, s, h, 2, dh // 2)
    x1, x2 = xf[..., :dh // 4], xf[..., dh // 4:]
    c, sn = cos[None, :, None], sin[None, :, None]
    out = jnp.concatenate([x1 * c - x2 * sn, x2 * c + x1 * sn], axis=-1)
    return out.reshape(b, s, h, dh).astype(x.dtype)


def multiscale_pool(u, w_pool, scale):
    b, s, _ = u.shape
    ug = u.reshape(b, s, POOL_GROUPS, POOL_CH)
    ugf = ug.astype(F32)
    cs = jnp.pad(jnp.cumsum(ugf, axis=1), ((0, 0), (1, 0), (0, 0), (0, 0)))
    t = jnp.arange(s)
    pooled = []
    for gi, w in enumerate(POOL_WINDOWS):
        lo = jnp.clip(t - w // 2, 0, s)
        hi = jnp.clip(t - w // 2 + w, 0, s)
        cs_g = cs[:, :, gi]
        cnt = (hi - lo).astype(F32)[None, :, None]
        pooled.append((cs_g[:, hi] - cs_g[:, lo]) / cnt)
    d = jnp.stack(pooled, axis=2) - ugf
    y = jnp.einsum('bsgc,gcd->bsgd', d.astype(u.dtype), w_pool)
    return y.reshape(b, s, GROUP_W) * scale


def global_gqa(q, k, v):
    b, s, hq, dh = q.shape
    hkv = k.shape[2]
    g = hq // hkv
    nb = s // Q_BLOCK
    qb = jnp.moveaxis(q.reshape(b, nb, Q_BLOCK, hkv, g, dh), 1, 0)
    scale = dh ** -0.5

    def one_block(qi):
        sc = jnp.einsum('bqkgd,bskd->bkgqs', qi, k, preferred_element_type=F32) * scale
        p = jax.nn.softmax(sc, axis=-1)
        return jnp.einsum('bkgqs,bskd->bqkgd', p.astype(v.dtype), v)

    o = lax.map(one_block, qb)
    return jnp.moveaxis(o, 0, 1).reshape(b, s, hq * dh)


def diff_attention(q, k, v, lam, lam_init, slopes, subln_w):
    b, s, h, _, dq = q.shape
    nb = s // Q_BLOCK
    qb = jnp.moveaxis(q.reshape(b, nb, Q_BLOCK, h, 2, dq), 1, 0)
    pos = jnp.arange(s)
    qpos = pos.reshape(nb, Q_BLOCK)
    scale = dq ** -0.5

    def one_block(args):
        qi, qp = args
        sc = jnp.einsum('bqhcd,bshcd->bhcqs', qi, k, preferred_element_type=F32) * scale
        dist = jnp.abs(qp[:, None] - pos[None, :]).astype(F32)
        sc = sc - slopes[None, :, None, None, None] * dist[None, None, None]
        p = jax.nn.softmax(sc, axis=-1)
        attn = p[:, :, 0] - lam * p[:, :, 1]
        return jnp.einsum('bhqs,bshd->bqhd', attn.astype(v.dtype), v)

    o = lax.map(one_block, (qb, qpos))
    o = jnp.moveaxis(o, 0, 1).reshape(b, s, h, v.shape[-1])
    o = rms_norm(o, subln_w) * (1.0 - lam_init)
    return o.reshape(b, s, h * v.shape[-1])


def windowed_gqa_sink(q, k, v, slopes, sink):
    b, s, hq, dh = q.shape
    hkv = k.shape[2]
    g = hq // hkv
    nb = s // Q_BLOCK
    pad = ((0, 0), (Q_BLOCK, Q_BLOCK), (0, 0), (0, 0))
    kp = jnp.pad(k, pad).reshape(b, nb + 2, Q_BLOCK, hkv, dh)
    vp = jnp.pad(v, pad).reshape(b, nb + 2, Q_BLOCK, hkv, dh)
    kband = jnp.concatenate([kp[:, :-2], kp[:, 1:-1], kp[:, 2:]], axis=2)
    vband = jnp.concatenate([vp[:, :-2], vp[:, 1:-1], vp[:, 2:]], axis=2)
    qb = q.reshape(b, nb, Q_BLOCK, hkv, g, dh)
    sc = jnp.einsum('bnqkgd,bnskd->bnkgqs', qb, kband, preferred_element_type=F32) * (dh ** -0.5)
    qpos = jnp.arange(s).reshape(nb, Q_BLOCK)
    kpos = (jnp.arange(nb)[:, None] - 1) * Q_BLOCK + jnp.arange(3 * Q_BLOCK)[None]
    dist = jnp.abs(qpos[:, :, None] - kpos[:, None, :])
    valid = (dist <= WINDOW) & (kpos[:, None, :] >= 0) & (kpos[:, None, :] < s)
    sl = slopes.reshape(hkv, g)[None, None, :, :, None, None]
    sc = sc - sl * dist.astype(F32)[None, :, None, None]
    sc = jnp.where(valid[None, :, None, None], sc, -jnp.inf)
    snk = sink.astype(F32).reshape(hkv, g)[None, None, :, :, None, None]
    m = jnp.maximum(jnp.max(sc, axis=-1, keepdims=True), snk)
    p = jnp.exp(sc - m)
    p = p / (jnp.sum(p, axis=-1, keepdims=True) + jnp.exp(snk - m))
    o = jnp.einsum('bnkgqs,bnskd->bnqkgd', p.astype(v.dtype), vband)
    return o.reshape(b, s, hq * dh)


def swiglu(x, w_gate, w_up, w_down):
    return (jax.nn.silu(x @ w_gate) * (x @ w_up)) @ w_down


def moe_swiglu(x, w_router, e_gate, e_up, e_down):
    b, s, d = x.shape
    xt = x.reshape(b * s, d)
    logits = jnp.dot(xt, w_router, preferred_element_type=F32)
    top_v, top_i = lax.top_k(logits, TOP_K)
    gates = jax.nn.softmax(top_v, axis=-1)
    combine = jnp.sum(jax.nn.one_hot(top_i, N_EXPERTS, dtype=F32) * gates[..., None], axis=1)
    y = jnp.zeros((b * s, d), F32)
    for e in range(N_EXPERTS):
        h = jax.nn.silu(xt @ e_gate[e]) * (xt @ e_up[e])
        y = y + combine[:, e:e + 1] * (h @ e_down[e]).astype(F32)
    return y.astype(x.dtype).reshape(b, s, d)


def setup_inputs(seed: int = 0) -> dict:
    key = jax.random.key(seed)
    ks = jax.random.split(key, 32)
    L = DEPTH

    def nrm(k, shape, scale):
        return jax.random.normal(k, shape, F32) * scale

    return {
        'x': nrm(ks[0], (BATCH, SEQ, D_MODEL), 1.0),
        'ln_in_g': 1.0 + nrm(ks[1], (D_MODEL,), 0.05),
        'ln_in_b': nrm(ks[2], (D_MODEL,), 0.02),
        'w_in': nrm(ks[3], (L, D_MODEL, D_IN), D_MODEL ** -0.5),
        'w_pool': nrm(ks[4], (L, POOL_GROUPS, POOL_CH, POOL_CH), POOL_CH ** -0.5),
        'pool_scale': 1.0 + nrm(ks[5], (L, GROUP_W), 0.1),
        'qn_w': 1.0 + nrm(ks[6], (L, HEAD_DIM), 0.05),
        'kn_w': 1.0 + nrm(ks[7], (L, HEAD_DIM), 0.05),
        'lam_q1': nrm(ks[8], (L, C_QK_DIM), 0.1),
        'lam_k1': nrm(ks[9], (L, C_QK_DIM), 0.1),
        'lam_q2': nrm(ks[10], (L, C_QK_DIM), 0.1),
        'lam_k2': nrm(ks[11], (L, C_QK_DIM), 0.1),
        'subln_w': 1.0 + nrm(ks[12], (L, HEAD_DIM), 0.05),
        'sink': nrm(ks[13], (L, D_HEADS), 0.5),
        'w_out': nrm(ks[14], (L, D_MIX, D_MODEL), D_MIX ** -0.5 * DEEPNORM_BETA),
        'ln1_g': 1.0 + nrm(ks[15], (L, D_MODEL), 0.05),
        'ln1_b': nrm(ks[16], (L, D_MODEL), 0.02),
        'w_gate': nrm(ks[17], (N_DENSE, D_MODEL, D_FF), D_MODEL ** -0.5),
        'w_up': nrm(ks[18], (N_DENSE, D_MODEL, D_FF), D_MODEL ** -0.5),
        'w_down': nrm(ks[19], (N_DENSE, D_FF, D_MODEL), D_FF ** -0.5 * DEEPNORM_BETA),
        'w_router': nrm(ks[20], (N_MOE, D_MODEL, N_EXPERTS), D_MODEL ** -0.5),
        'e_gate': nrm(ks[21], (N_MOE, N_EXPERTS, D_MODEL, D_FF_EXPERT), D_MODEL ** -0.5),
        'e_up': nrm(ks[22], (N_MOE, N_EXPERTS, D_MODEL, D_FF_EXPERT), D_MODEL ** -0.5),
        'e_down': nrm(ks[23], (N_MOE, N_EXPERTS, D_FF_EXPERT, D_MODEL), D_FF_EXPERT ** -0.5 * DEEPNORM_BETA),
        'ln2_g': 1.0 + nrm(ks[24], (L, D_MODEL), 0.05),
        'ln2_b': nrm(ks[25], (L, D_MODEL), 0.02),
    }


def reference(x, ln_in_g, ln_in_b, w_in, w_pool, pool_scale, qn_w, kn_w, lam_q1, lam_k1,
              lam_q2, lam_k2, subln_w, sink, w_out, ln1_g, ln1_b, w_gate, w_up, w_down,
              w_router, e_gate, e_up, e_down, ln2_g, ln2_b):
    b, s, _ = x.shape
    cos, sin = axial_rope_tables(s)
    slopes = alibi_slopes()
    slopes_c, slopes_d = slopes[0::2], slopes[1::2]
    x = layer_norm(x, ln_in_g, ln_in_b)
    for l in range(DEPTH):
        proj = jnp.einsum('bsd,de->bse', x, w_in[l])
        (u_a, q_b, k_b, v_b, q_c, k_c, v_c, q_d, k_d, v_d) = split_columns(proj)
        y_a = multiscale_pool(u_a, w_pool[l], pool_scale[l])
        qb_ = apply_axial_rope(rms_norm(q_b.reshape(b, s, B_HEADS, HEAD_DIM), qn_w[l]), cos, sin)
        kb_ = apply_axial_rope(rms_norm(k_b.reshape(b, s, B_KV_HEADS, HEAD_DIM), kn_w[l]), cos, sin)
        y_b = global_gqa(qb_, kb_, v_b.reshape(b, s, B_KV_HEADS, HEAD_DIM))
        lam_init = 0.8 - 0.6 * math.exp(-0.3 * l)
        lam = (jnp.exp(jnp.sum((lam_q1[l] * lam_k1[l]).astype(F32)))
               - jnp.exp(jnp.sum((lam_q2[l] * lam_k2[l]).astype(F32))) + lam_init)
        y_c = diff_attention(q_c.reshape(b, s, C_HEADS, 2, C_QK_DIM),
                             k_c.reshape(b, s, C_HEADS, 2, C_QK_DIM),
                             v_c.reshape(b, s, C_HEADS, HEAD_DIM),
                             lam, lam_init, slopes_c, subln_w[l])
        y_d = windowed_gqa_sink(q_d.reshape(b, s, D_HEADS, HEAD_DIM),
                                k_d.reshape(b, s, D_KV_HEADS, HEAD_DIM),
                                v_d.reshape(b, s, D_KV_HEADS, HEAD_DIM),
                                slopes_d, sink[l])
        mix = jnp.concatenate([y_a, y_b, y_c, y_d], axis=-1) @ w_out[l]
        x = layer_norm(DEEPNORM_ALPHA * x + mix, ln1_g[l], ln1_b[l])
        i = l // 2
        if l % 2 == 0:
            f = swiglu(x, w_gate[i], w_up[i], w_down[i])
        else:
            f = moe_swiglu(x, w_router[i], e_gate[i], e_up[i], e_down[i])
        x = layer_norm(DEEPNORM_ALPHA * x + f, ln2_g[l], ln2_b[l])
    return x
```

```cpp
#include <hip/hip_runtime.h>
#include <cstdio>
#include <cstdint>
#include <cmath>

constexpr int BATCH = 16, SEQ = 2048, DM = 1024, M = BATCH * SEQ, DEPTH = 2;
constexpr int D_IN = 2048, D_FF = 2816, N_EXP = 8, D_FFE = 3584;
constexpr float LN_EPS = 1e-5f, RMS_EPS = 1e-6f;
constexpr float ALPHA = 1.41421356237309515f;

namespace nv {
__device__ __forceinline__ float wave_sum(float v) {
#pragma unroll
    for (int o = 1; o < 64; o <<= 1) v += __shfl_xor(v, o);
    return v;
}
__device__ __forceinline__ float wave_max(float v) {
#pragma unroll
    for (int o = 1; o < 64; o <<= 1) v = fmaxf(v, __shfl_xor(v, o));
    return v;
}
__global__ __launch_bounds__(256) void ln_rows(const float* x, const float* f, float a, const float* g, const float* b, float* out) {
    const int row = blockIdx.x * 4 + (threadIdx.x >> 6), lane = threadIdx.x & 63;
    const float* xr = x + (size_t)row * DM; const float* fr = f ? f + (size_t)row * DM : nullptr;
    float v[16]; float s = 0.f;
#pragma unroll
    for (int j = 0; j < 16; ++j) { const int c = lane + 64 * j; float t = a * xr[c]; if (fr) t += fr[c]; v[j] = t; s += t; }
    const float mean = wave_sum(s) * (1.f / DM); float q = 0.f;
#pragma unroll
    for (int j = 0; j < 16; ++j) { const float d = v[j] - mean; q += d * d; }
    const float rstd = 1.0f / sqrtf(wave_sum(q) * (1.f / DM) + LN_EPS);
#pragma unroll
    for (int j = 0; j < 16; ++j) { const int c = lane + 64 * j; out[(size_t)row * DM + c] = (v[j] - mean) * rstd * g[c] + b[c]; }
}

template <int MODE>
__global__ __launch_bounds__(256) void gemm(const float* A, int lda, const int* aidx, const int* oidx, const int* cntp, const float* B, const float* B2, int ldb,
                                            float* C, int ldc, int K, const float* gatev) {
    __shared__ float As[8][132];
    __shared__ float Bs[8][128];
    __shared__ float Bs2[MODE == 1 ? 8 : 1][128];
    const int tm = blockIdx.y * 128, tn = blockIdx.x * 128, t = threadIdx.x;
    const int cnt = cntp ? *cntp : (int)gridDim.y * 128;
    if (tm >= cnt) return;
    const int ty = t >> 4, tx = t & 15;
    float acc[8][8], acc2[MODE == 1 ? 8 : 1][8];
#pragma unroll
    for (int i = 0; i < 8; ++i)
#pragma unroll
        for (int j = 0; j < 8; ++j) { acc[i][j] = 0.f; if constexpr (MODE == 1) acc2[i][j] = 0.f; }
    const int ar = t >> 1, ak = (t & 1) * 4;
    long arow = -1;
    if (tm + ar < cnt) arow = aidx ? (long)aidx[tm + ar] : (long)(tm + ar);
    const int bk = t >> 5, bn = (t & 31) * 4;
    for (int k0 = 0; k0 < K; k0 += 8) {
        float4 av = make_float4(0.f, 0.f, 0.f, 0.f);
        if (arow >= 0) av = *(const float4*)(A + arow * lda + k0 + ak);
        const float4 bv = *(const float4*)(B + (size_t)(k0 + bk) * ldb + tn + bn);
        float4 bv2 = make_float4(0.f, 0.f, 0.f, 0.f);
        if constexpr (MODE == 1) bv2 = *(const float4*)(B2 + (size_t)(k0 + bk) * ldb + tn + bn);
        __syncthreads();
        As[ak + 0][ar] = av.x; As[ak + 1][ar] = av.y; As[ak + 2][ar] = av.z; As[ak + 3][ar] = av.w;
        *(float4*)&Bs[bk][bn] = bv;
        if constexpr (MODE == 1) *(float4*)&Bs2[bk][bn] = bv2;
        __syncthreads();
#pragma unroll
        for (int k = 0; k < 8; ++k) {
            float a[8], b[8];
            *(float4*)&a[0] = *(const float4*)&As[k][ty * 8]; *(float4*)&a[4] = *(const float4*)&As[k][ty * 8 + 4];
            *(float4*)&b[0] = *(const float4*)&Bs[k][tx * 8]; *(float4*)&b[4] = *(const float4*)&Bs[k][tx * 8 + 4];
#pragma unroll
            for (int i = 0; i < 8; ++i)
#pragma unroll
                for (int j = 0; j < 8; ++j) acc[i][j] += a[i] * b[j];
            if constexpr (MODE == 1) {
                float b2[8];
                *(float4*)&b2[0] = *(const float4*)&Bs2[k][tx * 8]; *(float4*)&b2[4] = *(const float4*)&Bs2[k][tx * 8 + 4];
#pragma unroll
                for (int i = 0; i < 8; ++i)
#pragma unroll
                    for (int j = 0; j < 8; ++j) acc2[i][j] += a[i] * b2[j];
            }
        }
    }
#pragma unroll
    for (int i = 0; i < 8; ++i) {
        const int r = tm + ty * 8 + i;
        if (r >= cnt) continue;
        if constexpr (MODE == 2) {
            const int tok = oidx[r]; const float gt = gatev[r];
#pragma unroll
            for (int j = 0; j < 8; ++j) atomicAdd(C + (size_t)tok * ldc + tn + tx * 8 + j, gt * acc[i][j]);
        } else {
            float o[8];
#pragma unroll
            for (int j = 0; j < 8; ++j) {
                if constexpr (MODE == 1) { const float gv = acc[i][j]; o[j] = gv / (1.f + expf(-gv)) * acc2[i][j]; } else o[j] = acc[i][j];
            }
            float* cp = C + (size_t)r * ldc + tn + tx * 8;
            *(float4*)cp = *(float4*)&o[0]; *(float4*)(cp + 4) = *(float4*)&o[4];
        }
    }
}

__global__ __launch_bounds__(256) void pool_d(const float* proj, float* dbuf) {
    const int t = blockIdx.x, c = threadIdx.x, s = t % SEQ, base = t - s;
    const int w = 2 << (c >> 6);
    int lo = s - w / 2; int hi = lo + w; if (lo < 0) lo = 0; if (hi > SEQ) hi = SEQ;
    float sum = 0.f;
    for (int j = lo; j < hi; ++j) sum += proj[(size_t)(base + j) * D_IN + c];
    dbuf[(size_t)t * 256 + c] = sum / (float)(hi - lo) - proj[(size_t)t * D_IN + c];
}
__global__ __launch_bounds__(256) void pool_mm(const float* dbuf, const float* wp, const float* scale, float* cat) {
    __shared__ float ds[256];
    const int t = blockIdx.x, o = threadIdx.x, g = o >> 6, dcol = o & 63;
    ds[o] = dbuf[(size_t)t * 256 + o];
    __syncthreads();
    float acc = 0.f;
    for (int c = 0; c < 64; ++c) acc += ds[g * 64 + c] * wp[(g * 64 + c) * 64 + dcol];
    cat[(size_t)t * DM + o] = acc * scale[o];
}
__global__ __launch_bounds__(256) void qk_norm_rope(float* proj, const float* qn, const float* kn) {
    const int gw = blockIdx.x * 4 + (threadIdx.x >> 6), lane = threadIdx.x & 63;
    const int t = gw / 6, hh = gw % 6;
    float* p = proj + (size_t)t * D_IN + 256 + hh * 64;
    const float* w = hh < 4 ? qn : kn;
    const float x = p[lane];
    const float ss = wave_sum(x * x);
    const float y = x * (1.0f / sqrtf(ss * (1.f / 64.f) + RMS_EPS)) * w[lane];
    const float partner = __shfl_xor(y, 16);
    const int s = t % SEQ; const float pos = (lane < 32) ? (float)(s / 64) : (float)(s % 64);
    const int i = lane & 15;
    const float inv_freq = powf(10000.0f, -(float)(2 * i) / 32.0f);
    const float ang = pos * inv_freq, c = cosf(ang), sn = sinf(ang);
    const bool second = (lane & 16) != 0;
    p[lane] = second ? (y * c + partner * sn) : (y * c - partner * sn);
}

struct AttnP {
    int q_col0, q_hs; int k_col0, k_hs, k_grp; int v_col0, v_hs, v_grp;
    int out_ld, out_col0; int window; int use_sink; float scale; int slope_mode;
};
template <int DQ>
__global__ __launch_bounds__(256) void attn(const float* proj, float* out, const float* sink, AttnP P) {
    __shared__ float qs[4][4][DQ];
    const int wave = threadIdx.x >> 6, lane = threadIdx.x & 63;
    const int vh = blockIdx.y, b = blockIdx.z, q0 = (blockIdx.x * 4 + wave) * 4;
    const size_t rowbase = (size_t)b * SEQ;
    for (int e = lane; e < 4 * DQ; e += 64) { const int qi = e / DQ, d = e % DQ; qs[wave][qi][d] = proj[(rowbase + q0 + qi) * D_IN + P.q_col0 + vh * P.q_hs + d] * P.scale; }
    __syncthreads();
    const float* Kb = proj + rowbase * D_IN + P.k_col0 + (vh / P.k_grp) * P.k_hs;
    const float* Vb = proj + rowbase * D_IN + P.v_col0 + (vh / P.v_grp) * P.v_hs;
    const float slope = P.slope_mode == 0 ? 0.f : (P.slope_mode == 1 ? exp2f(-(float)(2 * (vh >> 1) + 1)) : exp2f(-(float)(2 * vh + 2)));
    int jlo = 0, jhi = 32;
    if (P.window) { int klo = q0 - P.window; if (klo < 0) klo = 0; int khi = q0 + 3 + P.window; if (khi > SEQ - 1) khi = SEQ - 1; jlo = klo / 64; jhi = khi / 64 + 1; }
    const float snk = P.use_sink ? sink[vh] : 0.f;
    float m0 = P.use_sink ? snk : -1e30f, m1 = m0, m2 = m0, m3 = m0;
    float l0 = P.use_sink ? 1.f : 0.f, l1 = l0, l2 = l0, l3 = l0;
    float o0 = 0.f, o1 = 0.f, o2 = 0.f, o3 = 0.f;
    for (int j = jlo; j < jhi; ++j) {
        const int key = j * 64 + lane;
        const float* kr = Kb + (size_t)key * D_IN;
        float a0 = 0.f, a1 = 0.f, a2 = 0.f, a3 = 0.f;
        for (int d = 0; d < DQ; d += 4) {
            const float4 kv = *(const float4*)(kr + d);
            a0 += kv.x * qs[wave][0][d] + kv.y * qs[wave][0][d + 1] + kv.z * qs[wave][0][d + 2] + kv.w * qs[wave][0][d + 3];
            a1 += kv.x * qs[wave][1][d] + kv.y * qs[wave][1][d + 1] + kv.z * qs[wave][1][d + 2] + kv.w * qs[wave][1][d + 3];
            a2 += kv.x * qs[wave][2][d] + kv.y * qs[wave][2][d + 1] + kv.z * qs[wave][2][d + 2] + kv.w * qs[wave][2][d + 3];
            a3 += kv.x * qs[wave][3][d] + kv.y * qs[wave][3][d + 1] + kv.z * qs[wave][3][d + 2] + kv.w * qs[wave][3][d + 3];
        }
        float p0, p1, p2, p3;
#define NV_ONE(QI, A, MM, LL, OO, PP) { int dist = (q0 + QI) - key; if (dist < 0) dist = -dist; const bool valid = (P.window == 0) || (dist <= P.window); \
            const float sv = valid ? (A - slope * (float)dist) : -INFINITY; const float mnew = fmaxf(MM, wave_max(sv)); const float corr = expf(MM - mnew); \
            PP = valid ? expf(sv - mnew) : 0.f; LL = LL * corr + wave_sum(PP); OO *= corr; MM = mnew; }
        NV_ONE(0, a0, m0, l0, o0, p0) NV_ONE(1, a1, m1, l1, o1, p1) NV_ONE(2, a2, m2, l2, o2, p2) NV_ONE(3, a3, m3, l3, o3, p3)
#undef NV_ONE
        for (int src = 0; src < 64; ++src) {
            const float v = Vb[(size_t)(j * 64 + src) * D_IN + lane];
            o0 += __shfl(p0, src) * v; o1 += __shfl(p1, src) * v; o2 += __shfl(p2, src) * v; o3 += __shfl(p3, src) * v;
        }
    }
    float* op = out + (rowbase + q0) * P.out_ld + P.out_col0 + vh * 64 + lane;
    op[0] = o0 / l0; op[(size_t)P.out_ld] = o1 / l1; op[(size_t)2 * P.out_ld] = o2 / l2; op[(size_t)3 * P.out_ld] = o3 / l3;
}
__global__ __launch_bounds__(256) void diff_combine(const float* T, float* cat, const float* lq1, const float* lk1, const float* lq2, const float* lk2, const float* subln, float lam_init) {
    const int gw = blockIdx.x * 4 + (threadIdx.x >> 6), lane = threadIdx.x & 63;
    const int t = gw >> 2, h = gw & 3;
    float a = lane < 32 ? lq1[lane] * lk1[lane] : 0.f, c = lane < 32 ? lq2[lane] * lk2[lane] : 0.f;
    const float lam = expf(wave_sum(a)) - expf(wave_sum(c)) + lam_init;
    const float o = T[(size_t)t * 512 + (h * 2) * 64 + lane] - lam * T[(size_t)t * 512 + (h * 2 + 1) * 64 + lane];
    const float ss = wave_sum(o * o);
    cat[(size_t)t * DM + 512 + h * 64 + lane] = o * (1.0f / sqrtf(ss * (1.f / 64.f) + RMS_EPS)) * subln[lane] * (1.0f - lam_init);
}
__global__ __launch_bounds__(256) void moe_route(const float* x, const float* wr, int* cnt, int* list_tok, float* list_gate) {
    const int t = blockIdx.x * 4 + (threadIdx.x >> 6), lane = threadIdx.x & 63;
    float acc[8];
#pragma unroll
    for (int e = 0; e < 8; ++e) acc[e] = 0.f;
    for (int j = 0; j < 16; ++j) { const int c = lane + 64 * j; const float xv = x[(size_t)t * DM + c];
#pragma unroll
        for (int e = 0; e < 8; ++e) acc[e] += xv * wr[c * 8 + e]; }
#pragma unroll
    for (int e = 0; e < 8; ++e) acc[e] = wave_sum(acc[e]);
    int i1 = 0; float v1 = acc[0];
#pragma unroll
    for (int e = 1; e < 8; ++e) if (acc[e] > v1) { v1 = acc[e]; i1 = e; }
    int i2 = -1; float v2 = -INFINITY;
#pragma unroll
    for (int e = 0; e < 8; ++e) if (e != i1 && acc[e] > v2) { v2 = acc[e]; i2 = e; }
    const float ex = expf(v2 - v1), g1 = 1.f / (1.f + ex), g2 = ex / (1.f + ex);
    if (lane == 0) {
        int p1 = atomicAdd(cnt + i1, 1); list_tok[i1 * M + p1] = t; list_gate[i1 * M + p1] = g1;
        int p2 = atomicAdd(cnt + i2, 1); list_tok[i2 * M + p2] = t; list_gate[i2 * M + p2] = g2;
    }
}
}

constexpr size_t MiB = 1u << 20;
extern "C" void kernel_launch(void* const* d_in, const int* in_sizes, int n_in, void* d_out, int out_size, void* d_ws, size_t ws_size, hipStream_t stream) {
    const float* x_in = (const float*)d_in[0];
    const float* ln_in_g = (const float*)d_in[1]; const float* ln_in_b = (const float*)d_in[2];
    const float* w_in = (const float*)d_in[3]; const float* w_pool = (const float*)d_in[4]; const float* pool_scale = (const float*)d_in[5];
    const float* qn_w = (const float*)d_in[6]; const float* kn_w = (const float*)d_in[7];
    const float* lam_q1 = (const float*)d_in[8]; const float* lam_k1 = (const float*)d_in[9]; const float* lam_q2 = (const float*)d_in[10]; const float* lam_k2 = (const float*)d_in[11];
    const float* subln_w = (const float*)d_in[12]; const float* sink = (const float*)d_in[13]; const float* w_out = (const float*)d_in[14];
    const float* ln1_g = (const float*)d_in[15]; const float* ln1_b = (const float*)d_in[16];
    const float* w_gate = (const float*)d_in[17]; const float* w_up = (const float*)d_in[18]; const float* w_down = (const float*)d_in[19];
    const float* w_router = (const float*)d_in[20]; const float* e_gate = (const float*)d_in[21]; const float* e_up = (const float*)d_in[22]; const float* e_down = (const float*)d_in[23];
    const float* ln2_g = (const float*)d_in[24]; const float* ln2_b = (const float*)d_in[25];
    float* X = (float*)d_out;
    unsigned char* ws = (unsigned char*)d_ws;
    float* PROJ = (float*)(ws);
    float* CAT = (float*)(ws + 256 * MiB);
    float* TB = (float*)(ws + 384 * MiB);
    float* MIX = (float*)(ws);
    float* Hb = (float*)(ws + 128 * MiB);
    int* CNT = (int*)(ws + 448 * MiB);
    int* LTOK = (int*)(ws + 449 * MiB);
    float* LGATE = (float*)(ws + 450 * MiB);
    (void)in_sizes; (void)n_in; (void)out_size; (void)ws_size;

    nv::ln_rows<<<M / 4, 256, 0, stream>>>(x_in, nullptr, 1.0f, ln_in_g, ln_in_b, X);
    for (int l = 0; l < DEPTH; ++l) {
        nv::gemm<0><<<dim3(D_IN / 128, M / 128), 256, 0, stream>>>(X, DM, nullptr, nullptr, nullptr, w_in + (size_t)l * DM * D_IN, nullptr, D_IN, PROJ, D_IN, DM, nullptr);
        nv::pool_d<<<M, 256, 0, stream>>>(PROJ, TB);
        nv::pool_mm<<<M, 256, 0, stream>>>(TB, w_pool + (size_t)l * 4 * 64 * 64, pool_scale + l * 256, CAT);
        nv::qk_norm_rope<<<M * 6 / 4, 256, 0, stream>>>(PROJ, qn_w + l * 64, kn_w + l * 64);
        {
            nv::AttnP P{}; P.q_col0 = 256; P.q_hs = 64; P.k_col0 = 512; P.k_hs = 64; P.k_grp = 2; P.v_col0 = 640; P.v_hs = 64; P.v_grp = 2;
            P.out_ld = DM; P.out_col0 = 256; P.window = 0; P.use_sink = 0; P.scale = 0.125f; P.slope_mode = 0;
            nv::attn<64><<<dim3(SEQ / 16, 4, BATCH), 256, 0, stream>>>(PROJ, CAT, nullptr, P);
        }
        {
            nv::AttnP P{}; P.q_col0 = 768; P.q_hs = 32; P.k_col0 = 1024; P.k_hs = 32; P.k_grp = 1; P.v_col0 = 1280; P.v_hs = 64; P.v_grp = 2;
            P.out_ld = 512; P.out_col0 = 0; P.window = 0; P.use_sink = 0; P.scale = 0.17677669529663687f;
            P.slope_mode = 1;
            nv::attn<32><<<dim3(SEQ / 16, 8, BATCH), 256, 0, stream>>>(PROJ, TB, nullptr, P);
            const float lam_init = 0.8f - 0.6f * expf(-0.3f * (float)l);
            nv::diff_combine<<<M, 256, 0, stream>>>(TB, CAT, lam_q1 + l * 32, lam_k1 + l * 32, lam_q2 + l * 32, lam_k2 + l * 32, subln_w + l * 64, lam_init);
        }
        {
            nv::AttnP P{}; P.q_col0 = 1536; P.q_hs = 64; P.k_col0 = 1792; P.k_hs = 64; P.k_grp = 2; P.v_col0 = 1920; P.v_hs = 64; P.v_grp = 2;
            P.out_ld = DM; P.out_col0 = 768; P.window = 128; P.use_sink = 1; P.scale = 0.125f;
            P.slope_mode = 2;
            nv::attn<64><<<dim3(SEQ / 16, 4, BATCH), 256, 0, stream>>>(PROJ, CAT, sink + l * 4, P);
        }
        nv::gemm<0><<<dim3(DM / 128, M / 128), 256, 0, stream>>>(CAT, DM, nullptr, nullptr, nullptr, w_out + (size_t)l * DM * DM, nullptr, DM, MIX, DM, DM, nullptr);
        nv::ln_rows<<<M / 4, 256, 0, stream>>>(X, MIX, ALPHA, ln1_g + l * DM, ln1_b + l * DM, X);
        float* F = MIX;
        if (l % 2 == 0) {
            const int i = l / 2; const int RC = 8192;
            for (int r0 = 0; r0 < M; r0 += RC) {
                nv::gemm<1><<<dim3(D_FF / 128, RC / 128), 256, 0, stream>>>(X + (size_t)r0 * DM, DM, nullptr, nullptr, nullptr, w_gate + (size_t)i * DM * D_FF, w_up + (size_t)i * DM * D_FF, D_FF, Hb, D_FF, DM, nullptr);
                nv::gemm<0><<<dim3(DM / 128, RC / 128), 256, 0, stream>>>(Hb, D_FF, nullptr, nullptr, nullptr, w_down + (size_t)i * D_FF * DM, nullptr, DM, F + (size_t)r0 * DM, DM, D_FF, nullptr);
            }
        } else {
            const int i = l / 2; const int FC = 896;
            (void)hipMemsetAsync(CNT, 0, 64, stream);
            (void)hipMemsetAsync(F, 0, (size_t)M * DM * 4, stream);
            nv::moe_route<<<M / 4, 256, 0, stream>>>(X, w_router + (size_t)i * DM * N_EXP, CNT, LTOK, LGATE);
            for (int e = 0; e < N_EXP; ++e) {
                const float* eg = e_gate + ((size_t)i * N_EXP + e) * DM * D_FFE; const float* eu = e_up + ((size_t)i * N_EXP + e) * DM * D_FFE;
                const float* ed = e_down + ((size_t)i * N_EXP + e) * D_FFE * DM;
                for (int c0 = 0; c0 < D_FFE; c0 += FC) {
                    nv::gemm<1><<<dim3(FC / 128, M / 128), 256, 0, stream>>>(X, DM, LTOK + e * M, nullptr, CNT + e, eg + c0, eu + c0, D_FFE, Hb, FC, DM, nullptr);
                    nv::gemm<2><<<dim3(DM / 128, M / 128), 256, 0, stream>>>(Hb, FC, nullptr, LTOK + e * M, CNT + e, ed + (size_t)c0 * DM, nullptr, DM, F, DM, FC, LGATE + e * M);
                }
            }
        }
        nv::ln_rows<<<M / 4, 256, 0, stream>>>(X, F, ALPHA, ln2_g + l * DM, ln2_b + l * DM, X);
    }
}
```

```cpp
#include <hip/hip_runtime.h>
#include <cstdio>
#include <cstdint>
#include <cmath>

constexpr int BATCH = 16, SEQ = 2048, DM = 1024, M = BATCH * SEQ, DEPTH = 2;
constexpr int D_IN = 2048, D_FF = 2816, N_EXP = 8, D_FFE = 3584;
constexpr float LN_EPS = 1e-5f, RMS_EPS = 1e-6f;
constexpr float ALPHA = 1.41421356237309515f;
constexpr float LOG2E = 1.4426950408889634f;
constexpr int NWAVES = 8;

#define GAS __attribute__((address_space(1)))
#define LAS __attribute__((address_space(3)))
typedef unsigned short bf16_t;
typedef short bf16x8 __attribute__((ext_vector_type(8)));
typedef float f32x4 __attribute__((ext_vector_type(4)));
typedef float f32x2 __attribute__((ext_vector_type(2)));
typedef float f32x16 __attribute__((ext_vector_type(16)));
typedef unsigned u32x4 __attribute__((ext_vector_type(4)));
typedef unsigned u32x2 __attribute__((ext_vector_type(2)));
typedef short s16x4 __attribute__((ext_vector_type(4)));
typedef __bf16 bf16x2_t __attribute__((ext_vector_type(2)));
typedef GAS unsigned gu32;

__device__ __forceinline__ unsigned pkbf(float lo, float hi) { f32x2 v = {lo, hi}; bf16x2_t b = __builtin_convertvector(v, bf16x2_t); return __builtin_bit_cast(unsigned, b); }
__device__ __forceinline__ float bf_lo(unsigned w) { return __uint_as_float(w << 16); }
__device__ __forceinline__ float bf_hi(unsigned w) { return __uint_as_float(w & 0xffff0000u); }
__device__ __forceinline__ float wave_sum(float v) {
#pragma unroll
    for (int o = 1; o < 64; o <<= 1) v += __shfl_xor(v, o);
    return v;
}

constexpr size_t MiB = 1u << 20;
constexpr size_t WS_CTL = 0, CTL_ZERO_BYTES = 1 * MiB;
constexpr size_t WS_ROPEC = 1 * MiB, WS_ROPES = 1 * MiB + 256 * 1024;
constexpr size_t WS_LTOK = 2 * MiB;
constexpr size_t WS_TPOS = 3 * MiB, WS_TGATE = 3 * MiB + 512 * 1024;
constexpr size_t WS_WIN = 4 * MiB;
constexpr size_t WS_WOUT = 12 * MiB;
constexpr size_t WS_WGU = 16 * MiB;
constexpr size_t WS_WD = 27 * MiB;
constexpr size_t WS_EGU = 33 * MiB;
constexpr size_t WS_ED = 145 * MiB;
constexpr size_t WS_XN = 201 * MiB;
constexpr size_t WS_R = 265 * MiB;
constexpr size_t WS_PJ = WS_R;
constexpr size_t WS_MIX = WS_R + 128 * MiB;
constexpr size_t WS_H = WS_R;
constexpr size_t WS_HC = WS_R;
constexpr size_t WS_Y = WS_R + 112 * MiB;
constexpr size_t WS_END = WS_Y + 132 * MiB;
static_assert(WS_WD + (size_t)DM * D_FF * 2 <= WS_EGU && WS_ED + (size_t)8 * DM * D_FFE * 2 <= WS_XN, "ws map");
constexpr int CW_TMO = 0, CW_BAR = 4096, CW_CNT = 8192;
constexpr int CHUNK_TILES = 64;

constexpr int RING_BYTES = 131072;
constexpr int MISC_OFF = RING_BYTES;
constexpr int LDS_BYTES = 147456;

#define XB_TMO      128
#define XB_XCNT(j)  (256  + 64 * (j))
#define XB_XSUB(j)  (1280 + 64 * (j))
#define XB_XGEN(j)  (2304 + 64 * (j))
#define XB_TOP      3328
#define XB_TOPGEN   3392
#define XCD_BAR_WORDS 3456
#define XB_SPIN_CAP (1u << 18)
__device__ __forceinline__ unsigned xb_ld(unsigned* p)              { return __hip_atomic_load(p, __ATOMIC_RELAXED, __HIP_MEMORY_SCOPE_AGENT); }
__device__ __forceinline__ unsigned xb_add(unsigned* p, unsigned v) { return __hip_atomic_fetch_add(p, v, __ATOMIC_RELAXED, __HIP_MEMORY_SCOPE_AGENT); }
__device__ __forceinline__ unsigned xb_xcc_id() { return (unsigned)__builtin_amdgcn_s_getreg((3 << 11) | 20) & 0xFu; }
#define XB_SPIN(cond, bar) do { unsigned _sp = 0; while (cond) { __builtin_amdgcn_s_sleep(1); \
    if ((++_sp & 255u) == 0u) { if (xb_ld(&(bar)[XB_TMO])) break; if (_sp > XB_SPIN_CAP) { atomicAdd(&(bar)[XB_TMO], 1u); break; } } } } while (0)
struct XcdBarrier { unsigned* bar; unsigned x; volatile LAS unsigned* st; };
__device__ __forceinline__ XcdBarrier xcd_barrier_post(unsigned* bar, volatile LAS unsigned* st) {
    XcdBarrier b; b.bar = bar; b.x = xb_xcc_id(); b.st = st;
    if (threadIdx.x == 0) (void)xb_add(&bar[XB_XCNT(b.x)], 1u);
    return b;
}
__device__ __forceinline__ void xcd_barrier_complete(unsigned* bar, unsigned x, unsigned& nloc, unsigned& nx) {
    const unsigned G = gridDim.x * gridDim.y * gridDim.z;
    unsigned sum, cnt, mine, sp = 0u;
    for (;;) {
        sum = 0u; cnt = 0u; mine = 0u;
#pragma unroll
        for (unsigned j = 0; j < 16; ++j) { const unsigned c = xb_ld(&bar[XB_XCNT(j)]); sum += c; cnt += (c > 0u) ? 1u : 0u; mine = (j == x) ? c : mine; }
        if (sum == G) break;
        __builtin_amdgcn_s_sleep(1);
        if ((++sp & 255u) == 0u) { if (xb_ld(&bar[XB_TMO])) break; if (sp > XB_SPIN_CAP) { atomicAdd(&bar[XB_TMO], 1u); break; } }
    }
    nloc = mine > 0u ? mine : 1u; nx = cnt > 0u ? cnt : 1u;
}
__device__ __forceinline__ void xcd_barrier(const XcdBarrier& b) {
    asm volatile("s_waitcnt vmcnt(0)" ::: "memory");
    __syncthreads();
    if (threadIdx.x == 0) {
        unsigned* bar = b.bar; asm volatile("" : "+s"(bar));
        __builtin_amdgcn_s_waitcnt(0);
        unsigned nloc = b.st[0], nx = b.st[1];
        unsigned bx = b.x; asm volatile("" : "+s"(bx));
        if (nloc == 0u) { xcd_barrier_complete(bar, bx, nloc, nx); b.st[0] = nloc; b.st[1] = nx; }
        const unsigned old = xb_add(&bar[XB_XSUB(bx)], 1u);
        const unsigned gen = old / nloc;
        if (old + 1u == (gen + 1u) * nloc) {
            __builtin_amdgcn_fence(__ATOMIC_RELEASE, "agent");
            asm volatile("s_waitcnt vmcnt(0)" ::: "memory");
            const unsigned og = xb_add(&bar[XB_TOP], 1u);
            const unsigned tg = og / nx;
            if (og + 1u == (tg + 1u) * nx) xb_add(&bar[XB_TOPGEN], 1u);
            else XB_SPIN(xb_ld(&bar[XB_TOPGEN]) == tg, bar);
            __builtin_amdgcn_fence(__ATOMIC_ACQUIRE, "agent");
            xb_add(&bar[XB_XGEN(bx)], 1u);
            asm volatile("s_waitcnt vmcnt(0)" ::: "memory");
        } else {
            XB_SPIN(xb_ld(&bar[XB_XGEN(bx)]) == gen, bar);
            __builtin_amdgcn_fence(__ATOMIC_ACQUIRE, "agent");
            asm volatile("s_waitcnt vmcnt(0)" ::: "memory");
        }
    }
    __syncthreads();
}

namespace pg8 {
constexpr int BM = 256, BK = 64, HALF = 128, HTB = HALF * BK * 2, STAGE_BYTES = 8 * HTB, NXCD = 8, WGM = 8;
__device__ __forceinline__ int lds_byte(int r, int c) { const int st = (r >> 4) * 2 + (c >> 5), rr = r & 15, cc = c & 31, ob = rr * 64 + cc * 2; return st * 1024 + (ob ^ (((ob >> 9) & 1) << 5)); }
__device__ __forceinline__ void stage_rc(int b, int& R, int& C) { const int st = b / 1024, sb = b % 1024, swz = sb ^ (((sb >> 9) & 1) << 5); R = (st >> 1) * 16 + swz / 64; C = (st & 1) * 32 + (swz % 64) / 2; }
__device__ __forceinline__ int perm32(int rho) { const int n = rho >> 4, i = rho & 15; return 8 * (i >> 2) + 4 * n + (i & 3); }

struct Unit { int pm, pn, e, p0, cnt; };
struct Gemm { const bf16_t* A; const bf16_t* Bt; int K; size_t estride; };

__device__ __forceinline__ bool grid_order(int i, int G, int c, int nM, int nN, int& pm, int& pn) {
    const int nwg = nM * nN; const long L = (long)i * G + c; if (L >= nwg) return false;
    int wgid = (int)L; { const int q = nwg / NXCD, r = nwg % NXCD, xcd = wgid % NXCD, off = wgid / NXCD; wgid = (xcd < r ? xcd * (q + 1) : r * (q + 1) + (xcd - r) * q) + off; }
    const int nig = WGM * nN, gid = wgid / nig, fm = gid * WGM, gsz = (nM - fm) < WGM ? (nM - fm) : WGM;
    pm = fm + ((wgid % nig) % gsz); pn = (wgid % nig) / gsz; return true;
}
struct StaticOrder {
    int nM, nN, G, c;
    __device__ void init(int Mrows, int N, int G_, int c_) { nM = Mrows / BM; nN = N / BM; G = G_; c = c_; }
    __device__ __forceinline__ bool next(int i, Unit& u) const { u.e = 0; u.p0 = 0; u.cnt = 0; return grid_order(i, G, c, nM, nN, u.pm, u.pn); }
    __device__ __forceinline__ int arow(const Unit& u, int r) const { return u.pm * BM + r; }
};

template <class Epi, class Sched, bool ALIGN_EPI, bool GATHER = false>
__device__ __forceinline__ void gemm_phase(LAS unsigned char* lds, const Gemm g, const Sched& S, const Epi& E) {
    int tid = threadIdx.x; asm volatile("" : "+v"(tid));
    const int wid = __builtin_amdgcn_readfirstlane(tid >> 6), lane = tid & 63, wr = wid >> 2, wc = wid & 3, fr = lane & 15, fq = lane >> 4;
    const int K = g.K, nt = K / BK;
    int Rp[2], Cp[2]; unsigned voffA[2], voffB[2];
#pragma unroll
    for (int i = 0; i < 2; ++i) { int R, C; stage_rc(tid * 16 + i * 8192, R, C); Rp[i] = R; Cp[i] = C; const int Rb = Epi::PERM ? ((R & ~31) + perm32(R & 31)) : R;
        voffA[i] = (unsigned)(R * K + C) * 2u; voffB[i] = (unsigned)(Rb * K + C) * 2u; }
    const size_t kstep = (size_t)(BK * 2);
    const size_t hstep = (size_t)HALF * K * 2;
    const size_t tstep = 2 * hstep;
    const unsigned ldsw = (unsigned)wid * 1024u;
    const int aoff = lds_byte(wr * 64 + fr, fq * 8), boff = lds_byte(wc * 32 + fr, fq * 8);
#define PG8_SA(b, h) (((b) * 2 + (h)) * HTB)
#define PG8_SB(b, h) ((4 + (b) * 2 + (h)) * HTB)
#define PG8_STAGE(bufoff, gbase, voff) do { _Pragma("unroll") for (int _i = 0; _i < 2; ++_i) \
        __builtin_amdgcn_global_load_lds((const unsigned*)((const char*)(gbase) + (voff)[_i]), (LAS unsigned*)(lds + (bufoff) + ldsw + _i * 8192), 16, 0, 0); } while (0)
#define PG8_STAGE_A(bufoff, ub, kb, h, V) do { if constexpr (GATHER) { PG8_STAGE(bufoff, Ab + (kb), (V)[h]); } else { PG8_STAGE(bufoff, (ub) + (kb) + (h) * hstep, voffA); } } while (0)
#define PG8_AOFF(dst, u) do { _Pragma("unroll") for (int _h = 0; _h < 2; ++_h) _Pragma("unroll") for (int _i = 0; _i < 2; ++_i) \
        dst[_h][_i] = ((unsigned)S.arow(u, Rp[_i] + _h * HALF) * (unsigned)K + (unsigned)Cp[_i]) * 2u; } while (0)
#define PG8_LDA(dst, b, h) do { _Pragma("unroll") for (int m = 0; m < 4; ++m) _Pragma("unroll") for (int k = 0; k < 2; ++k) dst[m][k] = *(const LAS bf16x8*)(lds + PG8_SA(b, h) + aoff + m * 2048 + k * 1024); } while (0)
#define PG8_LDB(dst, b, h) do { _Pragma("unroll") for (int n = 0; n < 2; ++n) _Pragma("unroll") for (int k = 0; k < 2; ++k) dst[n][k] = *(const LAS bf16x8*)(lds + PG8_SB(b, h) + boff + n * 2048 + k * 1024); } while (0)
#define PG8_MMA(ai, bj, At, Bt) do { __builtin_amdgcn_s_setprio(1); _Pragma("unroll") for (int m = 0; m < 4; ++m) _Pragma("unroll") for (int n = 0; n < 2; ++n) _Pragma("unroll") for (int k = 0; k < 2; ++k) \
        acc[ai][bj][m][n] = __builtin_amdgcn_mfma_f32_16x16x32_bf16(Bt[n][k], At[m][k], acc[ai][bj][m][n], 0, 0, 0); __builtin_amdgcn_s_setprio(0); } while (0)
#define PG8_WAIT_V(n) asm volatile("s_waitcnt vmcnt(" #n ")" ::: "memory")
#define PG8_WAIT_L(n) asm volatile("s_waitcnt lgkmcnt(" #n ")" ::: "memory")
#define PG8_BAR __builtin_amdgcn_s_barrier()
#define PG8_SCHED __builtin_amdgcn_sched_barrier(0)
    Unit cur, nxt; int ui = 0;
    if (!S.next(0, cur)) return;
    f32x4 acc[2][2][4][2];
#pragma unroll
    for (int a = 0; a < 2; ++a)
#pragma unroll
        for (int b = 0; b < 2; ++b)
#pragma unroll
            for (int m = 0; m < 4; ++m)
#pragma unroll
                for (int n = 0; n < 2; ++n) acc[a][b][m][n] = (f32x4){0.f, 0.f, 0.f, 0.f};
    bf16x8 At[4][2], B0[2][2], B1[2][2];
    unsigned vc[2][2], vn[2][2];
    if constexpr (GATHER) { PG8_AOFF(vc, cur); }
    const char* Ab = (const char*)g.A;
    const char* cA = GATHER ? Ab : Ab + (size_t)S.arow(cur, 0) * K * 2;
    const char* cB = (const char*)g.Bt + (size_t)cur.e * g.estride + (size_t)cur.pn * tstep;
    PG8_STAGE(PG8_SB(0, 0), cB, voffB); PG8_STAGE(PG8_SB(0, 1), cB + hstep, voffB); PG8_STAGE_A(PG8_SA(0, 0), cA, 0, 0, vc); PG8_STAGE_A(PG8_SA(0, 1), cA, 0, 1, vc);
    if (wr == 1) PG8_BAR;
    PG8_WAIT_V(2); PG8_BAR;
    PG8_STAGE(PG8_SB(1, 0), cB + kstep, voffB); PG8_STAGE_A(PG8_SA(1, 0), cA, kstep, 0, vc); PG8_STAGE(PG8_SB(1, 1), cB + hstep + kstep, voffB);
    PG8_WAIT_V(6); PG8_BAR;
    for (;;) {
        const bool has_next = S.next(ui + 1, nxt);
        if constexpr (GATHER) {
            if (has_next) { PG8_AOFF(vn, nxt); } else {
#pragma unroll
                for (int h = 0; h < 2; ++h)
#pragma unroll
                    for (int i = 0; i < 2; ++i) vn[h][i] = vc[h][i]; } }
        const char* nA = GATHER ? Ab : (has_next ? Ab + (size_t)S.arow(nxt, 0) * K * 2 : cA);
        const char* nB = has_next ? (const char*)g.Bt + (size_t)nxt.e * g.estride + (size_t)nxt.pn * tstep : cB;
        for (int t = 0; t < nt; t += 2) {
            const bool last = (t == nt - 2);
            const size_t k1 = (size_t)(t + 1) * kstep;
            const size_t k2 = last ? (size_t)0 : (size_t)(t + 2) * kstep, k3 = k2 + kstep;
            const char* a2 = last ? nA : cA;
            const char* b2 = last ? nB : cB + (size_t)(t + 2) * kstep; const char* b3 = b2 + kstep;
            PG8_LDB(B0, 0, 0); PG8_LDB(B1, 0, 1); PG8_SCHED; PG8_LDA(At, 0, 0); PG8_STAGE_A(PG8_SA(1, 1), cA, k1, 1, vc);
            if constexpr (GATHER) { if (last) {
#pragma unroll
                for (int h = 0; h < 2; ++h)
#pragma unroll
                    for (int i = 0; i < 2; ++i) vc[h][i] = vn[h][i]; } }
            PG8_WAIT_V(8); PG8_WAIT_L(0); PG8_BAR; PG8_MMA(0, 0, At, B0); PG8_MMA(0, 1, At, B1); PG8_BAR; PG8_SCHED;
            PG8_LDA(At, 0, 1); PG8_STAGE(PG8_SB(0, 0), b2, voffB); PG8_STAGE(PG8_SB(0, 1), b2 + hstep, voffB); PG8_STAGE_A(PG8_SA(0, 0), a2, k2, 0, vc);
            PG8_WAIT_V(8); PG8_WAIT_L(0); PG8_BAR; PG8_MMA(1, 0, At, B0); PG8_MMA(1, 1, At, B1); PG8_BAR; PG8_SCHED;
            PG8_LDB(B0, 1, 0); PG8_LDB(B1, 1, 1); PG8_SCHED; PG8_LDA(At, 1, 0); PG8_STAGE_A(PG8_SA(0, 1), a2, k2, 1, vc);
            PG8_WAIT_V(8); PG8_WAIT_L(0); PG8_BAR; PG8_MMA(0, 0, At, B0); PG8_MMA(0, 1, At, B1); PG8_BAR; PG8_SCHED;
            PG8_LDA(At, 1, 1); PG8_STAGE(PG8_SB(1, 0), b3, voffB); PG8_STAGE(PG8_SB(1, 1), b3 + hstep, voffB); PG8_STAGE_A(PG8_SA(1, 0), a2, k3, 0, vc);
            PG8_WAIT_V(8); PG8_WAIT_L(0); PG8_BAR; PG8_MMA(1, 0, At, B0); PG8_MMA(1, 1, At, B1); PG8_BAR; PG8_SCHED;
        }
        if constexpr (ALIGN_EPI) { if (wr == 0) PG8_BAR; }
        E(acc, cur, wr, wc, fr, fq);
        if (!has_next) break;
#pragma unroll
        for (int a = 0; a < 2; ++a)
#pragma unroll
            for (int b = 0; b < 2; ++b)
#pragma unroll
                for (int m = 0; m < 4; ++m)
#pragma unroll
                    for (int n = 0; n < 2; ++n) acc[a][b][m][n] = (f32x4){0.f, 0.f, 0.f, 0.f};
        cur = nxt; cA = nA; cB = nB; ++ui;
        if constexpr (ALIGN_EPI) { if (wr == 1) PG8_BAR; }
    }
    PG8_WAIT_V(0);
    if constexpr (!ALIGN_EPI) { if (wr == 0) PG8_BAR; }
    PG8_BAR;
#undef PG8_SA
#undef PG8_SB
#undef PG8_STAGE
#undef PG8_STAGE_A
#undef PG8_AOFF
#undef PG8_LDA
#undef PG8_LDB
#undef PG8_MMA
#undef PG8_WAIT_V
#undef PG8_WAIT_L
#undef PG8_BAR
#undef PG8_SCHED
}

struct EpiProj {
    static constexpr bool PERM = true;
    bf16_t* PJ; const float* qn; const float* kn; const float* ropec; const float* ropes;
    __device__ __forceinline__ void operator()(const f32x4 (&acc)[2][2][4][2], const Unit& u, int wr, int wc, int fr, int fq) const {
        const int row0 = u.pm * BM + wr * 64 + fr, pn = u.pn;
        const bool htype = (pn == 1) || (pn == 2);
        const bool roped = (pn == 1) || (pn == 2 && wc < 2);
        if (!htype) {
            const float sc = (pn == 3) ? 0.17677669529663687f * LOG2E : (pn == 6 ? 0.125f * LOG2E : 1.f);
            const int col0 = pn * BM + wc * 32 + 8 * fq;
#pragma unroll
            for (int ai = 0; ai < 2; ++ai)
#pragma unroll
                for (int m = 0; m < 4; ++m) { bf16_t* rowp = PJ + (size_t)(row0 + ai * HALF + m * 16) * D_IN + col0;
#pragma unroll
                    for (int bj = 0; bj < 2; ++bj) { const f32x4 v0 = acc[ai][bj][m][0] * sc, v1 = acc[ai][bj][m][1] * sc;
                        u32x4 w; w.x = pkbf(v0[0], v0[1]); w.y = pkbf(v0[2], v0[3]); w.z = pkbf(v1[0], v1[1]); w.w = pkbf(v1[2], v1[3]);
                        *(u32x4*)(rowp + bj * HALF) = w; } }
        } else {
            const int colh = pn * BM + wc * 64 + 8 * fq;
            if (!roped) {
#pragma unroll
                for (int ai = 0; ai < 2; ++ai)
#pragma unroll
                    for (int m = 0; m < 4; ++m) { bf16_t* rowp = PJ + (size_t)(row0 + ai * HALF + m * 16) * D_IN + colh;
#pragma unroll
                        for (int bj = 0; bj < 2; ++bj) { const f32x4 v0 = acc[ai][bj][m][0], v1 = acc[ai][bj][m][1];
                            u32x4 w; w.x = pkbf(v0[0], v0[1]); w.y = pkbf(v0[2], v0[3]); w.z = pkbf(v1[0], v1[1]); w.w = pkbf(v1[2], v1[3]);
                            *(u32x4*)(rowp + bj * 32) = w; } }
            } else {
                const float* nw = (pn == 1) ? qn : kn; const float osc = (pn == 1) ? 0.125f * LOG2E : 1.f;
                f32x4 w1[2], w2[2];
#pragma unroll
                for (int bj = 0; bj < 2; ++bj) { w1[bj] = *(const f32x4*)(nw + 32 * bj + 4 * fq); w2[bj] = *(const f32x4*)(nw + 32 * bj + 16 + 4 * fq); }
#pragma unroll
                for (int ai = 0; ai < 2; ++ai)
#pragma unroll
                    for (int m = 0; m < 4; ++m) {
                        const int row = row0 + ai * HALF + m * 16, s = row & (SEQ - 1);
                        float ss = 0.f;
#pragma unroll
                        for (int bj = 0; bj < 2; ++bj)
#pragma unroll
                            for (int n = 0; n < 2; ++n) { const f32x4 x = acc[ai][bj][m][n]; ss += (x[0] * x[0] + x[1] * x[1]) + (x[2] * x[2] + x[3] * x[3]); }
                        ss += __shfl_xor(ss, 16); ss += __shfl_xor(ss, 32);
                        const float rinv = 1.0f / sqrtf(ss * (1.f / 64.f) + RMS_EPS);
                        bf16_t* rowp = PJ + (size_t)row * D_IN + colh;
#pragma unroll
                        for (int bj = 0; bj < 2; ++bj) {
                            const f32x4 c = *(const f32x4*)(ropec + s * 32 + bj * 16 + 4 * fq), sn = *(const f32x4*)(ropes + s * 32 + bj * 16 + 4 * fq);
                            const f32x4 x1 = acc[ai][bj][m][0] * rinv * w1[bj], x2 = acc[ai][bj][m][1] * rinv * w2[bj];
                            const f32x4 o1 = (x1 * c - x2 * sn) * osc, o2 = (x2 * c + x1 * sn) * osc;
                            u32x4 w; w.x = pkbf(o1[0], o1[1]); w.y = pkbf(o1[2], o1[3]); w.z = pkbf(o2[0], o2[1]); w.w = pkbf(o2[2], o2[3]);
                            *(u32x4*)(rowp + bj * 32) = w; }
                    }
            }
        }
    }
};
struct EpiResid {
    static constexpr bool PERM = false;
    float* X;
    __device__ __forceinline__ void operator()(const f32x4 (&acc)[2][2][4][2], const Unit& u, int wr, int wc, int fr, int fq) const {
        const int row0 = u.pm * BM + wr * 64 + fr, col0 = u.pn * BM + wc * 32 + 4 * fq;
#pragma unroll
        for (int ai = 0; ai < 2; ++ai)
#pragma unroll
            for (int m = 0; m < 4; ++m) { float* rowp = X + (size_t)(row0 + ai * HALF + m * 16) * DM + col0;
#pragma unroll
                for (int bj = 0; bj < 2; ++bj)
#pragma unroll
                    for (int n = 0; n < 2; ++n) { f32x4* p = (f32x4*)(rowp + bj * HALF + n * 16); *p = *p * ALPHA + acc[ai][bj][m][n]; } }
    }
};
struct EpiSwiGLU {
    static constexpr bool PERM = true;
    bf16_t* H; int ldh; int rt0;
    __device__ __forceinline__ void operator()(const f32x4 (&acc)[2][2][4][2], const Unit& u, int wr, int wc, int fr, int fq) const {
        const int row0 = (u.pm - rt0) * BM + wr * 64 + fr, col0 = u.pn * HALF + wc * 32 + 8 * fq;
#pragma unroll
        for (int ai = 0; ai < 2; ++ai)
#pragma unroll
            for (int m = 0; m < 4; ++m) {
                float o[8];
#pragma unroll
                for (int n = 0; n < 2; ++n)
#pragma unroll
                    for (int j = 0; j < 4; ++j) { const float gv = acc[ai][0][m][n][j], uv = acc[ai][1][m][n][j];
                        o[4 * n + j] = gv * __builtin_amdgcn_rcpf(1.0f + __builtin_amdgcn_exp2f(-gv * LOG2E)) * uv; }
                u32x4 w; w.x = pkbf(o[0], o[1]); w.y = pkbf(o[2], o[3]); w.z = pkbf(o[4], o[5]); w.w = pkbf(o[6], o[7]);
                *(u32x4*)(H + (size_t)(row0 + ai * HALF + m * 16) * ldh + col0) = w; }
    }
};
struct EpiBf16 {
    static constexpr bool PERM = true;
    bf16_t* O; int ldc;
    __device__ __forceinline__ void operator()(const f32x4 (&acc)[2][2][4][2], const Unit& u, int wr, int wc, int fr, int fq) const {
        const int row0 = u.pm * BM + wr * 64 + fr, col0 = u.pn * BM + wc * 32 + 8 * fq;
#pragma unroll
        for (int ai = 0; ai < 2; ++ai)
#pragma unroll
            for (int m = 0; m < 4; ++m) { bf16_t* rowp = O + (size_t)(row0 + ai * HALF + m * 16) * ldc + col0;
#pragma unroll
                for (int bj = 0; bj < 2; ++bj) { const f32x4 v0 = acc[ai][bj][m][0], v1 = acc[ai][bj][m][1];
                    u32x4 w; w.x = pkbf(v0[0], v0[1]); w.y = pkbf(v0[2], v0[3]); w.z = pkbf(v1[0], v1[1]); w.w = pkbf(v1[2], v1[3]);
                    *(u32x4*)(rowp + bj * HALF) = w; } }
    }
};
}

struct MoeTable { volatile LAS int* T; };
__device__ __forceinline__ int moe_expert_of(const MoeTable& t, int rt) { int e = 0;
#pragma unroll
    for (int j = 1; j < 8; ++j) e += (rt >= t.T[j]) ? 1 : 0;
    return e; }
struct MoeOrder {
    MoeTable tab; int rt_lo, nM, nN, G, c; const int* ltok; bool gather;
    __device__ __forceinline__ bool next(int i, pg8::Unit& u) const {
        int pm, pn; if (!pg8::grid_order(i, G, c, nM, nN, pm, pn)) return false;
        u.pm = rt_lo + pm; u.pn = pn; u.e = moe_expert_of(tab, u.pm); u.p0 = (u.pm - tab.T[u.e]) * 256; u.cnt = tab.T[16 + u.e]; return true; }
    __device__ __forceinline__ int arow(const pg8::Unit& u, int r) const {
        if (gather) { const int p = u.p0 + r; return p < u.cnt ? ltok[u.e * M + p] : 0; }
        return (u.pm - rt_lo) * 256 + r; }
};

namespace att {
constexpr int PJP = D_IN, MXP = DM, SLOTB = 8192;
constexpr int L_K = 0, L_V = 2 * SLOTB, L_WS = 4 * SLOTB, L_OST = L_WS + 8 * 512, OST_W = 32 * 68 * 4, L_BYTES = L_OST + 8 * OST_W;
static_assert(L_BYTES <= RING_BYTES, "attention scratch");
constexpr float THR = 8.0f;
__device__ __forceinline__ int crow(int r, int hi) { return (r & 3) + 8 * (r >> 2) + 4 * hi; }
__device__ __forceinline__ void glds16(const void* gsrc, unsigned lds_dst) { unsigned keep;
    asm volatile("s_mov_b32 %0, m0\n\ts_mov_b32 m0, %2\n\ts_nop 0\n\tglobal_load_lds_dwordx4 %1, off\n\ts_mov_b32 m0, %0" : "=&s"(keep) : "v"(gsrc), "s"(lds_dst) : "memory"); }
#define ATT_MX3(a, b, c) __builtin_fmaxf(__builtin_fmaxf((a), (b)), (c))
__device__ __forceinline__ float rowmax(const f32x16& p0, const f32x16& p1) {
    float a = ATT_MX3(p0[0], p0[1], p1[0]), b = ATT_MX3(p0[2], p0[3], p1[1]); a = ATT_MX3(a, p1[2], p1[3]);
#pragma unroll
    for (int r = 4; r < 16; r += 4) { a = ATT_MX3(a, p0[r], p0[r + 1]); b = ATT_MX3(b, p0[r + 2], p0[r + 3]); a = ATT_MX3(a, p1[r], p1[r + 1]); b = ATT_MX3(b, p1[r + 2], p1[r + 3]); }
    float m = __builtin_fmaxf(a, b); auto rr = __builtin_amdgcn_permlane32_swap(__float_as_uint(m), __float_as_uint(m), false, false);
    return __builtin_fmaxf(__uint_as_float(rr[0]), __uint_as_float(rr[1])); }
template <int D0, int NS>
__device__ __forceinline__ void qkt(f32x16& p0, f32x16& p1, const LAS unsigned char* Kslot, const bf16x8* qr, const f32x16& cinit, int r32, int hi) {
    const LAS unsigned char* kb = Kslot + hi * 1024 + r32 * 16;
#pragma unroll
    for (int s = 0; s < NS; ++s) { const int d0 = D0 + s;
        const bf16x8 b0 = *(const LAS bf16x8*)(kb + d0 * 2048), b1 = *(const LAS bf16x8*)(kb + d0 * 2048 + 512);
        if (s == 0) { p0 = __builtin_amdgcn_mfma_f32_32x32x16_bf16(b0, qr[d0], cinit, 0, 0, 0); p1 = __builtin_amdgcn_mfma_f32_32x32x16_bf16(b1, qr[d0], cinit, 0, 0, 0); }
        else { p0 = __builtin_amdgcn_mfma_f32_32x32x16_bf16(b0, qr[d0], p0, 0, 0, 0); p1 = __builtin_amdgcn_mfma_f32_32x32x16_bf16(b1, qr[d0], p1, 0, 0, 0); } }
}
__device__ __forceinline__ void pv(f32x16* o, int vb, bf16x8 pa0, bf16x8 pa1, bf16x8 pa2, bf16x8 pa3) {
#pragma unroll
    for (int d0 = 0; d0 < 2; ++d0) { s16x4 lo[4], hi[4];
#pragma unroll
        for (int ks = 0; ks < 4; ++ks) {
            asm volatile("ds_read_b64_tr_b16 %0,%1 offset:%c2" : "=&v"(lo[ks]) : "v"(vb), "i"(d0 * 4096 + ks * 1024) : "memory");
            asm volatile("ds_read_b64_tr_b16 %0,%1 offset:%c2" : "=&v"(hi[ks]) : "v"(vb), "i"(d0 * 4096 + ks * 1024 + 512) : "memory"); }
        asm volatile("s_waitcnt lgkmcnt(0)" ::: "memory"); __builtin_amdgcn_sched_barrier(0);
#define ATT_PK(k) (bf16x8){lo[k][0], lo[k][1], lo[k][2], lo[k][3], hi[k][0], hi[k][1], hi[k][2], hi[k][3]}
        o[d0] = __builtin_amdgcn_mfma_f32_32x32x16_bf16(pa0, ATT_PK(0), o[d0], 0, 0, 0);
        o[d0] = __builtin_amdgcn_mfma_f32_32x32x16_bf16(pa1, ATT_PK(1), o[d0], 0, 0, 0);
        o[d0] = __builtin_amdgcn_mfma_f32_32x32x16_bf16(pa2, ATT_PK(2), o[d0], 0, 0, 0);
        o[d0] = __builtin_amdgcn_mfma_f32_32x32x16_bf16(pa3, ATT_PK(3), o[d0], 0, 0, 0);
#undef ATT_PK
    }
}
struct Par { float slope2; float sink2; float lam; float oscale; const float* subln; };
template <int VAR>
__device__ __forceinline__ void unit(int b, int h, int qb, const bf16_t* PJ, bf16_t* MIX, LAS unsigned char* shm, const Par P) {
    constexpr int NC = (VAR == 1) ? 2 : 1;
    constexpr int QC = VAR == 0 ? 256 : (VAR == 1 ? 768 : 1536), KC = VAR == 0 ? 512 : (VAR == 1 ? 1024 : 1792), VC = VAR == 0 ? 640 : (VAR == 1 ? 1280 : 1920), OC = VAR == 0 ? 256 : (VAR == 1 ? 512 : 768);
    int tid = threadIdx.x; asm volatile("" : "+v"(tid));
    const int lane = tid & 63, r32 = lane & 31, hi = lane >> 5; const int wid = __builtin_amdgcn_readfirstlane(tid >> 6);
    const long rowbase = (long)b * SEQ; const int q0 = qb * 256;
    const int kvh = (VAR == 1) ? h : (h >> 1);
    const bf16_t* Qw = PJ + (rowbase + q0 + wid * 32) * PJP + QC + h * 64;
    const bf16_t* Kh = PJ + rowbase * PJP + KC + kvh * 64; const bf16_t* Vh = PJ + rowbase * PJP + VC + kvh * 64;
    const unsigned lds0 = (unsigned)(uintptr_t)shm;
    LAS float* wsf = (LAS float*)(shm + L_WS) + wid * 128;
    const bf16_t* ksrc = Kh + (long)lane * PJP + wid * 8;
    const bf16_t* vsrc = Vh + (long)(16 * (wid & 3) + (lane >> 2)) * PJP + (wid >> 2) * 32 + (lane & 3) * 8;
    const unsigned kdst = lds0 + L_K + wid * 1024, vdst = lds0 + L_V + wid * 1024;
#define ATT_DMA_K(t, so) glds16(ksrc + (long)(t) * 64 * PJP, (unsigned)__builtin_amdgcn_readfirstlane(kdst + (so)))
#define ATT_DMA_V(t, so) glds16(vsrc + (long)(t) * 64 * PJP, (unsigned)__builtin_amdgcn_readfirstlane(vdst + (so)))
    const int vb0 = (int)(lds0 + L_V) + ((lane >> 4) & 1) * 32 + (lane & 3) * 8 + (4 * hi + ((lane & 15) >> 2)) * 64;
    int t_lo = 0, t_hi = 31;
    if (VAR == 2) { t_lo = q0 / 64 - 2; if (t_lo < 0) t_lo = 0; t_hi = q0 / 64 + 5; if (t_hi > 31) t_hi = 31; }
    ATT_DMA_K(t_lo, 0); ATT_DMA_V(t_lo, 0);
    bf16x8 qr[4];
#pragma unroll
    for (int d0 = 0; d0 < 4; ++d0) qr[d0] = *reinterpret_cast<const bf16x8*>(&Qw[(long)r32 * PJP + d0 * 16 + hi * 8]);
    float mh[NC], lsum[NC]; f32x16 o[NC][2];
#pragma unroll
    for (int c = 0; c < NC; ++c) { mh[c] = (VAR == 2) ? P.sink2 : 0.f; lsum[c] = (VAR == 2 && hi == 0) ? 1.f : 0.f; o[c][0] = f32x16{}; o[c][1] = f32x16{}; }
    const int qpos = q0 + wid * 32 + r32, qw = q0 + wid * 32;
    for (int t = t_lo; t <= t_hi; ++t) {
        const int so = ((t - t_lo) & 1) * SLOTB;
        asm volatile("s_waitcnt vmcnt(0) lgkmcnt(0)\n\ts_barrier" ::: "memory");
        if (t < t_hi) { ATT_DMA_K(t + 1, so ^ SLOTB); ATT_DMA_V(t + 1, so ^ SLOTB); }
        bool rel = true;
        if (VAR == 2) rel = (64 * t + 63 >= qw - 128) && (64 * t <= qw + 31 + 128);
        if (rel) {
            const bool first = (VAR != 2) && (t == t_lo);
#pragma unroll
            for (int c = 0; c < NC; ++c) {
                f32x16 cinit;
#pragma unroll
                for (int r = 0; r < 16; ++r) cinit[r] = -mh[c];
                f32x16 p0, p1;
                if (VAR == 1) { if (c == 0) qkt<0, 2>(p0, p1, shm + L_K + so, qr, cinit, r32, hi); else qkt<2, 2>(p0, p1, shm + L_K + so, qr, cinit, r32, hi); }
                else qkt<0, 4>(p0, p1, shm + L_K + so, qr, cinit, r32, hi);
                if (VAR != 0) {
                    const int kvb = 64 * t + 4 * hi;
#pragma unroll
                    for (int r = 0; r < 16; ++r) { const int kv = kvb + (r & 3) + 8 * (r >> 2);
                        int d0 = qpos - kv; d0 = d0 < 0 ? -d0 : d0; int d1 = qpos - kv - 32; d1 = d1 < 0 ? -d1 : d1;
                        p0[r] -= P.slope2 * (float)d0; p1[r] -= P.slope2 * (float)d1;
                        if (VAR == 2) { if (d0 > 128) p0[r] = -INFINITY; if (d1 > 128) p1[r] = -INFINITY; } }
                }
                const float rm = rowmax(p0, p1);
                if (first) {
                    mh[c] = rm;
#pragma unroll
                    for (int r = 0; r < 16; ++r) { p0[r] -= rm; p1[r] -= rm; }
                } else if (__any(rm > THR)) {
                    const float dl = __builtin_fmaxf(rm, 0.f); mh[c] += dl;
#pragma unroll
                    for (int r = 0; r < 16; ++r) { p0[r] -= dl; p1[r] -= dl; }
                    const float f = __builtin_amdgcn_exp2f(-dl); lsum[c] *= f;
                    if (hi == 0) wsf[r32] = f;
                    asm volatile("s_waitcnt lgkmcnt(0)" ::: "memory");
#pragma unroll
                    for (int r = 0; r < 16; ++r) { const float fr_ = wsf[crow(r, hi)]; o[c][0][r] *= fr_; o[c][1][r] *= fr_; }
                }
                float sacc = 0.f;
#pragma unroll
                for (int r = 0; r < 16; ++r) { p0[r] = __builtin_amdgcn_exp2f(p0[r]); p1[r] = __builtin_amdgcn_exp2f(p1[r]); sacc += p0[r] + p1[r]; }
                lsum[c] += sacc;
                u32x4 pw0, pw1, pw2, pw3;
                pw0 = (u32x4){pkbf(p0[0], p0[1]), pkbf(p0[2], p0[3]), pkbf(p0[4], p0[5]), pkbf(p0[6], p0[7])};
                pw1 = (u32x4){pkbf(p0[8], p0[9]), pkbf(p0[10], p0[11]), pkbf(p0[12], p0[13]), pkbf(p0[14], p0[15])};
                pw2 = (u32x4){pkbf(p1[0], p1[1]), pkbf(p1[2], p1[3]), pkbf(p1[4], p1[5]), pkbf(p1[6], p1[7])};
                pw3 = (u32x4){pkbf(p1[8], p1[9]), pkbf(p1[10], p1[11]), pkbf(p1[12], p1[13]), pkbf(p1[14], p1[15])};
                pv(o[c], vb0 + so, __builtin_bit_cast(bf16x8, pw0), __builtin_bit_cast(bf16x8, pw1), __builtin_bit_cast(bf16x8, pw2), __builtin_bit_cast(bf16x8, pw3));
            }
        }
    }
#pragma unroll
    for (int c = 0; c < NC; ++c) { auto rr = __builtin_amdgcn_permlane32_swap(__float_as_uint(lsum[c]), __float_as_uint(lsum[c]), false, false);
        const float lt = __uint_as_float(rr[0]) + __uint_as_float(rr[1]); if (hi == 0) wsf[32 + 32 * c + r32] = lt; }
    asm volatile("s_waitcnt lgkmcnt(0)" ::: "memory");
    LAS float* stg = (LAS float*)(shm + L_OST + wid * OST_W);
#pragma unroll
    for (int r = 0; r < 16; ++r) { const int orow = crow(r, hi);
        const float rl0 = __builtin_amdgcn_rcpf(wsf[32 + orow]);
        float rl1 = 0.f; if (VAR == 1) rl1 = P.lam * __builtin_amdgcn_rcpf(wsf[64 + orow]);
#pragma unroll
        for (int d0 = 0; d0 < 2; ++d0) { float v = o[0][d0][r] * rl0; if (VAR == 1) v -= o[NC - 1][d0][r] * rl1; stg[orow * 68 + d0 * 32 + r32] = v; } }
    asm volatile("s_waitcnt lgkmcnt(0)" ::: "memory");
    {
        const int row = lane >> 1, half = lane & 1;
        f32x4 x[8];
#pragma unroll
        for (int k = 0; k < 8; ++k) x[k] = *(const LAS f32x4*)(stg + row * 68 + half * 32 + 4 * k);
        if (VAR == 1) {
            float ss = 0.f;
#pragma unroll
            for (int k = 0; k < 8; ++k) ss += (x[k][0] * x[k][0] + x[k][1] * x[k][1]) + (x[k][2] * x[k][2] + x[k][3] * x[k][3]);
            ss += __shfl_xor(ss, 1);
            const float rinv = P.oscale / sqrtf(ss * (1.f / 64.f) + RMS_EPS);
#pragma unroll
            for (int k = 0; k < 8; ++k) x[k] = x[k] * rinv * *(const f32x4*)(P.subln + half * 32 + 4 * k);
        }
        bf16_t* op = MIX + (rowbase + q0 + wid * 32 + row) * MXP + OC + h * 64 + half * 32;
#pragma unroll
        for (int k = 0; k < 4; ++k) { u32x4 w; w.x = pkbf(x[2 * k][0], x[2 * k][1]); w.y = pkbf(x[2 * k][2], x[2 * k][3]); w.z = pkbf(x[2 * k + 1][0], x[2 * k + 1][1]); w.w = pkbf(x[2 * k + 1][2], x[2 * k + 1][3]);
            *(u32x4*)(op + 8 * k) = w; }
    }
    asm volatile("s_waitcnt lgkmcnt(0)\n\ts_barrier" ::: "memory");
#undef ATT_DMA_K
#undef ATT_DMA_V
}
}

struct Frame {
    LAS unsigned char* lds; volatile LAS unsigned* MISC; gu32* ctl;
    int tid, lane, wave, vcu, G;
};
struct Args { const float* in[26]; float* out; unsigned char* ws; };
constexpr int PT_OFF = MISC_OFF + 1024;
__device__ __forceinline__ unsigned long long ldp_raw(LAS unsigned char* lds, int i) {
    unsigned z = 0u; asm volatile("" : "+v"(z));
    const unsigned a = z + (unsigned)(uintptr_t)lds + PT_OFF + 8u * (unsigned)i;
    const unsigned long long v = *(volatile LAS unsigned long long*)(uintptr_t)a;
    const unsigned lo = __builtin_amdgcn_readfirstlane((unsigned)v), hi = __builtin_amdgcn_readfirstlane((unsigned)(v >> 32));
    return ((unsigned long long)hi << 32) | lo; }
#define INP(i) ((const float*)ldp_raw(F.lds, (i)))
#define OUTP() ((float*)ldp_raw(F.lds, 26))
#define WSP() ((unsigned char*)ldp_raw(F.lds, 27))

__device__ __forceinline__ int winmap(int n) {
    const int tile = n >> 8, p = n & 255;
    if (tile != 1 && tile != 2) return n;
    const int hh = p >> 6, dim = p & 63, bj = dim >> 5, w = dim & 31;
    int fq, e;
    if (tile == 1 || hh < 2) { const int ehi = w >> 4, i = w & 15; fq = i >> 2; e = (i & 3) + 4 * ehi; }
    else { fq = w >> 3; e = w & 7; }
    return tile * 256 + 128 * bj + 32 * hh + 8 * fq + e;
}
template <int MAP> __device__ __forceinline__ int rowmap(int n) {
    if (MAP == 1) return winmap(n);
    if (MAP == 2) return (n >> 7) * 256 + (n & 127);
    if (MAP == 3) return (n >> 7) * 256 + 128 + (n & 127);
    return n;
}
__device__ __forceinline__ void tr_write(bf16_t* WT, int K, int k0, LAS float* scr, int lane, const int (&drow)[4]) {
    const int c = lane & 7;
#pragma unroll
    for (int j = 0; j < 4; ++j) { const int n = (lane >> 3) + 8 * j; const LAS float* s = scr + (8 * c) * 33 + n;
        u32x4 o; o.x = pkbf(s[0 * 33], s[1 * 33]); o.y = pkbf(s[2 * 33], s[3 * 33]); o.z = pkbf(s[4 * 33], s[5 * 33]); o.w = pkbf(s[6 * 33], s[7 * 33]);
        *(u32x4*)(WT + (size_t)drow[j] * K + k0 + 8 * c) = o; }
    asm volatile("s_waitcnt lgkmcnt(0)" ::: "memory");
}
template <int MAP>
__device__ __forceinline__ void tr_item(const float* W, int K, int N, int ncol0, bf16_t* WT, LAS float* scr, int item, int lane) {
    const int nblk = (N - ncol0) / 32, kb = item / nblk, nb = item % nblk, k0 = 64 * kb, n0 = ncol0 + 32 * nb;
#pragma unroll 8
    for (int i = 0; i < 32; ++i) { const int kk = 2 * i + (lane >> 5); scr[kk * 33 + (lane & 31)] = W[(size_t)(k0 + kk) * N + n0 + (lane & 31)]; }
    asm volatile("s_waitcnt lgkmcnt(0)" ::: "memory");
    int drow[4];
#pragma unroll
    for (int j = 0; j < 4; ++j) drow[j] = rowmap<MAP>(n0 + (lane >> 3) + 8 * j);
    tr_write(WT, K, k0, scr, lane, drow);
}
__device__ __forceinline__ void tr_item_pool(const float* W, const float* wp, const float* scale, bf16_t* WT, LAS float* scr, int item, int lane) {
    const int kb = item / 8, nb = item % 8, k0 = 64 * kb, n0 = 32 * nb, g = n0 >> 6, nn = n0 + (lane & 31);
    const float sc = scale[nn]; const float* wpc = wp + (size_t)g * 4096 + (nn & 63);
    for (int i = 0; i < 32; ++i) { const int kk = 2 * i + (lane >> 5); const float* wrow = W + (size_t)(k0 + kk) * D_IN + 64 * g;
        float a = 0.f;
        for (int c = 0; c < 64; ++c) a += wrow[c] * wpc[c * 64];
        scr[kk * 33 + (lane & 31)] = a * sc; }
    asm volatile("s_waitcnt lgkmcnt(0)" ::: "memory");
    int drow[4];
#pragma unroll
    for (int j = 0; j < 4; ++j) drow[j] = n0 + (lane >> 3) + 8 * j;
    tr_write(WT, DM, k0, scr, lane, drow);
}
__device__ __forceinline__ void ln_core(f32x4 (&v)[4], const f32x4 (&g4)[4], const f32x4 (&b4)[4]) {
    float s = 0.f;
#pragma unroll
    for (int j = 0; j < 4; ++j) s += (v[j][0] + v[j][1]) + (v[j][2] + v[j][3]);
    const float mean = wave_sum(s) * (1.f / DM); float s2 = 0.f;
#pragma unroll
    for (int j = 0; j < 4; ++j) { v[j] = v[j] - mean; s2 += (v[j][0] * v[j][0] + v[j][1] * v[j][1]) + (v[j][2] * v[j][2] + v[j][3] * v[j][3]); }
    const float rstd = 1.f / sqrtf(wave_sum(s2) * (1.f / DM) + LN_EPS);
#pragma unroll
    for (int j = 0; j < 4; ++j) v[j] = v[j] * rstd * g4[j] + b4[j];
}
__device__ __forceinline__ void ln_store(const f32x4 (&v)[4], float* xo, bf16_t* xn, int lane) {
#pragma unroll
    for (int j = 0; j < 4; ++j) {
        if (xo) *((f32x4*)xo + lane + 64 * j) = v[j];
        if (xn) { u32x2 w; w.x = pkbf(v[j][0], v[j][1]); w.y = pkbf(v[j][2], v[j][3]); *((u32x2*)xn + lane + 64 * j) = w; } }
}

__global__ void __launch_bounds__(NWAVES * 64, 2) mega_fwd(Args args) {
    extern __shared__ __attribute__((aligned(16))) unsigned char lds_raw[];
    Frame F;
    F.lds = (LAS unsigned char*)lds_raw;
    F.MISC = (volatile LAS unsigned*)(F.lds + MISC_OFF);
    F.tid = threadIdx.x; F.lane = F.tid & 63; F.wave = __builtin_amdgcn_readfirstlane(F.tid >> 6);
    F.G = gridDim.x; { const int bx = blockIdx.x; F.vcu = (F.G % 8 == 0) ? (bx % 8) * (F.G / 8) + bx / 8 : bx; }
    F.ctl = (gu32*)(args.ws + WS_CTL);
    for (int u = F.tid; u < 256; u += NWAVES * 64) F.MISC[u] = 0u;
    if (F.tid == 0) { volatile LAS unsigned long long* PT = (volatile LAS unsigned long long*)(F.lds + PT_OFF);
#pragma unroll
        for (int i = 0; i < 26; ++i) PT[i] = (unsigned long long)args.in[i];
        PT[26] = (unsigned long long)args.out; PT[27] = (unsigned long long)args.ws; }
    __syncthreads();
    XcdBarrier bar = xcd_barrier_post((unsigned*)(F.ctl + CW_BAR), F.MISC + 8);
#define GRID_BAR() xcd_barrier(bar)
#define PHASE_LOCALS() int tid_ = threadIdx.x; asm volatile("" : "+v"(tid_)); int bid_ = blockIdx.x, G_ = gridDim.x; asm volatile("" : "+s"(bid_), "+s"(G_)); \
    const int lane = tid_ & 63, wave = __builtin_amdgcn_readfirstlane(tid_ >> 6), vcu = (G_ % 8 == 0) ? (bid_ % 8) * (G_ / 8) + bid_ / 8 : bid_, gw = vcu * NWAVES + wave, NGW = G_ * NWAVES; \
    (void)lane; (void)gw; (void)NGW; (void)vcu; (void)wave

        asm volatile("; MARK_P0" ::: "memory");
    {
        PHASE_LOCALS();
        LAS float* scr = (LAS float*)(F.lds + wave * 16384);
        unsigned char* ws = WSP();
        const float* x_in = INP(0); const float* ln_in_g = INP(1); const float* ln_in_b = INP(2); const float* w_in = INP(3); const float* w_pool = INP(4); const float* pool_scale = INP(5);
        const float* w_out = INP(14); const float* w_gate = INP(17); const float* w_up = INP(18); const float* w_down = INP(19); const float* e_gate = INP(21); const float* e_up = INP(22); const float* e_down = INP(23);
        float* X = OUTP(); float* ropec = (float*)(ws + WS_ROPEC); float* ropes = (float*)(ws + WS_ROPES);
        bf16_t* Win_t = (bf16_t*)(ws + WS_WIN); bf16_t* Wout_t = (bf16_t*)(ws + WS_WOUT); bf16_t* Wgu_t = (bf16_t*)(ws + WS_WGU); bf16_t* Wd_t = (bf16_t*)(ws + WS_WD);
        bf16_t* Egu_t = (bf16_t*)(ws + WS_EGU); bf16_t* Ed_t = (bf16_t*)(ws + WS_ED); bf16_t* XN = (bf16_t*)(ws + WS_XN);
        constexpr int I_WIN = 16 * 56, I_POOL = 16 * 8, I_WOUT = 16 * 32, I_G = 16 * 88, I_D = 44 * 32, I_EG = 16 * 112, I_ED = 56 * 32;
        constexpr int N0 = 2 * (I_WIN + I_POOL), N1 = N0 + 2 * I_WOUT, N2 = N1 + 2 * I_G, N3 = N2 + I_D, N4 = N3 + 16 * I_EG, N5 = N4 + 8 * I_ED;
        for (int it = gw; it < N5; it += NGW) {
            int r = it;
            if (r < N0) { const int l = r / (I_WIN + I_POOL); r -= l * (I_WIN + I_POOL);
                if (r < I_WIN) tr_item<1>(w_in + (size_t)l * DM * D_IN, DM, D_IN, 256, Win_t + (size_t)l * D_IN * DM, scr, r, lane);
                else tr_item_pool(w_in + (size_t)l * DM * D_IN, w_pool + (size_t)l * 4 * 4096, pool_scale + l * 256, Win_t + (size_t)l * D_IN * DM, scr, r - I_WIN, lane);
                continue; }
            if (r < N1) { r -= N0; const int l = r / I_WOUT; r -= l * I_WOUT; tr_item<0>(w_out + (size_t)l * DM * DM, DM, DM, 0, Wout_t + (size_t)l * DM * DM, scr, r, lane); continue; }
            if (r < N2) { r -= N1; const int which = r / I_G; r -= which * I_G;
                if (which == 0) tr_item<2>(w_gate, DM, D_FF, 0, Wgu_t, scr, r, lane); else tr_item<3>(w_up, DM, D_FF, 0, Wgu_t, scr, r, lane);
                continue; }
            if (r < N3) { r -= N2; tr_item<0>(w_down, D_FF, DM, 0, Wd_t, scr, r, lane); continue; }
            if (r < N4) { r -= N3; const int idx = r / I_EG; r -= idx * I_EG; const int e = idx >> 1;
                if ((idx & 1) == 0) tr_item<2>(e_gate + (size_t)e * DM * D_FFE, DM, D_FFE, 0, Egu_t + (size_t)e * 2 * D_FFE * DM, scr, r, lane);
                else tr_item<3>(e_up + (size_t)e * DM * D_FFE, DM, D_FFE, 0, Egu_t + (size_t)e * 2 * D_FFE * DM, scr, r, lane);
                continue; }
            { r -= N4; const int e = r / I_ED; r -= e * I_ED; tr_item<0>(e_down + (size_t)e * D_FFE * DM, D_FFE, DM, 0, Ed_t + (size_t)e * DM * D_FFE, scr, r, lane); }
        }
        for (int idx = bid_ * 512 + tid_; idx < SEQ * 32; idx += G_ * 512) { const int s = idx >> 5, ax = (idx >> 4) & 1, i = idx & 15;
            const float pos = ax == 0 ? (float)(s / 64) : (float)(s % 64); const float inv_freq = powf(10000.0f, -(float)(2 * i) / 32.0f); const float ang = pos * inv_freq;
            ropec[idx] = cosf(ang); ropes[idx] = sinf(ang); }
        f32x4 g4[4], b4[4];
#pragma unroll
        for (int j = 0; j < 4; ++j) { g4[j] = *((const f32x4*)ln_in_g + lane + 64 * j); b4[j] = *((const f32x4*)ln_in_b + lane + 64 * j); }
        for (int m = gw; m < M; m += NGW) { f32x4 v[4];
#pragma unroll
            for (int j = 0; j < 4; ++j) v[j] = *((const f32x4*)(x_in + (size_t)m * DM) + lane + 64 * j);
            ln_core(v, g4, b4); ln_store(v, X + (size_t)m * DM, XN + (size_t)m * DM, lane); }
    }
    GRID_BAR();

    for (int l = 0; l < DEPTH; ++l) {
        asm volatile("; MARK_P1" ::: "memory");
        {
            PHASE_LOCALS();
            unsigned char* ws = WSP(); const float* qn_w = INP(6); const float* kn_w = INP(7);
            bf16_t* XN = (bf16_t*)(ws + WS_XN); bf16_t* Win_t = (bf16_t*)(ws + WS_WIN); bf16_t* PJ = (bf16_t*)(ws + WS_PJ); const float* ropec = (const float*)(ws + WS_ROPEC); const float* ropes = (const float*)(ws + WS_ROPES);
            pg8::Gemm g{XN, Win_t + (size_t)l * D_IN * DM, DM, 0};
            pg8::StaticOrder S; S.init(M, D_IN, G_, bid_);
            pg8::EpiProj E{PJ, qn_w + l * 64, kn_w + l * 64, ropec, ropes};
            pg8::gemm_phase<pg8::EpiProj, pg8::StaticOrder, true>(F.lds, g, S, E);
        }
        GRID_BAR();
        asm volatile("; MARK_P2" ::: "memory");
        {
            PHASE_LOCALS();
            unsigned char* ws = WSP(); const float* lam_q1 = INP(8); const float* lam_k1 = INP(9); const float* lam_q2 = INP(10); const float* lam_k2 = INP(11); const float* subln_w = INP(12); const float* sink = INP(13);
            bf16_t* PJ = (bf16_t*)(ws + WS_PJ); bf16_t* MIX = (bf16_t*)(ws + WS_MIX);
            const float lam_init = 0.8f - 0.6f * expf(-0.3f * (float)l);
            float a = lane < 32 ? lam_q1[l * 32 + lane] * lam_k1[l * 32 + lane] : 0.f, c = lane < 32 ? lam_q2[l * 32 + lane] * lam_k2[l * 32 + lane] : 0.f;
            const float lam = expf(wave_sum(a)) - expf(wave_sum(c)) + lam_init;
            for (int i = 0; i < 2; ++i) { const int u = 2 * vcu + i; if (u >= 512) break; const int qb = u & 7, h = (u >> 3) & 3, b = u >> 5;
                att::Par P{exp2f(-(float)(2 * h + 1)) * LOG2E, 0.f, lam, 1.0f - lam_init, subln_w + l * 64};
                att::unit<1>(b, h, qb, PJ, MIX, F.lds, P); }
            for (int i = 0; i < 2; ++i) { const int u = 2 * vcu + i; if (u >= 512) break; const int qb = u & 7, h = (u >> 3) & 3, b = u >> 5;
                att::Par P{0.f, 0.f, 0.f, 0.f, nullptr};
                att::unit<0>(b, h, qb, PJ, MIX, F.lds, P); }
            for (int i = 0; i < 2; ++i) { const int u = 2 * vcu + i; if (u >= 512) break; const int qb = u & 7, h = (u >> 3) & 3, b = u >> 5;
                att::Par P{exp2f(-(float)(2 * h + 2)) * LOG2E, sink[l * 4 + h] * LOG2E, 0.f, 0.f, nullptr};
                att::unit<2>(b, h, qb, PJ, MIX, F.lds, P); }
            for (int ch = vcu; ch < M / 128; ch += G_) {
                for (int it = tid_; it < 128 * 32; it += NWAVES * 64) { const int t = ch * 128 + (it >> 5), cg = it & 31, c0 = cg * 8, s = t & (SEQ - 1), base = t - s;
                    const int w = 2 << (c0 >> 6); int lo = s - w / 2, hi = lo + w; if (lo < 0) lo = 0; if (hi > SEQ) hi = SEQ;
                    float acc[8];
#pragma unroll
                    for (int j = 0; j < 8; ++j) acc[j] = 0.f;
                    for (int j = lo; j < hi; ++j) { const u32x4 zz = *(const u32x4*)(PJ + (size_t)(base + j) * D_IN + c0);
                        acc[0] += bf_lo(zz.x); acc[1] += bf_hi(zz.x); acc[2] += bf_lo(zz.y); acc[3] += bf_hi(zz.y); acc[4] += bf_lo(zz.z); acc[5] += bf_hi(zz.z); acc[6] += bf_lo(zz.w); acc[7] += bf_hi(zz.w); }
                    const float inv = 1.0f / (float)(hi - lo); const u32x4 zs = *(const u32x4*)(PJ + (size_t)t * D_IN + c0);
                    u32x4 o; o.x = pkbf(acc[0] * inv - bf_lo(zs.x), acc[1] * inv - bf_hi(zs.x)); o.y = pkbf(acc[2] * inv - bf_lo(zs.y), acc[3] * inv - bf_hi(zs.y));
                    o.z = pkbf(acc[4] * inv - bf_lo(zs.z), acc[5] * inv - bf_hi(zs.z)); o.w = pkbf(acc[6] * inv - bf_lo(zs.w), acc[7] * inv - bf_hi(zs.w));
                    *(u32x4*)(MIX + (size_t)t * DM + c0) = o; }
            }
        }
        GRID_BAR();
        asm volatile("; MARK_P3" ::: "memory");
        {
            PHASE_LOCALS();
            unsigned char* ws = WSP(); float* X = OUTP(); bf16_t* MIX = (bf16_t*)(ws + WS_MIX); bf16_t* Wout_t = (bf16_t*)(ws + WS_WOUT);
            pg8::Gemm g{MIX, Wout_t + (size_t)l * DM * DM, DM, 0};
            pg8::StaticOrder S; S.init(M, DM, G_, bid_);
            pg8::EpiResid E{X};
            pg8::gemm_phase<pg8::EpiResid, pg8::StaticOrder, true>(F.lds, g, S, E);
        }
        GRID_BAR();
        asm volatile("; MARK_LN1" ::: "memory");
        {
            PHASE_LOCALS();
            unsigned char* ws = WSP(); float* X = OUTP(); const float* ln1_g = INP(15); const float* ln1_b = INP(16); const float* w_router = INP(20);
            bf16_t* XN = (bf16_t*)(ws + WS_XN); int* ltok = (int*)(ws + WS_LTOK); int* tpos = (int*)(ws + WS_TPOS); float* tgate = (float*)(ws + WS_TGATE);
            f32x4 g4[4], b4[4];
#pragma unroll
            for (int j = 0; j < 4; ++j) { g4[j] = *((const f32x4*)(ln1_g + l * DM) + lane + 64 * j); b4[j] = *((const f32x4*)(ln1_b + l * DM) + lane + 64 * j); }
            int me1 = -1, me2 = -1; float mg1 = 0.f, mg2 = 0.f;
            const int rows_per_wave = M / NGW;
            for (int ri = 0; ri < rows_per_wave; ++ri) { const int m = gw * rows_per_wave + ri; f32x4 v[4];
#pragma unroll
                for (int j = 0; j < 4; ++j) v[j] = *((const f32x4*)(X + (size_t)m * DM) + lane + 64 * j);
                ln_core(v, g4, b4); ln_store(v, X + (size_t)m * DM, XN + (size_t)m * DM, lane);
                if (l == 1) {
                    float lg[8];
#pragma unroll
                    for (int e = 0; e < 8; ++e) lg[e] = 0.f;
#pragma unroll
                    for (int j = 0; j < 4; ++j)
#pragma unroll
                        for (int q = 0; q < 4; ++q) { const int c = 4 * lane + 256 * j + q; const f32x4 wa = *(const f32x4*)(w_router + c * 8), wb = *(const f32x4*)(w_router + c * 8 + 4); const float xv = v[j][q];
                            lg[0] += xv * wa[0]; lg[1] += xv * wa[1]; lg[2] += xv * wa[2]; lg[3] += xv * wa[3]; lg[4] += xv * wb[0]; lg[5] += xv * wb[1]; lg[6] += xv * wb[2]; lg[7] += xv * wb[3]; }
#pragma unroll
                    for (int e = 0; e < 8; ++e) lg[e] = wave_sum(lg[e]);
                    int i1 = 0; float v1 = lg[0];
#pragma unroll
                    for (int e = 1; e < 8; ++e) if (lg[e] > v1) { v1 = lg[e]; i1 = e; }
                    int i2 = 0; float v2 = -INFINITY;
#pragma unroll
                    for (int e = 0; e < 8; ++e) if (e != i1 && lg[e] > v2) { v2 = lg[e]; i2 = e; }
                    const float ex = expf(v2 - v1), ga = 1.f / (1.f + ex), gb = ex / (1.f + ex);
                    if (lane == ri) { me1 = i1; me2 = i2; mg1 = ga; mg2 = gb; }
                }
            }
            if (l == 1) {
                const int myrow = gw * rows_per_wave + lane;
#pragma unroll
                for (int e = 0; e < 8; ++e) {
                    const bool has = (lane < rows_per_wave) && (me1 == e || me2 == e);
                    const unsigned long long mask = __ballot(has);
                    const int n = __popcll(mask);
                    if (n) {
                        int base = 0;
                        if (lane == 0) base = (int)__hip_atomic_fetch_add((unsigned*)(ws + WS_CTL) + CW_CNT + 64 * e, (unsigned)n, __ATOMIC_RELAXED, __HIP_MEMORY_SCOPE_AGENT);
                        base = __shfl(base, 0);
                        if (has) { const int p = base + __popcll(mask & ((1ull << lane) - 1ull)); const int k = (me1 == e) ? 0 : 1;
                            ltok[e * M + p] = myrow; tpos[myrow * 2 + k] = (e << 20) | p; tgate[myrow * 2 + k] = k == 0 ? mg1 : mg2; }
                    }
                }
            }
        }
        GRID_BAR();
        if (l == 0) {
        asm volatile("; MARK_DENSE" ::: "memory");
            {
                PHASE_LOCALS();
                unsigned char* ws = WSP(); bf16_t* XN = (bf16_t*)(ws + WS_XN); bf16_t* Wgu_t = (bf16_t*)(ws + WS_WGU); bf16_t* Hd = (bf16_t*)(ws + WS_H);
                pg8::Gemm g{XN, Wgu_t, DM, 0};
                pg8::StaticOrder S; S.init(M, 2 * D_FF, G_, bid_);
                pg8::EpiSwiGLU E{Hd, D_FF, 0};
                pg8::gemm_phase<pg8::EpiSwiGLU, pg8::StaticOrder, true>(F.lds, g, S, E);
            }
            GRID_BAR();
            {
                PHASE_LOCALS();
                unsigned char* ws = WSP(); float* X = OUTP(); bf16_t* Wd_t = (bf16_t*)(ws + WS_WD); bf16_t* Hd = (bf16_t*)(ws + WS_H);
                pg8::Gemm g{Hd, Wd_t, D_FF, 0};
                pg8::StaticOrder S; S.init(M, DM, G_, bid_);
                pg8::EpiResid E{X};
                pg8::gemm_phase<pg8::EpiResid, pg8::StaticOrder, true>(F.lds, g, S, E);
            }
            GRID_BAR();
        asm volatile("; MARK_LN2" ::: "memory");
            {
                PHASE_LOCALS();
                unsigned char* ws = WSP(); float* X = OUTP(); const float* ln2_g = INP(24); const float* ln2_b = INP(25); bf16_t* XN = (bf16_t*)(ws + WS_XN);
                f32x4 g4[4], b4[4];
#pragma unroll
                for (int j = 0; j < 4; ++j) { g4[j] = *((const f32x4*)(ln2_g + l * DM) + lane + 64 * j); b4[j] = *((const f32x4*)(ln2_b + l * DM) + lane + 64 * j); }
                for (int m = gw; m < M; m += NGW) { f32x4 v[4];
#pragma unroll
                    for (int j = 0; j < 4; ++j) v[j] = *((const f32x4*)(X + (size_t)m * DM) + lane + 64 * j);
                    ln_core(v, g4, b4); ln_store(v, X + (size_t)m * DM, XN + (size_t)m * DM, lane); }
            }
            GRID_BAR();
        } else {
        asm volatile("; MARK_MOE" ::: "memory");
            volatile LAS int* T = (volatile LAS int*)(F.MISC + 64);
            if (threadIdx.x == 0) { int acc = 0; unsigned* ctlw = (unsigned*)(WSP() + WS_CTL);
                for (int e = 0; e < 8; ++e) { const int c = (int)__hip_atomic_load(ctlw + CW_CNT + 64 * e, __ATOMIC_RELAXED, __HIP_MEMORY_SCOPE_AGENT); T[e] = acc; T[16 + e] = c; acc += (c + 255) >> 8; }
                T[8] = acc; }
            __syncthreads();
            MoeTable tab{T};
            const int total_tiles = T[8];
            for (int rt_lo = 0; rt_lo < total_tiles; rt_lo += CHUNK_TILES) {
                const int nrt = (total_tiles - rt_lo) < CHUNK_TILES ? (total_tiles - rt_lo) : CHUNK_TILES;
                {
                    PHASE_LOCALS();
                    unsigned char* ws = WSP(); bf16_t* XN = (bf16_t*)(ws + WS_XN); bf16_t* Egu_t = (bf16_t*)(ws + WS_EGU); bf16_t* HC = (bf16_t*)(ws + WS_HC); const int* ltok = (const int*)(ws + WS_LTOK);
                    pg8::Gemm g{XN, Egu_t, DM, (size_t)2 * D_FFE * DM * 2};
                    MoeOrder S{tab, rt_lo, nrt, 2 * D_FFE / 256, G_, bid_, ltok, true};
                    pg8::EpiSwiGLU E{HC, D_FFE, rt_lo};
                    pg8::gemm_phase<pg8::EpiSwiGLU, MoeOrder, true, true>(F.lds, g, S, E);
                }
                GRID_BAR();
                {
                    PHASE_LOCALS();
                    unsigned char* ws = WSP(); bf16_t* Ed_t = (bf16_t*)(ws + WS_ED); bf16_t* HC = (bf16_t*)(ws + WS_HC); bf16_t* Y = (bf16_t*)(ws + WS_Y); const int* ltok = (const int*)(ws + WS_LTOK);
                    pg8::Gemm g{HC, Ed_t, D_FFE, (size_t)DM * D_FFE * 2};
                    MoeOrder S{tab, rt_lo, nrt, DM / 256, G_, bid_, ltok, false};
                    pg8::EpiBf16 E{Y, DM};
                    pg8::gemm_phase<pg8::EpiBf16, MoeOrder, true>(F.lds, g, S, E);
                }
                GRID_BAR();
            }
        asm volatile("; MARK_COMB" ::: "memory");
            {
                PHASE_LOCALS();
                unsigned char* ws = WSP(); float* X = OUTP(); const float* ln2_g = INP(24); const float* ln2_b = INP(25);
                const bf16_t* Y = (const bf16_t*)(ws + WS_Y); const int* tpos = (const int*)(ws + WS_TPOS); const float* tgate = (const float*)(ws + WS_TGATE);
                f32x4 g4[4], b4[4];
#pragma unroll
                for (int j = 0; j < 4; ++j) { g4[j] = *((const f32x4*)(ln2_g + l * DM) + lane + 64 * j); b4[j] = *((const f32x4*)(ln2_b + l * DM) + lane + 64 * j); }
                for (int m = gw; m < M; m += NGW) {
                    const int pa = tpos[m * 2], pb = tpos[m * 2 + 1]; const float ga = tgate[m * 2], gb = tgate[m * 2 + 1];
                    const size_t ra = (size_t)T[pa >> 20] * 256 + (pa & 0xfffff), rb = (size_t)T[pb >> 20] * 256 + (pb & 0xfffff);
                    f32x4 v[4];
#pragma unroll
                    for (int j = 0; j < 4; ++j) { const u32x2 ya = *((const u32x2*)(Y + ra * DM) + lane + 64 * j), yb = *((const u32x2*)(Y + rb * DM) + lane + 64 * j);
                        const f32x4 xv = *((const f32x4*)(X + (size_t)m * DM) + lane + 64 * j);
                        v[j][0] = ALPHA * xv[0] + ga * bf_lo(ya.x) + gb * bf_lo(yb.x); v[j][1] = ALPHA * xv[1] + ga * bf_hi(ya.x) + gb * bf_hi(yb.x);
                        v[j][2] = ALPHA * xv[2] + ga * bf_lo(ya.y) + gb * bf_lo(yb.y); v[j][3] = ALPHA * xv[3] + ga * bf_hi(ya.y) + gb * bf_hi(yb.y); }
                    ln_core(v, g4, b4); ln_store(v, X + (size_t)m * DM, nullptr, lane); }
            }
        }
    }
}

extern "C" void kernel_launch(void* const* d_in, const int* in_sizes, int n_in, void* d_out, int out_size, void* d_ws, size_t ws_size, hipStream_t stream) {
    static int grid = 0;
    if (grid == 0) {
        if (n_in != 26 || in_sizes[0] != M * DM || out_size != M * DM || ws_size < WS_END) { fprintf(stderr, "kernel_launch: unexpected shapes (n_in %d, ws %zu < %zu)\n", n_in, ws_size, (size_t)WS_END); grid = -1; return; }
        int dev = 0, cus = 0, per_cu = 0;
        if (hipGetDevice(&dev) != hipSuccess || hipDeviceGetAttribute(&cus, hipDeviceAttributeMultiprocessorCount, dev) != hipSuccess) { grid = -1; return; }
        if (hipFuncSetAttribute((const void*)mega_fwd, hipFuncAttributeMaxDynamicSharedMemorySize, LDS_BYTES) != hipSuccess) { fprintf(stderr, "kernel_launch: hipFuncSetAttribute failed\n"); grid = -1; return; }
        if (hipOccupancyMaxActiveBlocksPerMultiprocessor(&per_cu, (const void*)mega_fwd, NWAVES * 64, LDS_BYTES) != hipSuccess || per_cu < 1) { fprintf(stderr, "kernel_launch: occupancy query says %d\n", per_cu); }
        (void)hipGetLastError();
        grid = cus;
    }
    if (grid < 0) return;
    if (hipMemsetAsync((char*)d_ws + WS_CTL, 0, CTL_ZERO_BYTES, stream) != hipSuccess) return;
    Args a{};
    for (int i = 0; i < 26; ++i) a.in[i] = (const float*)d_in[i];
    a.out = (float*)d_out; a.ws = (unsigned char*)d_ws;
    hipLaunchKernelGGL(mega_fwd, dim3(grid), dim3(NWAVES * 64), LDS_BYTES, stream, a);
}
```

```cpp
#include <hip/hip_runtime.h>
#include <cstdio>
#include <cstdint>
#include <cmath>

constexpr int BATCH = 16, SEQ = 2048, DM = 1024, M = BATCH * SEQ, DEPTH = 2;
constexpr int D_IN = 2048, D_FF = 2816, N_EXP = 8, D_FFE = 3584;
constexpr float LN_EPS = 1e-5f, RMS_EPS = 1e-6f;
constexpr float ALPHA = 1.41421356237309515f;
constexpr float LOG2E = 1.4426950408889634f;
constexpr float EGU_SCALE = 64.f, ED_SCALE = 128.f;
constexpr int NWAVES = 8;
#ifndef DUP_P0
#define DUP_P0 1
#endif
#ifndef DUP_P1
#define DUP_P1 1
#endif
#ifndef DUP_P2
#define DUP_P2 1
#endif
#ifndef DUP_GU
#define DUP_GU 1
#endif
#ifndef DUP_MOE
#define DUP_MOE 1
#endif

#define GAS __attribute__((address_space(1)))
#define LAS __attribute__((address_space(3)))
typedef unsigned short bf16_t;
typedef short bf16x8 __attribute__((ext_vector_type(8)));
typedef float f32x4 __attribute__((ext_vector_type(4)));
typedef float f32x2 __attribute__((ext_vector_type(2)));
typedef float f32x16 __attribute__((ext_vector_type(16)));
typedef unsigned u32x4 __attribute__((ext_vector_type(4)));
typedef unsigned u32x2 __attribute__((ext_vector_type(2)));
typedef short s16x4 __attribute__((ext_vector_type(4)));
typedef __bf16 bf16x2_t __attribute__((ext_vector_type(2)));
typedef GAS unsigned gu32;

__device__ __forceinline__ unsigned pkbf(float lo, float hi) { f32x2 v = {lo, hi}; bf16x2_t b = __builtin_convertvector(v, bf16x2_t); return __builtin_bit_cast(unsigned, b); }
typedef int i32x4 __attribute__((ext_vector_type(4)));
typedef int i32x8 __attribute__((ext_vector_type(8)));
__device__ __forceinline__ float clamp8(float v) { return __builtin_fminf(__builtin_fmaxf(v, -448.f), 448.f); }
__device__ __forceinline__ unsigned pk4_fp8(float a, float b, float c, float d) { int w = __builtin_amdgcn_cvt_pk_fp8_f32(clamp8(a), clamp8(b), 0, false); w = __builtin_amdgcn_cvt_pk_fp8_f32(clamp8(c), clamp8(d), w, true); return (unsigned)w; }
__device__ __forceinline__ float bf_lo(unsigned w) { return __uint_as_float(w << 16); }
__device__ __forceinline__ float bf_hi(unsigned w) { return __uint_as_float(w & 0xffff0000u); }
__device__ __forceinline__ int lane_id() { int l; asm volatile("v_mbcnt_lo_u32_b32 %0, -1, 0\n\tv_mbcnt_hi_u32_b32 %0, -1, %0" : "=v"(l)); return l; }
template <int K> __device__ __forceinline__ float xor_lane(float v) { return __int_as_float(__builtin_amdgcn_ds_swizzle(__float_as_int(v), (K << 10) | 0x1f)); }
__device__ __forceinline__ float sum_xor32(float v) { auto rr = __builtin_amdgcn_permlane32_swap(__float_as_uint(v), __float_as_uint(v), false, false); return __uint_as_float(rr[0]) + __uint_as_float(rr[1]); }
__device__ __forceinline__ float wave_sum(float v) {
    v += xor_lane<1>(v); v += xor_lane<2>(v); v += xor_lane<4>(v); v += xor_lane<8>(v); v += xor_lane<16>(v);
    return sum_xor32(v);
}

constexpr size_t MiB = 1u << 20;
constexpr size_t WS_CTL = 0, CTL_ZERO_BYTES = 1 * MiB;
constexpr size_t WS_ROPEC = 1 * MiB, WS_ROPES = 1 * MiB + 256 * 1024;
constexpr size_t WS_LTOK = 2 * MiB;
constexpr size_t WS_TPOS = 3 * MiB, WS_TGATE = 3 * MiB + 512 * 1024;
constexpr size_t WS_WIN = 4 * MiB;
constexpr size_t WS_WOUT = 12 * MiB;
constexpr size_t WS_WGU = 16 * MiB;
constexpr size_t WS_WD = 27 * MiB;
constexpr size_t WS_EGU = 33 * MiB;
constexpr size_t WS_ED = 89 * MiB;
constexpr size_t WS_XN = 201 * MiB;
constexpr size_t WS_R = 265 * MiB;
constexpr size_t WS_PJ = WS_R;
constexpr size_t WS_MIX = WS_R + 128 * MiB;
constexpr size_t WS_H = WS_R;
constexpr size_t WS_HC = WS_R;
constexpr size_t WS_Y = WS_R + 112 * MiB;
constexpr size_t WS_END = WS_Y + 132 * MiB;
static_assert(WS_WD + (size_t)DM * D_FF * 2 <= WS_EGU && WS_EGU + (size_t)16 * DM * D_FFE <= WS_ED && WS_ED + (size_t)8 * DM * D_FFE <= WS_XN, "ws map");
constexpr int CW_TMO = 0, CW_BAR = 4096, CW_CNT = 8192, CW_Q = 9216, CW_NRM = 12288;
constexpr int CHUNK_TILES = 128;

constexpr int RING_BYTES = 131072;
constexpr int MISC_OFF = RING_BYTES;
constexpr int LDS_BYTES = 147456;
constexpr int VN_OFF = MISC_OFF + 2048;
static_assert(VN_OFF + 8192 <= LDS_BYTES, "LDS map");

#define XB_TMO      128
#define XB_XCNT(j)  (256  + 64 * (j))
#define XB_XSUB(j)  (1280 + 64 * (j))
#define XB_XGEN(j)  (2304 + 64 * (j))
#define XB_TOP      3328
#define XB_TOPGEN   3392
#define XCD_BAR_WORDS 3456
#define XB_SPIN_CAP (1u << 18)
__device__ __forceinline__ unsigned xb_ld(unsigned* p)              { return __hip_atomic_load(p, __ATOMIC_RELAXED, __HIP_MEMORY_SCOPE_AGENT); }
__device__ __forceinline__ unsigned xb_add(unsigned* p, unsigned v) { return __hip_atomic_fetch_add(p, v, __ATOMIC_RELAXED, __HIP_MEMORY_SCOPE_AGENT); }
__device__ __forceinline__ unsigned xb_xcc_id() { return (unsigned)__builtin_amdgcn_s_getreg((3 << 11) | 20) & 0xFu; }
#define XB_SPIN(cond, bar) do { unsigned _sp = 0; while (cond) { __builtin_amdgcn_s_sleep(1); \
    if ((++_sp & 255u) == 0u) { if (xb_ld(&(bar)[XB_TMO])) break; if (_sp > XB_SPIN_CAP) { atomicAdd(&(bar)[XB_TMO], 1u); break; } } } } while (0)
struct XcdBarrier { unsigned* bar; unsigned x; volatile LAS unsigned* st; };
__device__ __forceinline__ XcdBarrier xcd_barrier_post(unsigned* bar, volatile LAS unsigned* st, bool t0) {
    XcdBarrier b; b.bar = bar; b.x = xb_xcc_id(); b.st = st;
    if (t0) (void)xb_add(&bar[XB_XCNT(b.x)], 1u);
    return b;
}
__device__ __forceinline__ void xcd_barrier_complete(unsigned* bar, unsigned x, unsigned& nloc, unsigned& nx) {
    const unsigned G = gridDim.x * gridDim.y * gridDim.z;
    unsigned sum, cnt, mine, sp = 0u;
    for (;;) {
        sum = 0u; cnt = 0u; mine = 0u;
#pragma unroll
        for (unsigned j = 0; j < 16; ++j) { const unsigned c = xb_ld(&bar[XB_XCNT(j)]); sum += c; cnt += (c > 0u) ? 1u : 0u; mine = (j == x) ? c : mine; }
        if (sum == G) break;
        __builtin_amdgcn_s_sleep(1);
        if ((++sp & 255u) == 0u) { if (xb_ld(&bar[XB_TMO])) break; if (sp > XB_SPIN_CAP) { atomicAdd(&bar[XB_TMO], 1u); break; } }
    }
    nloc = mine > 0u ? mine : 1u; nx = cnt > 0u ? cnt : 1u;
}
__device__ __forceinline__ void xcd_barrier(const XcdBarrier& b, bool t0) {
    asm volatile("s_waitcnt vmcnt(0)" ::: "memory");
    __syncthreads();
    if (t0) {
        unsigned* bar = b.bar; asm volatile("" : "+s"(bar));
        __builtin_amdgcn_s_waitcnt(0);
        unsigned nloc = b.st[0], nx = b.st[1];
        unsigned bx = b.x; asm volatile("" : "+s"(bx));
        if (nloc == 0u) { xcd_barrier_complete(bar, bx, nloc, nx); b.st[0] = nloc; b.st[1] = nx; }
        const unsigned old = xb_add(&bar[XB_XSUB(bx)], 1u);
        const unsigned gen = old / nloc;
        if (old + 1u == (gen + 1u) * nloc) {
            __builtin_amdgcn_fence(__ATOMIC_RELEASE, "agent");
            asm volatile("s_waitcnt vmcnt(0)" ::: "memory");
            const unsigned og = xb_add(&bar[XB_TOP], 1u);
            const unsigned tg = og / nx;
            if (og + 1u == (tg + 1u) * nx) xb_add(&bar[XB_TOPGEN], 1u);
            else XB_SPIN(xb_ld(&bar[XB_TOPGEN]) == tg, bar);
            __builtin_amdgcn_fence(__ATOMIC_ACQUIRE, "agent");
            xb_add(&bar[XB_XGEN(bx)], 1u);
            asm volatile("s_waitcnt vmcnt(0)" ::: "memory");
        } else {
            XB_SPIN(xb_ld(&bar[XB_XGEN(bx)]) == gen, bar);
            __builtin_amdgcn_fence(__ATOMIC_ACQUIRE, "agent");
            asm volatile("s_waitcnt vmcnt(0)" ::: "memory");
        }
    }
    __syncthreads();
}

namespace pg8 {
constexpr int BM = 256, BK = 64, HALF = 128, HTB = HALF * BK * 2, STAGE_BYTES = 8 * HTB, NXCD = 8, WGM = 8;
__device__ __forceinline__ int lds_byte(int r, int c) { const int st = (r >> 4) * 2 + (c >> 5), rr = r & 15, cc = c & 31, ob = rr * 64 + cc * 2; return st * 1024 + (ob ^ (((ob >> 9) & 1) << 5)); }
__device__ __forceinline__ void stage_rc(int b, int& R, int& C) { const int st = b / 1024, sb = b % 1024, swz = sb ^ (((sb >> 9) & 1) << 5); R = (st >> 1) * 16 + swz / 64; C = (st & 1) * 32 + (swz % 64) / 2; }
__device__ __forceinline__ int perm32(int rho) { const int n = rho >> 4, i = rho & 15; return 8 * (i >> 2) + 4 * n + (i & 3); }

struct Unit { int pm, pn, e, p0, cnt; };
struct Gemm { const void* A; const void* Bt; int K; size_t estride; };

__device__ __forceinline__ bool grid_order(int i, int G, int c, int nM, int nN, int& pm, int& pn) {
    const int nwg = nM * nN; const long L = (long)i * G + c; if (L >= nwg) return false;
    int wgid = (int)L; { const int q = nwg / NXCD, r = nwg % NXCD, xcd = wgid % NXCD, off = wgid / NXCD; wgid = (xcd < r ? xcd * (q + 1) : r * (q + 1) + (xcd - r) * q) + off; }
    const int nig = WGM * nN, gid = wgid / nig, fm = gid * WGM, gsz = (nM - fm) < WGM ? (nM - fm) : WGM;
    pm = fm + ((wgid % nig) % gsz); pn = (wgid % nig) / gsz; return true;
}
struct StaticOrder {
    int nM, nN, G, c;
    __device__ void init(int Mrows, int N, int G_, int c_) { nM = Mrows / BM; nN = N / BM; G = G_; c = c_; }
    __device__ __forceinline__ bool next(int i, Unit& u) const { u.e = 0; u.p0 = 0; u.cnt = 0; return grid_order(i, G, c, nM, nN, u.pm, u.pn); }
    __device__ __forceinline__ int arow(const Unit& u, int r) const { return u.pm * BM + r; }
};

template <class Epi, class Sched, bool ALIGN_EPI, bool GATHER = false, int ES = 2>
__device__ __forceinline__ void gemm_phase(LAS unsigned char* lds, const Gemm g, const Sched& S, const Epi& E, int wave0) {
    int tid = wave0 * 64 + lane_id(); asm volatile("" : "+v"(tid));
    const int wid = __builtin_amdgcn_readfirstlane(tid >> 6), lane = tid & 63, wr = wid >> 2, wc = wid & 3, fr = lane & 15, fq = lane >> 4;
    const int K = g.K, nt = K * ES / 128;
    unsigned voffA, voffB;
    { int R, C; stage_rc(tid * 16, R, C); const int Rb = Epi::PERM ? ((R & ~31) + perm32(R & 31)) : R; voffA = (unsigned)(R * K * ES + C * 2); voffB = (unsigned)(Rb * K * ES + C * 2); }
    const unsigned pstep = (unsigned)(64 * K * ES);
    const unsigned kstep = 128u;
    const unsigned hstep = (unsigned)(HALF * K * ES);
    const unsigned tstep = 2u * hstep;
    const unsigned ldsw = (unsigned)wid * 1024u;
    const unsigned lp = (unsigned)lds_byte(fr, fq * 8); const unsigned aS = (unsigned)wr * 8192u, bS = (unsigned)wc * 4096u;
#define PG8_ADDR(soff) ({ unsigned _t = lp; asm volatile("" : "+v"(_t)); _t + (soff); })
    const __amdgpu_buffer_rsrc_t rA = __builtin_amdgcn_make_buffer_rsrc(const_cast<void*>(g.A), 0, 0x7fffffff, 0x00020000);
    const __amdgpu_buffer_rsrc_t rB = __builtin_amdgcn_make_buffer_rsrc(const_cast<void*>(g.Bt), 0, 0x7fffffff, 0x00020000);
#define PG8_SA(b, h) (((b) * 2 + (h)) * HTB)
#define PG8_SB(b, h) ((4 + (b) * 2 + (h)) * HTB)
#define PG8_STAGE(bufoff, rsrc, soff, voff) do { _Pragma("unroll") for (int _i = 0; _i < 2; ++_i) \
        __builtin_amdgcn_raw_ptr_buffer_load_lds(rsrc, (LAS unsigned*)(lds + (bufoff) + ldsw + _i * 8192), 16, (voff), (int)((soff) + _i * pstep), 0, 0); } while (0)
#define PG8_STAGE_G(bufoff, rsrc, soff, V) do { _Pragma("unroll") for (int _i = 0; _i < 2; ++_i) \
        __builtin_amdgcn_raw_ptr_buffer_load_lds(rsrc, (LAS unsigned*)(lds + (bufoff) + ldsw + _i * 8192), 16, (V)[_i], (int)(soff), 0, 0); } while (0)
#define PG8_STAGE_A(bufoff, uo, kb, h, V) do { if constexpr (GATHER) { PG8_STAGE_G(bufoff, rA, (kb), (V)[h]); } else { PG8_STAGE(bufoff, rA, (uo) + (kb) + (h) * hstep, voffA); } } while (0)
#define PG8_AOFF(dst, u) do { const int _t = wid * 64 + lane_id(); _Pragma("unroll") for (int _i = 0; _i < 2; ++_i) { int _R, _C; stage_rc(_t * 16 + _i * 8192, _R, _C); _Pragma("unroll") for (int _h = 0; _h < 2; ++_h) \
        dst[_h][_i] = (unsigned)S.arow(u, _R + _h * HALF) * (unsigned)(K * ES) + (unsigned)_C * 2u; } } while (0)
#define PG8_FR(p) (*(const LAS bf16x8*)(p))
#define PG8_FR8(p) __builtin_shufflevector(__builtin_bit_cast(i32x4, PG8_FR(p)), __builtin_bit_cast(i32x4, PG8_FR((p) + 1024)), 0, 1, 2, 3, 4, 5, 6, 7)
#define PG8_LDA(dst, b, h) do { const unsigned aoff = PG8_ADDR(aS); _Pragma("unroll") for (int m = 0; m < 4; ++m) { if constexpr (ES == 2) { _Pragma("unroll") for (int k = 0; k < 2; ++k) dst[m][k] = PG8_FR(lds + PG8_SA(b, h) + aoff + m * 2048 + k * 1024); } \
        else dst##8[m] = PG8_FR8(lds + PG8_SA(b, h) + aoff + m * 2048); } } while (0)
#define PG8_LDB(dst, b, h) do { const unsigned boff = PG8_ADDR(bS); _Pragma("unroll") for (int n = 0; n < 2; ++n) { if constexpr (ES == 2) { _Pragma("unroll") for (int k = 0; k < 2; ++k) dst[n][k] = PG8_FR(lds + PG8_SB(b, h) + boff + n * 2048 + k * 1024); } \
        else dst##8[n] = PG8_FR8(lds + PG8_SB(b, h) + boff + n * 2048); } } while (0)
#define PG8_MMA(ai, bj, At, Bt) do { __builtin_amdgcn_s_setprio(1); _Pragma("unroll") for (int m = 0; m < 4; ++m) _Pragma("unroll") for (int n = 0; n < 2; ++n) { \
        if constexpr (ES == 2) { _Pragma("unroll") for (int k = 0; k < 2; ++k) acc[ai][bj][m][n] = __builtin_amdgcn_mfma_f32_16x16x32_bf16(Bt[n][k], At[m][k], acc[ai][bj][m][n], 0, 0, 0); } \
        else { acc[ai][bj][m][n] = __builtin_amdgcn_mfma_scale_f32_16x16x128_f8f6f4(Bt##8[n], At##8[m], acc[ai][bj][m][n], 0, 0, 0, 0, 0, 0); } } \
        __builtin_amdgcn_s_setprio(0); } while (0)
#define PG8_WAIT_V(n) asm volatile("s_waitcnt vmcnt(" #n ")" ::: "memory")
#define PG8_WAIT_L(n) asm volatile("s_waitcnt lgkmcnt(" #n ")" ::: "memory")
#define PG8_BAR __builtin_amdgcn_s_barrier()
#define PG8_SCHED __builtin_amdgcn_sched_barrier(0)
    Unit cur, nxt; int ui = 0;
    if (!S.next(0, cur)) return;
    f32x4 acc[2][2][4][2];
#pragma unroll
    for (int a = 0; a < 2; ++a)
#pragma unroll
        for (int b = 0; b < 2; ++b)
#pragma unroll
            for (int m = 0; m < 4; ++m)
#pragma unroll
                for (int n = 0; n < 2; ++n) acc[a][b][m][n] = (f32x4){0.f, 0.f, 0.f, 0.f};
    bf16x8 At[4][2], B0[2][2], B1[2][2];
    i32x8 At8[4], B08[2], B18[2];
    unsigned vc[2][2];
    LAS u32x4* vstash = (LAS u32x4*)(lds + VN_OFF - 0) + tid;
    if constexpr (GATHER) { PG8_AOFF(vc, cur); }
    unsigned cA = GATHER ? 0u : (unsigned)S.arow(cur, 0) * (unsigned)(K * ES);
    unsigned cB = (unsigned)cur.e * (unsigned)g.estride + (unsigned)cur.pn * tstep;
    PG8_STAGE(PG8_SB(0, 0), rB, cB, voffB); PG8_STAGE(PG8_SB(0, 1), rB, cB + hstep, voffB); PG8_STAGE_A(PG8_SA(0, 0), cA, 0u, 0, vc); PG8_STAGE_A(PG8_SA(0, 1), cA, 0u, 1, vc);
    if (wr == 1) PG8_BAR;
    PG8_WAIT_V(2); PG8_BAR;
    PG8_STAGE(PG8_SB(1, 0), rB, cB + kstep, voffB); PG8_STAGE_A(PG8_SA(1, 0), cA, kstep, 0, vc); PG8_STAGE(PG8_SB(1, 1), rB, cB + hstep + kstep, voffB);
    PG8_WAIT_V(6); PG8_BAR;
    for (;;) {
        const bool has_next = S.next(ui + 1, nxt);
        if constexpr (GATHER) { unsigned vn[2][2];
            if (has_next) { PG8_AOFF(vn, nxt); } else {
#pragma unroll
                for (int h = 0; h < 2; ++h)
#pragma unroll
                    for (int i = 0; i < 2; ++i) vn[h][i] = vc[h][i]; }
            *vstash = (u32x4){vn[0][0], vn[0][1], vn[1][0], vn[1][1]}; }
        const unsigned nA = GATHER ? 0u : (has_next ? (unsigned)S.arow(nxt, 0) * (unsigned)(K * ES) : cA);
        const unsigned nB = has_next ? (unsigned)nxt.e * (unsigned)g.estride + (unsigned)nxt.pn * tstep : cB;
        for (int t = 0; t < nt; t += 2) {
            const bool last = (t == nt - 2);
            const unsigned k1 = (unsigned)(t + 1) * kstep;
            const unsigned k2 = last ? 0u : (unsigned)(t + 2) * kstep, k3 = k2 + kstep;
            const unsigned a2 = last ? nA : cA;
            const unsigned b2 = last ? nB : cB + (unsigned)(t + 2) * kstep, b3 = b2 + kstep;
            PG8_LDB(B0, 0, 0); PG8_LDB(B1, 0, 1); PG8_SCHED; PG8_LDA(At, 0, 0); PG8_STAGE_A(PG8_SA(1, 1), cA, k1, 1, vc);
            if constexpr (GATHER) { if (last) { const u32x4 vv = *vstash; vc[0][0] = vv[0]; vc[0][1] = vv[1]; vc[1][0] = vv[2]; vc[1][1] = vv[3]; } }
            PG8_WAIT_V(8); PG8_WAIT_L(0); PG8_BAR; PG8_MMA(0, 0, At, B0); PG8_MMA(0, 1, At, B1); PG8_BAR; PG8_SCHED;
            PG8_LDA(At, 0, 1); PG8_STAGE(PG8_SB(0, 0), rB, b2, voffB); PG8_STAGE(PG8_SB(0, 1), rB, b2 + hstep, voffB); PG8_STAGE_A(PG8_SA(0, 0), a2, k2, 0, vc);
            PG8_WAIT_V(8); PG8_WAIT_L(0); PG8_BAR; PG8_MMA(1, 0, At, B0); PG8_MMA(1, 1, At, B1); PG8_BAR; PG8_SCHED;
            PG8_LDB(B0, 1, 0); PG8_LDB(B1, 1, 1); PG8_SCHED; PG8_LDA(At, 1, 0); PG8_STAGE_A(PG8_SA(0, 1), a2, k2, 1, vc);
            PG8_WAIT_V(8); PG8_WAIT_L(0); PG8_BAR; PG8_MMA(0, 0, At, B0); PG8_MMA(0, 1, At, B1); PG8_BAR; PG8_SCHED;
            PG8_LDA(At, 1, 1); PG8_STAGE(PG8_SB(1, 0), rB, b3, voffB); PG8_STAGE(PG8_SB(1, 1), rB, b3 + hstep, voffB); PG8_STAGE_A(PG8_SA(1, 0), a2, k3, 0, vc);
            PG8_WAIT_V(8); PG8_WAIT_L(0); PG8_BAR; PG8_MMA(1, 0, At, B0); PG8_MMA(1, 1, At, B1); PG8_BAR; PG8_SCHED;
        }
        if constexpr (ALIGN_EPI) { if (wr == 0) PG8_BAR; }
        { const int l2 = lane_id(); E(acc, cur, wr, wc, l2 & 15, l2 >> 4); }
        if (!has_next) break;
#pragma unroll
        for (int a = 0; a < 2; ++a)
#pragma unroll
            for (int b = 0; b < 2; ++b)
#pragma unroll
                for (int m = 0; m < 4; ++m)
#pragma unroll
                    for (int n = 0; n < 2; ++n) acc[a][b][m][n] = (f32x4){0.f, 0.f, 0.f, 0.f};
        cur = nxt; cA = nA; cB = nB; ++ui;
        if constexpr (ALIGN_EPI) { if (wr == 1) PG8_BAR; }
    }
    PG8_WAIT_V(0);
    if constexpr (!ALIGN_EPI) { if (wr == 0) PG8_BAR; }
    PG8_BAR;
#undef PG8_SA
#undef PG8_SB
#undef PG8_STAGE
#undef PG8_STAGE_G
#undef PG8_STAGE_A
#undef PG8_AOFF
#undef PG8_LDA
#undef PG8_LDB
#undef PG8_MMA
#undef PG8_FR
#undef PG8_ADDR
#undef PG8_FR8
#undef PG8_WAIT_V
#undef PG8_WAIT_L
#undef PG8_BAR
#undef PG8_SCHED
}

struct EpiProj {
    static constexpr bool PERM = true;
    bf16_t* PJ; const float* qn; const float* kn; const float* ropec; const float* ropes; unsigned* nrm;
    __device__ __forceinline__ void operator()(const f32x4 (&acc)[2][2][4][2], const Unit& u, int wr, int wc, int fr, int fq) const {
        const int row0 = u.pm * BM + wr * 64 + fr, pn = u.pn;
        const bool htype = (pn == 1) || (pn == 2);
        const bool roped = (pn == 1) || (pn == 2 && wc < 2);
        if (!htype) {
            const float sc = (pn == 3) ? 0.17677669529663687f * LOG2E : (pn == 6 ? 0.125f * LOG2E : 1.f);
            const int col0 = pn * BM + wc * 32 + 8 * fq;
            float nmax[2] = {0.f, 0.f};
#pragma unroll
            for (int ai = 0; ai < 2; ++ai)
#pragma unroll
                for (int m = 0; m < 4; ++m) { bf16_t* rowp = PJ + (size_t)(row0 + ai * HALF + m * 16) * D_IN + col0;
#pragma unroll
                    for (int bj = 0; bj < 2; ++bj) { const f32x4 v0 = acc[ai][bj][m][0] * sc, v1 = acc[ai][bj][m][1] * sc;
                        u32x4 w; w.x = pkbf(v0[0], v0[1]); w.y = pkbf(v0[2], v0[3]); w.z = pkbf(v1[0], v1[1]); w.w = pkbf(v1[2], v1[3]);
                        *(u32x4*)(rowp + bj * HALF) = w;
                        if (pn == 3 || pn == 4) { float ss = (v0[0] * v0[0] + v0[1] * v0[1]) + (v0[2] * v0[2] + v0[3] * v0[3]) + (v1[0] * v1[0] + v1[1] * v1[1]) + (v1[2] * v1[2] + v1[3] * v1[3]);
                            ss += xor_lane<16>(ss); ss = sum_xor32(ss); nmax[bj] = __builtin_fmaxf(nmax[bj], ss); } } }
            if (pn == 3 || pn == 4) {
#pragma unroll
                for (int bj = 0; bj < 2; ++bj) { float v = nmax[bj]; v = __builtin_fmaxf(v, xor_lane<1>(v)); v = __builtin_fmaxf(v, xor_lane<2>(v)); v = __builtin_fmaxf(v, xor_lane<4>(v)); v = __builtin_fmaxf(v, xor_lane<8>(v));
                    if (fr == 0 && fq == 0) { const int b = (u.pm * BM) / SEQ, h = 2 * bj + (wc >> 1), c = wc & 1;
                        __hip_atomic_fetch_max(nrm + ((pn - 3) * 16 + b) * 8 + h * 2 + c, __float_as_uint(v), __ATOMIC_RELAXED, __HIP_MEMORY_SCOPE_AGENT); } }
            }
        } else {
            const int colh = pn * BM + wc * 64 + 8 * fq;
            if (!roped) {
#pragma unroll
                for (int ai = 0; ai < 2; ++ai)
#pragma unroll
                    for (int m = 0; m < 4; ++m) { bf16_t* rowp = PJ + (size_t)(row0 + ai * HALF + m * 16) * D_IN + colh;
#pragma unroll
                        for (int bj = 0; bj < 2; ++bj) { const f32x4 v0 = acc[ai][bj][m][0], v1 = acc[ai][bj][m][1];
                            u32x4 w; w.x = pkbf(v0[0], v0[1]); w.y = pkbf(v0[2], v0[3]); w.z = pkbf(v1[0], v1[1]); w.w = pkbf(v1[2], v1[3]);
                            *(u32x4*)(rowp + bj * 32) = w; } }
            } else {
                const float* nw = (pn == 1) ? qn : kn; const float osc = (pn == 1) ? 0.125f * LOG2E : 1.f;
                f32x4 w1[2], w2[2];
#pragma unroll
                for (int bj = 0; bj < 2; ++bj) { w1[bj] = *(const f32x4*)(nw + 32 * bj + 4 * fq); w2[bj] = *(const f32x4*)(nw + 32 * bj + 16 + 4 * fq); }
#pragma unroll
                for (int ai = 0; ai < 2; ++ai)
#pragma unroll
                    for (int m = 0; m < 4; ++m) {
                        const int row = row0 + ai * HALF + m * 16, s = row & (SEQ - 1);
                        float ss = 0.f;
#pragma unroll
                        for (int bj = 0; bj < 2; ++bj)
#pragma unroll
                            for (int n = 0; n < 2; ++n) { const f32x4 x = acc[ai][bj][m][n]; ss += (x[0] * x[0] + x[1] * x[1]) + (x[2] * x[2] + x[3] * x[3]); }
                        ss += xor_lane<16>(ss); ss = sum_xor32(ss);
                        const float rinv = 1.0f / sqrtf(ss * (1.f / 64.f) + RMS_EPS);
                        bf16_t* rowp = PJ + (size_t)row * D_IN + colh;
#pragma unroll
                        for (int bj = 0; bj < 2; ++bj) {
                            const f32x4 c = *(const f32x4*)(ropec + s * 32 + bj * 16 + 4 * fq), sn = *(const f32x4*)(ropes + s * 32 + bj * 16 + 4 * fq);
                            const f32x4 x1 = acc[ai][bj][m][0] * rinv * w1[bj], x2 = acc[ai][bj][m][1] * rinv * w2[bj];
                            const f32x4 o1 = (x1 * c - x2 * sn) * osc, o2 = (x2 * c + x1 * sn) * osc;
                            u32x4 w; w.x = pkbf(o1[0], o1[1]); w.y = pkbf(o1[2], o1[3]); w.z = pkbf(o2[0], o2[1]); w.w = pkbf(o2[2], o2[3]);
                            *(u32x4*)(rowp + bj * 32) = w; }
                    }
            }
        }
    }
};
struct EpiResid {
    static constexpr bool PERM = false;
    float* X;
    __device__ __forceinline__ void operator()(const f32x4 (&acc)[2][2][4][2], const Unit& u, int wr, int wc, int fr, int fq) const {
        const int row0 = u.pm * BM + wr * 64 + fr, col0 = u.pn * BM + wc * 32 + 4 * fq;
#pragma unroll
        for (int ai = 0; ai < 2; ++ai)
#pragma unroll
            for (int m = 0; m < 4; ++m) { float* rowp = X + (size_t)(row0 + ai * HALF + m * 16) * DM + col0;
#pragma unroll
                for (int bj = 0; bj < 2; ++bj)
#pragma unroll
                    for (int n = 0; n < 2; ++n) { f32x4* p = (f32x4*)(rowp + bj * HALF + n * 16); *p = *p * ALPHA + acc[ai][bj][m][n]; } }
    }
};
template <bool OUT8>
struct EpiSwiGLU {
    static constexpr bool PERM = true;
    void* H; int ldh; int rt0;
    __device__ __forceinline__ void operator()(const f32x4 (&acc)[2][2][4][2], const Unit& u, int wr, int wc, int fr, int fq) const {
        const int row0 = (u.pm - rt0) * BM + wr * 64 + fr, col0 = u.pn * HALF + wc * 32 + 8 * fq;
#pragma unroll
        for (int ai = 0; ai < 2; ++ai)
#pragma unroll
            for (int m = 0; m < 4; ++m) {
                float o[8];
#pragma unroll
                for (int n = 0; n < 2; ++n)
#pragma unroll
                    for (int j = 0; j < 4; ++j) { const float isc = OUT8 ? 1.0f / EGU_SCALE : 1.0f; const float gv = acc[ai][0][m][n][j] * isc, uv = acc[ai][1][m][n][j] * isc;
                        o[4 * n + j] = gv * __builtin_amdgcn_rcpf(1.0f + __builtin_amdgcn_exp2f(-gv * LOG2E)) * uv; }
                if constexpr (OUT8) { u32x2 w; w.x = pk4_fp8(o[0], o[1], o[2], o[3]); w.y = pk4_fp8(o[4], o[5], o[6], o[7]);
                    *(u32x2*)((unsigned char*)H + (size_t)(row0 + ai * HALF + m * 16) * ldh + col0) = w; }
                else { u32x4 w; w.x = pkbf(o[0], o[1]); w.y = pkbf(o[2], o[3]); w.z = pkbf(o[4], o[5]); w.w = pkbf(o[6], o[7]);
                    *(u32x4*)((bf16_t*)H + (size_t)(row0 + ai * HALF + m * 16) * ldh + col0) = w; } }
    }
};
struct EpiBf16 {
    static constexpr bool PERM = true;
    bf16_t* O; int ldc; float sc;
    __device__ __forceinline__ void operator()(const f32x4 (&acc)[2][2][4][2], const Unit& u, int wr, int wc, int fr, int fq) const {
        const int row0 = u.pm * BM + wr * 64 + fr, col0 = u.pn * BM + wc * 32 + 8 * fq;
#pragma unroll
        for (int ai = 0; ai < 2; ++ai)
#pragma unroll
            for (int m = 0; m < 4; ++m) { bf16_t* rowp = O + (size_t)(row0 + ai * HALF + m * 16) * ldc + col0;
#pragma unroll
                for (int bj = 0; bj < 2; ++bj) { const f32x4 v0 = acc[ai][bj][m][0] * sc, v1 = acc[ai][bj][m][1] * sc;
                    u32x4 w; w.x = pkbf(v0[0], v0[1]); w.y = pkbf(v0[2], v0[3]); w.z = pkbf(v1[0], v1[1]); w.w = pkbf(v1[2], v1[3]);
                    *(u32x4*)(rowp + bj * HALF) = w; } }
    }
};
}

struct MoeTable { volatile LAS int* T; };
__device__ __forceinline__ int moe_expert_of(const MoeTable& t, int rt) { int e = 0;
#pragma unroll
    for (int j = 1; j < 8; ++j) e += (rt >= t.T[j]) ? 1 : 0;
    return __builtin_amdgcn_readfirstlane(e); }
struct MoeOrder {
    MoeTable tab; int rt_lo, nM, nN, G, c; const int* ltok; bool gather;
    __device__ __forceinline__ bool next(int i, pg8::Unit& u) const {
        int pm, pn; if (!pg8::grid_order(i, G, c, nM, nN, pm, pn)) return false;
        u.pm = rt_lo + pm; u.pn = pn; u.e = moe_expert_of(tab, u.pm); u.p0 = __builtin_amdgcn_readfirstlane((u.pm - tab.T[u.e]) * 256); u.cnt = __builtin_amdgcn_readfirstlane(tab.T[16 + u.e]); return true; }
    __device__ __forceinline__ int arow(const pg8::Unit& u, int r) const {
        if (gather) { const int p = u.p0 + r; return p < u.cnt ? ltok[u.e * M + p] : 0; }
        return (u.pm - rt_lo) * 256 + r; }
};

namespace att {
constexpr int PJP = D_IN, MXP = DM, SLOTB = 8192;
constexpr int L_K = 0, L_V = 2 * SLOTB, L_WS = 4 * SLOTB, L_OST = L_WS + 8 * 512, OST_W = 32 * 68 * 4, L_BYTES = L_OST + 8 * OST_W;
static_assert(L_BYTES <= RING_BYTES, "attention scratch");
constexpr float THR = 8.0f;
__device__ __forceinline__ int crow(int r, int hi) { return (r & 3) + 8 * (r >> 2) + 4 * hi; }
__device__ __forceinline__ void glds16(const void* gsrc, unsigned lds_dst) { unsigned keep;
    asm volatile("s_mov_b32 %0, m0\n\ts_mov_b32 m0, %2\n\ts_nop 0\n\tglobal_load_lds_dwordx4 %1, off\n\ts_mov_b32 m0, %0" : "=&s"(keep) : "v"(gsrc), "s"(lds_dst) : "memory"); }
#define ATT_MX3(a, b, c) __builtin_fmaxf(__builtin_fmaxf((a), (b)), (c))
__device__ __forceinline__ float rowmax(const f32x16& p0, const f32x16& p1) {
    float a = ATT_MX3(p0[0], p0[1], p1[0]), b = ATT_MX3(p0[2], p0[3], p1[1]); a = ATT_MX3(a, p1[2], p1[3]);
#pragma unroll
    for (int r = 4; r < 16; r += 4) { a = ATT_MX3(a, p0[r], p0[r + 1]); b = ATT_MX3(b, p0[r + 2], p0[r + 3]); a = ATT_MX3(a, p1[r], p1[r + 1]); b = ATT_MX3(b, p1[r + 2], p1[r + 3]); }
    float m = __builtin_fmaxf(a, b); auto rr = __builtin_amdgcn_permlane32_swap(__float_as_uint(m), __float_as_uint(m), false, false);
    return __builtin_fmaxf(__uint_as_float(rr[0]), __uint_as_float(rr[1])); }
template <int D0, int NS>
__device__ __forceinline__ void qkt(f32x16& p0, f32x16& p1, const LAS unsigned char* Kslot, const bf16x8* qr, const f32x16& cinit, int r32, int hi) {
    const LAS unsigned char* kb = Kslot + hi * 1024 + r32 * 16;
#pragma unroll
    for (int s = 0; s < NS; ++s) { const int d0 = D0 + s;
        const bf16x8 b0 = *(const LAS bf16x8*)(kb + d0 * 2048), b1 = *(const LAS bf16x8*)(kb + d0 * 2048 + 512);
        if (s == 0) { p0 = __builtin_amdgcn_mfma_f32_32x32x16_bf16(b0, qr[d0], cinit, 0, 0, 0); p1 = __builtin_amdgcn_mfma_f32_32x32x16_bf16(b1, qr[d0], cinit, 0, 0, 0); }
        else { p0 = __builtin_amdgcn_mfma_f32_32x32x16_bf16(b0, qr[d0], p0, 0, 0, 0); p1 = __builtin_amdgcn_mfma_f32_32x32x16_bf16(b1, qr[d0], p1, 0, 0, 0); } }
}
__device__ __forceinline__ void pv(f32x16* o, int vb, bf16x8 pa0, bf16x8 pa1, bf16x8 pa2, bf16x8 pa3) {
#pragma unroll
    for (int d0 = 0; d0 < 2; ++d0) { s16x4 lo[4], hi[4];
#pragma unroll
        for (int ks = 0; ks < 4; ++ks) {
            asm volatile("ds_read_b64_tr_b16 %0,%1 offset:%c2" : "=&v"(lo[ks]) : "v"(vb), "i"(d0 * 4096 + ks * 1024) : "memory");
            asm volatile("ds_read_b64_tr_b16 %0,%1 offset:%c2" : "=&v"(hi[ks]) : "v"(vb), "i"(d0 * 4096 + ks * 1024 + 512) : "memory"); }
        asm volatile("s_waitcnt lgkmcnt(0)" ::: "memory"); __builtin_amdgcn_sched_barrier(0);
#define ATT_PK(k) (bf16x8){lo[k][0], lo[k][1], lo[k][2], lo[k][3], hi[k][0], hi[k][1], hi[k][2], hi[k][3]}
        o[d0] = __builtin_amdgcn_mfma_f32_32x32x16_bf16(pa0, ATT_PK(0), o[d0], 0, 0, 0);
        o[d0] = __builtin_amdgcn_mfma_f32_32x32x16_bf16(pa1, ATT_PK(1), o[d0], 0, 0, 0);
        o[d0] = __builtin_amdgcn_mfma_f32_32x32x16_bf16(pa2, ATT_PK(2), o[d0], 0, 0, 0);
        o[d0] = __builtin_amdgcn_mfma_f32_32x32x16_bf16(pa3, ATT_PK(3), o[d0], 0, 0, 0);
#undef ATT_PK
    }
}
struct Par { float slope2; float sink2; float lam; float oscale; const float* subln; int dcut; };
template <int VAR>
__device__ __forceinline__ void unit(int b, int h, int qb, const bf16_t* PJ, bf16_t* MIX, LAS unsigned char* shm, const Par P, int wave0) {
    constexpr int NC = (VAR == 1) ? 2 : 1;
    constexpr int QC = VAR == 0 ? 256 : (VAR == 1 ? 768 : 1536), KC = VAR == 0 ? 512 : (VAR == 1 ? 1024 : 1792), VC = VAR == 0 ? 640 : (VAR == 1 ? 1280 : 1920), OC = VAR == 0 ? 256 : (VAR == 1 ? 512 : 768);
    int tid = wave0 * 64 + lane_id(); asm volatile("" : "+v"(tid));
    const int lane = tid & 63, r32 = lane & 31, hi = lane >> 5; const int wid = __builtin_amdgcn_readfirstlane(tid >> 6);
    const long rowbase = (long)b * SEQ; const int q0 = qb * 256;
    const int kvh = (VAR == 1) ? h : (h >> 1);
    const bf16_t* Qw = PJ + (rowbase + q0 + wid * 32) * PJP + QC + h * 64;
    const bf16_t* Kh = PJ + rowbase * PJP + KC + kvh * 64; const bf16_t* Vh = PJ + rowbase * PJP + VC + kvh * 64;
    const unsigned lds0 = (unsigned)(uintptr_t)shm;
    LAS float* wsf = (LAS float*)(shm + L_WS) + wid * 128;
    const bf16_t* ksrc = Kh + (long)lane * PJP + wid * 8;
    const bf16_t* vsrc = Vh + (long)(16 * (wid & 3) + (lane >> 2)) * PJP + (wid >> 2) * 32 + (lane & 3) * 8;
    const unsigned kdst = lds0 + L_K + wid * 1024, vdst = lds0 + L_V + wid * 1024;
#define ATT_DMA_K(t, so) glds16(ksrc + (long)(t) * 64 * PJP, (unsigned)__builtin_amdgcn_readfirstlane(kdst + (so)))
#define ATT_DMA_V(t, so) glds16(vsrc + (long)(t) * 64 * PJP, (unsigned)__builtin_amdgcn_readfirstlane(vdst + (so)))
    const int vb0 = (int)(lds0 + L_V) + ((lane >> 4) & 1) * 32 + (lane & 3) * 8 + (4 * hi + ((lane & 15) >> 2)) * 64;
    int t_lo = 0, t_hi = 31;
    if (VAR == 2) { t_lo = q0 / 64 - 2; if (t_lo < 0) t_lo = 0; t_hi = q0 / 64 + 5; if (t_hi > 31) t_hi = 31; }
    if (VAR == 1) { t_lo = (q0 - P.dcut) >> 6; if (t_lo < 0) t_lo = 0; t_hi = (q0 + 255 + P.dcut) >> 6; if (t_hi > 31) t_hi = 31; }
    ATT_DMA_K(t_lo, 0); ATT_DMA_V(t_lo, 0);
    bf16x8 qr[4];
#pragma unroll
    for (int d0 = 0; d0 < 4; ++d0) qr[d0] = *reinterpret_cast<const bf16x8*>(&Qw[(long)r32 * PJP + d0 * 16 + hi * 8]);
    float mh[NC], lsum[NC]; f32x16 o[NC][2];
    float zf = 0.f; asm volatile("" : "+v"(zf));
#pragma unroll
    for (int c = 0; c < NC; ++c) { mh[c] = (VAR == 2) ? P.sink2 : 0.f; lsum[c] = (VAR == 2 && hi == 0) ? 1.f : 0.f;
#pragma unroll
        for (int r = 0; r < 16; ++r) { o[c][0][r] = zf; o[c][1][r] = zf; } }
    const int qpos = q0 + wid * 32 + r32, qw = q0 + wid * 32;
    bool started = false;
    for (int t = t_lo; t <= t_hi; ++t) {
        const int so = ((t - t_lo) & 1) * SLOTB;
        asm volatile("s_waitcnt vmcnt(0) lgkmcnt(0)\n\ts_barrier" ::: "memory");
        if (t < t_hi) { ATT_DMA_K(t + 1, so ^ SLOTB); ATT_DMA_V(t + 1, so ^ SLOTB); }
        bool rel = true;
        if (VAR == 2) rel = (64 * t + 63 >= qw - 128) && (64 * t <= qw + 31 + 128);
        if (VAR == 1) rel = (64 * t + 63 >= qw - P.dcut) && (64 * t <= qw + 31 + P.dcut);
        if (rel) {
            const bool first = (VAR != 2) && !started; started = true;
#pragma unroll
            for (int c = 0; c < NC; ++c) {
                f32x16 cinit;
#pragma unroll
                for (int r = 0; r < 16; ++r) cinit[r] = -mh[c];
                f32x16 p0, p1;
                if (VAR == 1) { if (c == 0) qkt<0, 2>(p0, p1, shm + L_K + so, qr, cinit, r32, hi); else qkt<2, 2>(p0, p1, shm + L_K + so, qr, cinit, r32, hi); }
                else qkt<0, 4>(p0, p1, shm + L_K + so, qr, cinit, r32, hi);
                if (VAR != 0) {
                    const int kvb = 64 * t + 4 * hi;
#pragma unroll
                    for (int r = 0; r < 16; ++r) { const int kv = kvb + (r & 3) + 8 * (r >> 2);
                        int d0 = qpos - kv; d0 = d0 < 0 ? -d0 : d0; int d1 = qpos - kv - 32; d1 = d1 < 0 ? -d1 : d1;
                        p0[r] -= P.slope2 * (float)d0; p1[r] -= P.slope2 * (float)d1;
                        if (VAR == 2) { if (d0 > 128) p0[r] = -INFINITY; if (d1 > 128) p1[r] = -INFINITY; } }
                }
                const float rm = rowmax(p0, p1);
                if (first) {
                    mh[c] = rm;
#pragma unroll
                    for (int r = 0; r < 16; ++r) { p0[r] -= rm; p1[r] -= rm; }
                } else if (__any(rm > THR)) {
                    const float dl = __builtin_fmaxf(rm, 0.f); mh[c] += dl;
#pragma unroll
                    for (int r = 0; r < 16; ++r) { p0[r] -= dl; p1[r] -= dl; }
                    const float f = __builtin_amdgcn_exp2f(-dl); lsum[c] *= f;
                    if (hi == 0) wsf[r32] = f;
                    asm volatile("s_waitcnt lgkmcnt(0)" ::: "memory");
#pragma unroll
                    for (int r = 0; r < 16; ++r) { const float fr_ = wsf[crow(r, hi)]; o[c][0][r] *= fr_; o[c][1][r] *= fr_; }
                }
                float sacc = 0.f;
#pragma unroll
                for (int r = 0; r < 16; ++r) { p0[r] = __builtin_amdgcn_exp2f(p0[r]); p1[r] = __builtin_amdgcn_exp2f(p1[r]); sacc += p0[r] + p1[r]; }
                lsum[c] += sacc;
                u32x4 pw0, pw1, pw2, pw3;
                pw0 = (u32x4){pkbf(p0[0], p0[1]), pkbf(p0[2], p0[3]), pkbf(p0[4], p0[5]), pkbf(p0[6], p0[7])};
                pw1 = (u32x4){pkbf(p0[8], p0[9]), pkbf(p0[10], p0[11]), pkbf(p0[12], p0[13]), pkbf(p0[14], p0[15])};
                pw2 = (u32x4){pkbf(p1[0], p1[1]), pkbf(p1[2], p1[3]), pkbf(p1[4], p1[5]), pkbf(p1[6], p1[7])};
                pw3 = (u32x4){pkbf(p1[8], p1[9]), pkbf(p1[10], p1[11]), pkbf(p1[12], p1[13]), pkbf(p1[14], p1[15])};
                pv(o[c], vb0 + so, __builtin_bit_cast(bf16x8, pw0), __builtin_bit_cast(bf16x8, pw1), __builtin_bit_cast(bf16x8, pw2), __builtin_bit_cast(bf16x8, pw3));
            }
        }
    }
#pragma unroll
    for (int c = 0; c < NC; ++c) { auto rr = __builtin_amdgcn_permlane32_swap(__float_as_uint(lsum[c]), __float_as_uint(lsum[c]), false, false);
        const float lt = __uint_as_float(rr[0]) + __uint_as_float(rr[1]); if (hi == 0) wsf[32 + 32 * c + r32] = lt; }
    asm volatile("s_waitcnt lgkmcnt(0)" ::: "memory");
    LAS float* stg = (LAS float*)(shm + L_OST + wid * OST_W);
#pragma unroll
    for (int r = 0; r < 16; ++r) { const int orow = crow(r, hi);
        const float rl0 = __builtin_amdgcn_rcpf(wsf[32 + orow]);
        float rl1 = 0.f; if (VAR == 1) rl1 = P.lam * __builtin_amdgcn_rcpf(wsf[64 + orow]);
#pragma unroll
        for (int d0 = 0; d0 < 2; ++d0) { float v = o[0][d0][r] * rl0; if (VAR == 1) v -= o[NC - 1][d0][r] * rl1; stg[orow * 68 + d0 * 32 + r32] = v; } }
    asm volatile("s_waitcnt lgkmcnt(0)" ::: "memory");
    {
        const int row = lane >> 1, half = lane & 1;
        f32x4 x[8];
#pragma unroll
        for (int k = 0; k < 8; ++k) x[k] = *(const LAS f32x4*)(stg + row * 68 + half * 32 + 4 * k);
        if (VAR == 1) {
            float ss = 0.f;
#pragma unroll
            for (int k = 0; k < 8; ++k) ss += (x[k][0] * x[k][0] + x[k][1] * x[k][1]) + (x[k][2] * x[k][2] + x[k][3] * x[k][3]);
            ss += xor_lane<1>(ss);
            const float rinv = P.oscale / sqrtf(ss * (1.f / 64.f) + RMS_EPS);
#pragma unroll
            for (int k = 0; k < 8; ++k) x[k] = x[k] * rinv * *(const f32x4*)(P.subln + half * 32 + 4 * k);
        }
        bf16_t* op = MIX + (rowbase + q0 + wid * 32 + row) * MXP + OC + h * 64 + half * 32;
#pragma unroll
        for (int k = 0; k < 4; ++k) { u32x4 w; w.x = pkbf(x[2 * k][0], x[2 * k][1]); w.y = pkbf(x[2 * k][2], x[2 * k][3]); w.z = pkbf(x[2 * k + 1][0], x[2 * k + 1][1]); w.w = pkbf(x[2 * k + 1][2], x[2 * k + 1][3]);
            *(u32x4*)(op + 8 * k) = w; }
    }
    asm volatile("s_waitcnt lgkmcnt(0)\n\ts_barrier" ::: "memory");
#undef ATT_DMA_K
#undef ATT_DMA_V
}
}

struct Frame {
    LAS unsigned char* lds; volatile LAS unsigned* MISC; gu32* ctl;
    int tid, lane, wave, vcu, G;
};
struct Args { const float* in[26]; float* out; unsigned char* ws; };
constexpr int PT_OFF = MISC_OFF + 1024;
__device__ __forceinline__ unsigned long long ldp_raw(LAS unsigned char* lds, int i) {
    unsigned z = 0u; asm volatile("" : "+v"(z));
    const unsigned a = z + (unsigned)(uintptr_t)lds + PT_OFF + 8u * (unsigned)i;
    const unsigned long long v = *(volatile LAS unsigned long long*)(uintptr_t)a;
    const unsigned lo = __builtin_amdgcn_readfirstlane((unsigned)v), hi = __builtin_amdgcn_readfirstlane((unsigned)(v >> 32));
    return ((unsigned long long)hi << 32) | lo; }
#define INP(i) ((const float*)ldp_raw(F.lds, (i)))
#define OUTP() ((float*)ldp_raw(F.lds, 26))
#define WSP() ((unsigned char*)ldp_raw(F.lds, 27))

__device__ __forceinline__ int winmap(int n) {
    const int tile = n >> 8, p = n & 255;
    if (tile != 1 && tile != 2) return n;
    const int hh = p >> 6, dim = p & 63, bj = dim >> 5, w = dim & 31;
    int fq, e;
    if (tile == 1 || hh < 2) { const int ehi = w >> 4, i = w & 15; fq = i >> 2; e = (i & 3) + 4 * ehi; }
    else { fq = w >> 3; e = w & 7; }
    return tile * 256 + 128 * bj + 32 * hh + 8 * fq + e;
}
template <int MAP> __device__ __forceinline__ int rowmap(int n) {
    if (MAP == 1) return winmap(n);
    if (MAP == 2) return (n >> 7) * 256 + (n & 127);
    if (MAP == 3) return (n >> 7) * 256 + 128 + (n & 127);
    return n;
}
__device__ __forceinline__ void tr_write(bf16_t* WT, int K, int k0, LAS float* scr, int lane, const int (&drow)[4]) {
    const int c = lane & 7;
#pragma unroll
    for (int j = 0; j < 4; ++j) { const int n = (lane >> 3) + 8 * j; const LAS float* s = scr + (8 * c) * 33 + n;
        u32x4 o; o.x = pkbf(s[0 * 33], s[1 * 33]); o.y = pkbf(s[2 * 33], s[3 * 33]); o.z = pkbf(s[4 * 33], s[5 * 33]); o.w = pkbf(s[6 * 33], s[7 * 33]);
        *(u32x4*)(WT + (size_t)drow[j] * K + k0 + 8 * c) = o; }
    asm volatile("s_waitcnt lgkmcnt(0)" ::: "memory");
}
template <int MAP>
__device__ __forceinline__ void tr_item(const float* W, int K, int N, int ncol0, bf16_t* WT, LAS float* scr, int item, int lane) {
    const int nblk = (N - ncol0) / 32, kb = item / nblk, nb = item % nblk, k0 = 64 * kb, n0 = ncol0 + 32 * nb;
    f32x4 v[8];
#pragma unroll
    for (int i = 0; i < 8; ++i) v[i] = __builtin_nontemporal_load((const f32x4*)(W + (size_t)(k0 + 8 * i + (lane >> 3)) * N + n0 + (lane & 7) * 4));
#pragma unroll
    for (int i = 0; i < 8; ++i) { LAS float* d = scr + (8 * i + (lane >> 3)) * 33 + (lane & 7) * 4; d[0] = v[i][0]; d[1] = v[i][1]; d[2] = v[i][2]; d[3] = v[i][3]; }
    asm volatile("s_waitcnt lgkmcnt(0)" ::: "memory");
    int drow[4];
#pragma unroll
    for (int j = 0; j < 4; ++j) drow[j] = rowmap<MAP>(n0 + (lane >> 3) + 8 * j);
    tr_write(WT, K, k0, scr, lane, drow);
}
template <int MAP>
__device__ __forceinline__ void tr_item8(const float* W, int K, int N, unsigned char* WT, float sc, LAS float* scr, int item, int lane) {
    const int nblk = N / 32, kb = item / nblk, nb = item % nblk, k0 = 64 * kb, n0 = 32 * nb;
    f32x4 v[8];
#pragma unroll
    for (int i = 0; i < 8; ++i) v[i] = __builtin_nontemporal_load((const f32x4*)(W + (size_t)(k0 + 8 * i + (lane >> 3)) * N + n0 + (lane & 7) * 4));
#pragma unroll
    for (int i = 0; i < 8; ++i) { LAS float* d = scr + (8 * i + (lane >> 3)) * 33 + (lane & 7) * 4; d[0] = v[i][0]; d[1] = v[i][1]; d[2] = v[i][2]; d[3] = v[i][3]; }
    asm volatile("s_waitcnt lgkmcnt(0)" ::: "memory");
    const int c = lane & 7;
#pragma unroll
    for (int j = 0; j < 4; ++j) { const int n = (lane >> 3) + 8 * j; const LAS float* s = scr + (8 * c) * 33 + n;
        u32x2 o; o.x = pk4_fp8(s[0 * 33] * sc, s[1 * 33] * sc, s[2 * 33] * sc, s[3 * 33] * sc); o.y = pk4_fp8(s[4 * 33] * sc, s[5 * 33] * sc, s[6 * 33] * sc, s[7 * 33] * sc);
        *(u32x2*)(WT + (size_t)rowmap<MAP>(n0 + n) * K + k0 + 8 * c) = o; }
    asm volatile("s_waitcnt lgkmcnt(0)" ::: "memory");
}
__device__ __forceinline__ void tr_item_pool_wg(const float* W, const float* wp, const float* scale, bf16_t* WT, LAS float* scr, int item, int tid) {
    const int kb = item / 8, nb = item % 8, k0 = 64 * kb, n0 = 32 * nb, g = n0 >> 6, kk = tid >> 3, nq = (tid & 7) * 4;
    const float* wrow = W + (size_t)(k0 + kk) * D_IN + 64 * g; const float* wpc = wp + (size_t)g * 4096 + (n0 & 63) + nq;
    f32x4 acc = {0.f, 0.f, 0.f, 0.f};
#pragma unroll 8
    for (int c = 0; c < 64; ++c) acc += *(const f32x4*)(wpc + c * 64) * wrow[c];
    acc = acc * *(const f32x4*)(scale + n0 + nq);
    LAS float* d = scr + kk * 33 + nq; d[0] = acc[0]; d[1] = acc[1]; d[2] = acc[2]; d[3] = acc[3];
    __syncthreads();
    if (tid < 64) { int drow[4];
#pragma unroll
        for (int j = 0; j < 4; ++j) drow[j] = n0 + (tid >> 3) + 8 * j;
        tr_write(WT, DM, k0, scr, tid, drow); }
    __syncthreads();
}
__device__ __forceinline__ void ln_core(f32x4 (&v)[4], const f32x4 (&g4)[4], const f32x4 (&b4)[4]) {
    float s = 0.f;
#pragma unroll
    for (int j = 0; j < 4; ++j) s += (v[j][0] + v[j][1]) + (v[j][2] + v[j][3]);
    const float mean = wave_sum(s) * (1.f / DM); float s2 = 0.f;
#pragma unroll
    for (int j = 0; j < 4; ++j) { v[j] = v[j] - mean; s2 += (v[j][0] * v[j][0] + v[j][1] * v[j][1]) + (v[j][2] * v[j][2] + v[j][3] * v[j][3]); }
    const float rstd = 1.f / sqrtf(wave_sum(s2) * (1.f / DM) + LN_EPS);
#pragma unroll
    for (int j = 0; j < 4; ++j) v[j] = v[j] * rstd * g4[j] + b4[j];
}
__device__ __forceinline__ void ln_store(const f32x4 (&v)[4], float* xo, bf16_t* xn, int lane) {
#pragma unroll
    for (int j = 0; j < 4; ++j) {
        if (xo) *((f32x4*)xo + lane + 64 * j) = v[j];
        if (xn) { u32x2 w; w.x = pkbf(v[j][0], v[j][1]); w.y = pkbf(v[j][2], v[j][3]); *((u32x2*)xn + lane + 64 * j) = w; } }
}

__global__ void __launch_bounds__(NWAVES * 64, 2) mega_fwd(Args args) {
    extern __shared__ __attribute__((aligned(16))) unsigned char lds_raw[];
    Frame F;
    F.lds = (LAS unsigned char*)lds_raw;
    F.MISC = (volatile LAS unsigned*)(F.lds + MISC_OFF);
    const int wave0 = __builtin_amdgcn_readfirstlane((int)threadIdx.x >> 6);
    F.ctl = (gu32*)(args.ws + WS_CTL);
    { const int t = wave0 * 64 + lane_id();
      for (int u = t; u < 256; u += NWAVES * 64) F.MISC[u] = 0u;
      if (t == 0) { volatile LAS unsigned long long* PT = (volatile LAS unsigned long long*)(F.lds + PT_OFF);
#pragma unroll
        for (int i = 0; i < 26; ++i) PT[i] = (unsigned long long)args.in[i];
        PT[26] = (unsigned long long)args.out; PT[27] = (unsigned long long)args.ws; } }
    __syncthreads();
    XcdBarrier bar = xcd_barrier_post((unsigned*)(F.ctl + CW_BAR), F.MISC + 8, wave0 == 0 && lane_id() == 0);
#define GRID_BAR() xcd_barrier(bar, wave0 == 0 && lane_id() == 0)
#define PHASE_LOCALS() int tid_ = wave0 * 64 + lane_id(); asm volatile("" : "+v"(tid_)); int bid_ = blockIdx.x, G_ = gridDim.x; asm volatile("" : "+s"(bid_), "+s"(G_)); \
    const int lane = tid_ & 63, wave = __builtin_amdgcn_readfirstlane(tid_ >> 6), vcu = (G_ % 8 == 0) ? (bid_ % 8) * (G_ / 8) + bid_ / 8 : bid_, gw = vcu * NWAVES + wave, NGW = G_ * NWAVES; \
    (void)lane; (void)gw; (void)NGW; (void)vcu; (void)wave

        asm volatile("; MARK_P0" ::: "memory");
    for (int dup = 0; dup < DUP_P0; ++dup) {
        PHASE_LOCALS();
        LAS float* scr = (LAS float*)(F.lds + wave * 16384);
        unsigned char* ws = WSP();
        const float* x_in = INP(0); const float* ln_in_g = INP(1); const float* ln_in_b = INP(2); const float* w_in = INP(3); const float* w_pool = INP(4); const float* pool_scale = INP(5);
        const float* w_out = INP(14); const float* w_gate = INP(17); const float* w_up = INP(18); const float* w_down = INP(19); const float* e_gate = INP(21); const float* e_up = INP(22); const float* e_down = INP(23);
        float* X = OUTP(); float* ropec = (float*)(ws + WS_ROPEC); float* ropes = (float*)(ws + WS_ROPES);
        bf16_t* Win_t = (bf16_t*)(ws + WS_WIN); bf16_t* Wout_t = (bf16_t*)(ws + WS_WOUT); bf16_t* Wgu_t = (bf16_t*)(ws + WS_WGU); bf16_t* Wd_t = (bf16_t*)(ws + WS_WD);
        unsigned char* Egu8 = ws + WS_EGU; unsigned char* Ed8 = ws + WS_ED; bf16_t* XN = (bf16_t*)(ws + WS_XN);
        constexpr int I_WIN = 16 * 56, I_POOL = 16 * 8, I_WOUT = 16 * 32, I_G = 16 * 88, I_D = 44 * 32, I_EG = 16 * 112, I_ED = 56 * 32;
        constexpr int N0 = 2 * I_WIN, N1 = N0 + 2 * I_WOUT, N2 = N1 + 2 * I_G, N3 = N2 + I_D, N4 = N3 + 16 * I_EG, N5 = N4 + 8 * I_ED;
        for (int pi = vcu; pi < 2 * I_POOL; pi += G_) { const int l = pi / I_POOL;
            tr_item_pool_wg(w_in + (size_t)l * DM * D_IN, w_pool + (size_t)l * 4 * 4096, pool_scale + l * 256, Win_t + (size_t)l * D_IN * DM, (LAS float*)F.lds, pi - l * I_POOL, tid_); }
        for (int it = gw; it < N5; it += NGW) {
            int r = it;
            if (r < N0) { const int l = r / I_WIN; r -= l * I_WIN; tr_item<1>(w_in + (size_t)l * DM * D_IN, DM, D_IN, 256, Win_t + (size_t)l * D_IN * DM, scr, r, lane); continue; }
            if (r < N1) { r -= N0; const int l = r / I_WOUT; r -= l * I_WOUT; tr_item<0>(w_out + (size_t)l * DM * DM, DM, DM, 0, Wout_t + (size_t)l * DM * DM, scr, r, lane); continue; }
            if (r < N2) { r -= N1; const int which = r / I_G; r -= which * I_G;
                if (which == 0) tr_item<2>(w_gate, DM, D_FF, 0, Wgu_t, scr, r, lane); else tr_item<3>(w_up, DM, D_FF, 0, Wgu_t, scr, r, lane);
                continue; }
            if (r < N3) { r -= N2; tr_item<0>(w_down, D_FF, DM, 0, Wd_t, scr, r, lane); continue; }
            if (r < N4) { r -= N3; const int idx = r / I_EG; r -= idx * I_EG; const int e = idx >> 1;
                if ((idx & 1) == 0) tr_item8<2>(e_gate + (size_t)e * DM * D_FFE, DM, D_FFE, Egu8 + (size_t)e * 2 * D_FFE * DM, EGU_SCALE, scr, r, lane);
                else tr_item8<3>(e_up + (size_t)e * DM * D_FFE, DM, D_FFE, Egu8 + (size_t)e * 2 * D_FFE * DM, EGU_SCALE, scr, r, lane);
                continue; }
            { r -= N4; const int e = r / I_ED; r -= e * I_ED; tr_item8<0>(e_down + (size_t)e * D_FFE * DM, D_FFE, DM, Ed8 + (size_t)e * DM * D_FFE, ED_SCALE, scr, r, lane); }
        }
        for (int idx = bid_ * 512 + tid_; idx < SEQ * 32; idx += G_ * 512) { const int s = idx >> 5, ax = (idx >> 4) & 1, i = idx & 15;
            const float pos = ax == 0 ? (float)(s / 64) : (float)(s % 64); const float inv_freq = powf(10000.0f, -(float)(2 * i) / 32.0f); const float ang = pos * inv_freq;
            ropec[idx] = cosf(ang); ropes[idx] = sinf(ang); }
        f32x4 g4[4], b4[4];
#pragma unroll
        for (int j = 0; j < 4; ++j) { g4[j] = *((const f32x4*)ln_in_g + lane + 64 * j); b4[j] = *((const f32x4*)ln_in_b + lane + 64 * j); }
        for (int m = gw; m < M; m += NGW) { f32x4 v[4];
#pragma unroll
            for (int j = 0; j < 4; ++j) v[j] = *((const f32x4*)(x_in + (size_t)m * DM) + lane + 64 * j);
            ln_core(v, g4, b4); ln_store(v, X + (size_t)m * DM, XN + (size_t)m * DM, lane); }
    }
    GRID_BAR();

#pragma clang loop unroll(full)
    for (int l = 0; l < DEPTH; ++l) {
        asm volatile("; MARK_P1" ::: "memory");
        for (int dup = 0; dup < DUP_P1; ++dup) {
            PHASE_LOCALS();
            unsigned char* ws = WSP(); const float* qn_w = INP(6); const float* kn_w = INP(7);
            bf16_t* XN = (bf16_t*)(ws + WS_XN); bf16_t* Win_t = (bf16_t*)(ws + WS_WIN); bf16_t* PJ = (bf16_t*)(ws + WS_PJ); const float* ropec = (const float*)(ws + WS_ROPEC); const float* ropes = (const float*)(ws + WS_ROPES);
            pg8::Gemm g{XN, Win_t + (size_t)l * D_IN * DM, DM, 0};
            pg8::StaticOrder S; S.init(M, D_IN, G_, bid_);
            pg8::EpiProj E{PJ, qn_w + l * 64, kn_w + l * 64, ropec, ropes, (unsigned*)(ws + WS_CTL) + CW_NRM + l * 256};
            pg8::gemm_phase<pg8::EpiProj, pg8::StaticOrder, true>(F.lds, g, S, E, wave0);
        }
        GRID_BAR();
        asm volatile("; MARK_P2" ::: "memory");
        for (int dup = 0; dup < DUP_P2; ++dup) {
            PHASE_LOCALS();
            unsigned char* ws = WSP(); const float* lam_q1 = INP(8); const float* lam_k1 = INP(9); const float* lam_q2 = INP(10); const float* lam_k2 = INP(11); const float* subln_w = INP(12); const float* sink = INP(13);
            bf16_t* PJ = (bf16_t*)(ws + WS_PJ); bf16_t* MIX = (bf16_t*)(ws + WS_MIX);
            const float lam_init = 0.8f - 0.6f * expf(-0.3f * (float)l);
            float a = lane < 32 ? lam_q1[l * 32 + lane] * lam_k1[l * 32 + lane] : 0.f, c = lane < 32 ? lam_q2[l * 32 + lane] * lam_k2[l * 32 + lane] : 0.f;
            const float lam = expf(wave_sum(a)) - expf(wave_sum(c)) + lam_init;
            unsigned* qhead = (unsigned*)(ws + WS_CTL) + CW_Q + 64 * l; const unsigned* nrm = (const unsigned*)(ws + WS_CTL) + CW_NRM + l * 256;
            volatile LAS unsigned* qslot = F.MISC + 32;
            for (;;) {
                if (wave0 == 0 && lane_id() == 0) *qslot = __hip_atomic_fetch_add(qhead, 1u, __ATOMIC_RELAXED, __HIP_MEMORY_SCOPE_AGENT);
                __syncthreads();
                const int idx = __builtin_amdgcn_readfirstlane((int)*qslot);
                __syncthreads();
                if (idx >= 1792) break;
                if (idx < 256 || (idx >= 768 && idx < 1024)) {
                    const int h = idx < 128 ? 3 : (idx < 256 ? 2 : (idx < 896 ? 1 : 0)), k = idx & 127, b = k >> 3, qb = k & 7;
                    const float slope2 = exp2f(-(float)(2 * h + 1)) * LOG2E;
                    const float q0n = __uint_as_float(nrm[(0 * 16 + b) * 8 + h * 2]), q1n = __uint_as_float(nrm[(0 * 16 + b) * 8 + h * 2 + 1]), k0n = __uint_as_float(nrm[(1 * 16 + b) * 8 + h * 2]), k1n = __uint_as_float(nrm[(1 * 16 + b) * 8 + h * 2 + 1]);
                    const float bound = sqrtf(__builtin_fmaxf(q0n * k0n, q1n * k1n));
                    float dc = (2.1f * bound + 40.0f) / slope2; if (dc > 4096.f) dc = 4096.f;
                    att::Par P{slope2, 0.f, lam, 1.0f - lam_init, subln_w + l * 64, (int)dc + 1};
                    att::unit<1>(b, h, qb, PJ, MIX, F.lds, P, wave0);
                } else if (idx < 768) {
                    const int k = idx - 256, qb = k & 7, h = (k >> 3) & 3, b = k >> 5;
                    att::Par P{0.f, 0.f, 0.f, 0.f, nullptr, 0};
                    att::unit<0>(b, h, qb, PJ, MIX, F.lds, P, wave0);
                } else if (idx < 1536) {
                    const int k = idx - 1024, qb = k & 7, h = (k >> 3) & 3, b = k >> 5;
                    att::Par P{exp2f(-(float)(2 * h + 2)) * LOG2E, sink[l * 4 + h] * LOG2E, 0.f, 0.f, nullptr, 0};
                    att::unit<2>(b, h, qb, PJ, MIX, F.lds, P, wave0);
                } else {
                    const int ch = idx - 1536;
                    for (int it = wave0 * 64 + lane_id(); it < 128 * 32; it += NWAVES * 64) { const int t = ch * 128 + (it >> 5), cg = it & 31, c0 = cg * 8, s = t & (SEQ - 1), base = t - s;
                        const int w = 2 << (c0 >> 6); int lo = s - w / 2, hi = lo + w; if (lo < 0) lo = 0; if (hi > SEQ) hi = SEQ;
                        float acc[8];
#pragma unroll
                        for (int j = 0; j < 8; ++j) acc[j] = 0.f;
                        for (int j = lo; j < hi; ++j) { const u32x4 zz = *(const u32x4*)(PJ + (size_t)(base + j) * D_IN + c0);
                            acc[0] += bf_lo(zz.x); acc[1] += bf_hi(zz.x); acc[2] += bf_lo(zz.y); acc[3] += bf_hi(zz.y); acc[4] += bf_lo(zz.z); acc[5] += bf_hi(zz.z); acc[6] += bf_lo(zz.w); acc[7] += bf_hi(zz.w); }
                        const float inv = 1.0f / (float)(hi - lo); const u32x4 zs = *(const u32x4*)(PJ + (size_t)t * D_IN + c0);
                        u32x4 o; o.x = pkbf(acc[0] * inv - bf_lo(zs.x), acc[1] * inv - bf_hi(zs.x)); o.y = pkbf(acc[2] * inv - bf_lo(zs.y), acc[3] * inv - bf_hi(zs.y));
                        o.z = pkbf(acc[4] * inv - bf_lo(zs.z), acc[5] * inv - bf_hi(zs.z)); o.w = pkbf(acc[6] * inv - bf_lo(zs.w), acc[7] * inv - bf_hi(zs.w));
                        *(u32x4*)(MIX + (size_t)t * DM + c0) = o; }
                }
            }
        }
        GRID_BAR();
        asm volatile("; MARK_P3" ::: "memory");
        {
            PHASE_LOCALS();
            unsigned char* ws = WSP(); float* X = OUTP(); bf16_t* MIX = (bf16_t*)(ws + WS_MIX); bf16_t* Wout_t = (bf16_t*)(ws + WS_WOUT);
            pg8::Gemm g{MIX, Wout_t + (size_t)l * DM * DM, DM, 0};
            pg8::StaticOrder S; S.init(M, DM, G_, bid_);
            pg8::EpiResid E{X};
            pg8::gemm_phase<pg8::EpiResid, pg8::StaticOrder, true>(F.lds, g, S, E, wave0);
        }
        GRID_BAR();
        asm volatile("; MARK_LN1" ::: "memory");
        {
            PHASE_LOCALS();
            unsigned char* ws = WSP(); float* X = OUTP(); const float* ln1_g = INP(15); const float* ln1_b = INP(16); const float* w_router = INP(20);
            bf16_t* XN = (bf16_t*)(ws + WS_XN); int* ltok = (int*)(ws + WS_LTOK); int* tpos = (int*)(ws + WS_TPOS); float* tgate = (float*)(ws + WS_TGATE);
            f32x4 g4[4], b4[4];
#pragma unroll
            for (int j = 0; j < 4; ++j) { g4[j] = *((const f32x4*)(ln1_g + l * DM) + lane + 64 * j); b4[j] = *((const f32x4*)(ln1_b + l * DM) + lane + 64 * j); }
            int me1 = -1, me2 = -1; float mg1 = 0.f, mg2 = 0.f;
            const int rows_per_wave = M / NGW;
            for (int ri = 0; ri < rows_per_wave; ++ri) { const int m = gw * rows_per_wave + ri; f32x4 v[4];
#pragma unroll
                for (int j = 0; j < 4; ++j) v[j] = *((const f32x4*)(X + (size_t)m * DM) + lane + 64 * j);
                ln_core(v, g4, b4);
                if (l == 0) ln_store(v, X + (size_t)m * DM, XN + (size_t)m * DM, lane);
                else { ln_store(v, X + (size_t)m * DM, nullptr, lane);
#pragma unroll
                    for (int j = 0; j < 4; ++j) *((unsigned*)((unsigned char*)XN + (size_t)m * DM) + lane + 64 * j) = pk4_fp8(v[j][0], v[j][1], v[j][2], v[j][3]); }
                if (l == 1) {
                    float lg[8];
#pragma unroll
                    for (int e = 0; e < 8; ++e) lg[e] = 0.f;
#pragma unroll
                    for (int j = 0; j < 4; ++j)
#pragma unroll
                        for (int q = 0; q < 4; ++q) { const int c = 4 * lane + 256 * j + q; const f32x4 wa = *(const f32x4*)(w_router + c * 8), wb = *(const f32x4*)(w_router + c * 8 + 4); const float xv = v[j][q];
                            lg[0] += xv * wa[0]; lg[1] += xv * wa[1]; lg[2] += xv * wa[2]; lg[3] += xv * wa[3]; lg[4] += xv * wb[0]; lg[5] += xv * wb[1]; lg[6] += xv * wb[2]; lg[7] += xv * wb[3]; }
#pragma unroll
                    for (int e = 0; e < 8; ++e) lg[e] = wave_sum(lg[e]);
                    int i1 = 0; float v1 = lg[0];
#pragma unroll
                    for (int e = 1; e < 8; ++e) if (lg[e] > v1) { v1 = lg[e]; i1 = e; }
                    int i2 = 0; float v2 = -INFINITY;
#pragma unroll
                    for (int e = 0; e < 8; ++e) if (e != i1 && lg[e] > v2) { v2 = lg[e]; i2 = e; }
                    const float ex = expf(v2 - v1), ga = 1.f / (1.f + ex), gb = ex / (1.f + ex);
                    if (lane == ri) { me1 = i1; me2 = i2; mg1 = ga; mg2 = gb; }
                }
            }
            if (l == 1) {
                const int myrow = gw * rows_per_wave + lane;
#pragma unroll
                for (int e = 0; e < 8; ++e) {
                    const bool has = (lane < rows_per_wave) && (me1 == e || me2 == e);
                    const unsigned long long mask = __ballot(has);
                    const int n = __popcll(mask);
                    if (n) {
                        int base = 0;
                        if (lane == 0) base = (int)__hip_atomic_fetch_add((unsigned*)(ws + WS_CTL) + CW_CNT + 64 * e, (unsigned)n, __ATOMIC_RELAXED, __HIP_MEMORY_SCOPE_AGENT);
                        base = __builtin_amdgcn_readfirstlane(base);
                        if (has) { const int p = base + (int)__builtin_amdgcn_mbcnt_hi((unsigned)(mask >> 32), __builtin_amdgcn_mbcnt_lo((unsigned)mask, 0u)); const int k = (me1 == e) ? 0 : 1;
                            ltok[e * M + p] = myrow; tpos[myrow * 2 + k] = (e << 20) | p; tgate[myrow * 2 + k] = k == 0 ? mg1 : mg2; }
                    }
                }
            }
        }
        GRID_BAR();
        if (l == 0) {
        asm volatile("; MARK_DENSE" ::: "memory");
            for (int dup = 0; dup < DUP_GU; ++dup) {
                PHASE_LOCALS();
                unsigned char* ws = WSP(); bf16_t* XN = (bf16_t*)(ws + WS_XN); bf16_t* Wgu_t = (bf16_t*)(ws + WS_WGU); bf16_t* Hd = (bf16_t*)(ws + WS_H);
                pg8::Gemm g{XN, Wgu_t, DM, 0};
                pg8::StaticOrder S; S.init(M, 2 * D_FF, G_, bid_);
                pg8::EpiSwiGLU<false> E{Hd, D_FF, 0};
                pg8::gemm_phase<pg8::EpiSwiGLU<false>, pg8::StaticOrder, true>(F.lds, g, S, E, wave0);
            }
            GRID_BAR();
            {
                PHASE_LOCALS();
                unsigned char* ws = WSP(); float* X = OUTP(); bf16_t* Wd_t = (bf16_t*)(ws + WS_WD); bf16_t* Hd = (bf16_t*)(ws + WS_H);
                pg8::Gemm g{Hd, Wd_t, D_FF, 0};
                pg8::StaticOrder S; S.init(M, DM, G_, bid_);
                pg8::EpiResid E{X};
                pg8::gemm_phase<pg8::EpiResid, pg8::StaticOrder, true>(F.lds, g, S, E, wave0);
            }
            GRID_BAR();
        asm volatile("; MARK_LN2" ::: "memory");
            {
                PHASE_LOCALS();
                unsigned char* ws = WSP(); float* X = OUTP(); const float* ln2_g = INP(24); const float* ln2_b = INP(25); bf16_t* XN = (bf16_t*)(ws + WS_XN);
                f32x4 g4[4], b4[4];
#pragma unroll
                for (int j = 0; j < 4; ++j) { g4[j] = *((const f32x4*)(ln2_g + l * DM) + lane + 64 * j); b4[j] = *((const f32x4*)(ln2_b + l * DM) + lane + 64 * j); }
                for (int m = gw; m < M; m += NGW) { f32x4 v[4];
#pragma unroll
                    for (int j = 0; j < 4; ++j) v[j] = *((const f32x4*)(X + (size_t)m * DM) + lane + 64 * j);
                    ln_core(v, g4, b4); ln_store(v, X + (size_t)m * DM, XN + (size_t)m * DM, lane); }
            }
            GRID_BAR();
        } else {
        asm volatile("; MARK_MOE" ::: "memory");
            volatile LAS int* T = (volatile LAS int*)(F.MISC + 64);
            if (wave0 == 0 && lane_id() == 0) { int acc = 0; unsigned* ctlw = (unsigned*)(WSP() + WS_CTL);
                for (int e = 0; e < 8; ++e) { const int c = (int)__hip_atomic_load(ctlw + CW_CNT + 64 * e, __ATOMIC_RELAXED, __HIP_MEMORY_SCOPE_AGENT); T[e] = acc; T[16 + e] = c; acc += (c + 255) >> 8; }
                T[8] = acc; }
            __syncthreads();
            MoeTable tab{T};
            const int total_tiles = __builtin_amdgcn_readfirstlane(T[8]);
            for (int dup = 0; dup < DUP_MOE; ++dup)
            for (int rt_lo = 0; rt_lo < total_tiles; rt_lo += CHUNK_TILES) {
                const int nrt = (total_tiles - rt_lo) < CHUNK_TILES ? (total_tiles - rt_lo) : CHUNK_TILES;
                {
                    PHASE_LOCALS();
                    unsigned char* ws = WSP(); unsigned char* XN8 = ws + WS_XN; unsigned char* Egu8 = ws + WS_EGU; unsigned char* HC = ws + WS_HC; const int* ltok = (const int*)(ws + WS_LTOK);
                    pg8::Gemm g{XN8, Egu8, DM, (size_t)2 * D_FFE * DM};
                    MoeOrder S{tab, rt_lo, nrt, 2 * D_FFE / 256, G_, bid_, ltok, true};
                    pg8::EpiSwiGLU<true> E{HC, D_FFE, rt_lo};
                    pg8::gemm_phase<pg8::EpiSwiGLU<true>, MoeOrder, true, true, 1>(F.lds, g, S, E, wave0);
                }
                GRID_BAR();
                {
                    PHASE_LOCALS();
                    unsigned char* ws = WSP(); unsigned char* Ed8 = ws + WS_ED; unsigned char* HC = ws + WS_HC; bf16_t* Y = (bf16_t*)(ws + WS_Y); const int* ltok = (const int*)(ws + WS_LTOK);
                    pg8::Gemm g{HC, Ed8, D_FFE, (size_t)DM * D_FFE};
                    MoeOrder S{tab, rt_lo, nrt, DM / 256, G_, bid_, ltok, false};
                    pg8::EpiBf16 E{Y, DM, 1.0f / ED_SCALE};
                    pg8::gemm_phase<pg8::EpiBf16, MoeOrder, true, false, 1>(F.lds, g, S, E, wave0);
                }
                GRID_BAR();
            }
        asm volatile("; MARK_COMB" ::: "memory");
            {
                PHASE_LOCALS();
                unsigned char* ws = WSP(); float* X = OUTP(); const float* ln2_g = INP(24); const float* ln2_b = INP(25);
                const bf16_t* Y = (const bf16_t*)(ws + WS_Y); const int* tpos = (const int*)(ws + WS_TPOS); const float* tgate = (const float*)(ws + WS_TGATE);
                f32x4 g4[4], b4[4];
#pragma unroll
                for (int j = 0; j < 4; ++j) { g4[j] = *((const f32x4*)(ln2_g + l * DM) + lane + 64 * j); b4[j] = *((const f32x4*)(ln2_b + l * DM) + lane + 64 * j); }
                for (int m = gw; m < M; m += NGW) {
                    const int pa = tpos[m * 2], pb = tpos[m * 2 + 1]; const float ga = tgate[m * 2], gb = tgate[m * 2 + 1];
                    const size_t ra = (size_t)T[pa >> 20] * 256 + (pa & 0xfffff), rb = (size_t)T[pb >> 20] * 256 + (pb & 0xfffff);
                    f32x4 v[4];
#pragma unroll
                    for (int j = 0; j < 4; ++j) { const u32x2 ya = *((const u32x2*)(Y + ra * DM) + lane + 64 * j), yb = *((const u32x2*)(Y + rb * DM) + lane + 64 * j);
                        const f32x4 xv = *((const f32x4*)(X + (size_t)m * DM) + lane + 64 * j);
                        v[j][0] = ALPHA * xv[0] + ga * bf_lo(ya.x) + gb * bf_lo(yb.x); v[j][1] = ALPHA * xv[1] + ga * bf_hi(ya.x) + gb * bf_hi(yb.x);
                        v[j][2] = ALPHA * xv[2] + ga * bf_lo(ya.y) + gb * bf_lo(yb.y); v[j][3] = ALPHA * xv[3] + ga * bf_hi(ya.y) + gb * bf_hi(yb.y); }
                    ln_core(v, g4, b4); ln_store(v, X + (size_t)m * DM, nullptr, lane); }
            }
        }
    }
}

extern "C" void kernel_launch(void* const* d_in, const int* in_sizes, int n_in, void* d_out, int out_size, void* d_ws, size_t ws_size, hipStream_t stream) {
    static int grid = 0;
    if (grid == 0) {
        if (n_in != 26 || in_sizes[0] != M * DM || out_size != M * DM || ws_size < WS_END) { fprintf(stderr, "kernel_launch: unexpected shapes (n_in %d, ws %zu < %zu)\n", n_in, ws_size, (size_t)WS_END); grid = -1; return; }
        int dev = 0, cus = 0, per_cu = 0;
        if (hipGetDevice(&dev) != hipSuccess || hipDeviceGetAttribute(&cus, hipDeviceAttributeMultiprocessorCount, dev) != hipSuccess) { grid = -1; return; }
        if (hipFuncSetAttribute((const void*)mega_fwd, hipFuncAttributeMaxDynamicSharedMemorySize, LDS_BYTES) != hipSuccess) { fprintf(stderr, "kernel_launch: hipFuncSetAttribute failed\n"); grid = -1; return; }
        if (hipOccupancyMaxActiveBlocksPerMultiprocessor(&per_cu, (const void*)mega_fwd, NWAVES * 64, LDS_BYTES) != hipSuccess || per_cu < 1) { fprintf(stderr, "kernel_launch: occupancy query says %d\n", per_cu); }
        (void)hipGetLastError();
        grid = cus;
    }
    if (grid < 0) return;
    if (hipMemsetAsync((char*)d_ws + WS_CTL, 0, CTL_ZERO_BYTES, stream) != hipSuccess) return;
    Args a{};
    for (int i = 0; i < 26; ++i) a.in[i] = (const float*)d_in[i];
    a.out = (float*)d_out; a.ws = (unsigned char*)d_ws;
    hipLaunchKernelGGL(mega_fwd, dim3(grid), dim3(NWAVES * 64), LDS_BYTES, stream, a);
}
```

```cpp
#include <hip/hip_runtime.h>
#include <cstdio>
#include <cstdint>
#include <cmath>

constexpr int BATCH = 16, SEQ = 2048, DM = 1024, M = BATCH * SEQ, DEPTH = 2;
constexpr int D_IN = 2048, D_FF = 2816, N_EXP = 8, D_FFE = 3584;
constexpr float LN_EPS = 1e-5f, RMS_EPS = 1e-6f;
constexpr float ALPHA = 1.41421356237309515f;
constexpr float LOG2E = 1.4426950408889634f;
constexpr float EGU_SCALE = 64.f, ED_SCALE = 128.f;
constexpr int NWAVES = 8;
#ifndef DENSE_FP8
#define DENSE_FP8 0
#endif
#ifndef DUP_P0
#define DUP_P0 1
#endif
#ifndef DUP_P1
#define DUP_P1 1
#endif
#ifndef DUP_P2
#define DUP_P2 1
#endif
#ifndef DUP_B
#define DUP_B 1
#endif
#ifndef DUP_C
#define DUP_C 1
#endif
#ifndef DUP_D
#define DUP_D 1
#endif
#ifndef DUP_GU
#define DUP_GU 1
#endif
#ifndef DUP_MOE
#define DUP_MOE 1
#endif

#define GAS __attribute__((address_space(1)))
#define LAS __attribute__((address_space(3)))
typedef unsigned short bf16_t;
typedef short bf16x8 __attribute__((ext_vector_type(8)));
typedef float f32x4 __attribute__((ext_vector_type(4)));
typedef float f32x2 __attribute__((ext_vector_type(2)));
typedef float f32x16 __attribute__((ext_vector_type(16)));
typedef unsigned u32x4 __attribute__((ext_vector_type(4)));
typedef unsigned u32x2 __attribute__((ext_vector_type(2)));
typedef short s16x4 __attribute__((ext_vector_type(4)));
typedef __bf16 bf16x2_t __attribute__((ext_vector_type(2)));
typedef GAS unsigned gu32;

__device__ __forceinline__ unsigned pkbf(float lo, float hi) { f32x2 v = {lo, hi}; bf16x2_t b = __builtin_convertvector(v, bf16x2_t); return __builtin_bit_cast(unsigned, b); }
typedef int i32x4 __attribute__((ext_vector_type(4)));
typedef int i32x8 __attribute__((ext_vector_type(8)));
__device__ __forceinline__ float clamp8(float v) { return __builtin_fminf(__builtin_fmaxf(v, -448.f), 448.f); }
__device__ __forceinline__ unsigned pk4_fp8(float a, float b, float c, float d) { int w = __builtin_amdgcn_cvt_pk_fp8_f32(clamp8(a), clamp8(b), 0, false); w = __builtin_amdgcn_cvt_pk_fp8_f32(clamp8(c), clamp8(d), w, true); return (unsigned)w; }
__device__ __forceinline__ float bf_lo(unsigned w) { return __uint_as_float(w << 16); }
__device__ __forceinline__ float bf_hi(unsigned w) { return __uint_as_float(w & 0xffff0000u); }
__device__ __forceinline__ int lane_id() { int l; asm volatile("v_mbcnt_lo_u32_b32 %0, -1, 0\n\tv_mbcnt_hi_u32_b32 %0, -1, %0" : "=v"(l)); return l; }
template <int K> __device__ __forceinline__ float xor_lane(float v) { return __int_as_float(__builtin_amdgcn_ds_swizzle(__float_as_int(v), (K << 10) | 0x1f)); }
__device__ __forceinline__ float sum_xor32(float v) { auto rr = __builtin_amdgcn_permlane32_swap(__float_as_uint(v), __float_as_uint(v), false, false); return __uint_as_float(rr[0]) + __uint_as_float(rr[1]); }
__device__ __forceinline__ float wave_sum(float v) {
    v += xor_lane<1>(v); v += xor_lane<2>(v); v += xor_lane<4>(v); v += xor_lane<8>(v); v += xor_lane<16>(v);
    return sum_xor32(v);
}

constexpr size_t MiB = 1u << 20;
constexpr size_t WS_CTL = 0, CTL_ZERO_BYTES = 1 * MiB;
constexpr size_t WS_ROPEC = 1 * MiB, WS_ROPES = 1 * MiB + 256 * 1024;
constexpr size_t WS_LTOK = 2 * MiB;
constexpr size_t WS_TPOS = 3 * MiB, WS_TGATE = 3 * MiB + 512 * 1024;
constexpr size_t WS_WIN = 4 * MiB;
constexpr size_t WS_WOUT = 12 * MiB;
constexpr size_t WS_WGU = 16 * MiB;
constexpr size_t WS_WD = 27 * MiB;
constexpr size_t WS_EGU = 33 * MiB;
constexpr size_t WS_ED = 89 * MiB;
constexpr size_t WS_XN = 201 * MiB;
constexpr size_t WS_R = 265 * MiB;
constexpr size_t WS_PJ = WS_R;
constexpr size_t WS_MIX = WS_R + 128 * MiB;
constexpr size_t WS_H = WS_R;
constexpr size_t WS_HC = WS_R;
constexpr size_t WS_Y = WS_R + 112 * MiB;
constexpr size_t WS_END = WS_Y + 132 * MiB;
static_assert(WS_WD + (size_t)DM * D_FF * 2 <= WS_EGU && WS_EGU + (size_t)16 * DM * D_FFE <= WS_ED && WS_ED + (size_t)8 * DM * D_FFE <= WS_XN, "ws map");
constexpr int CW_TMO = 0, CW_BAR = 4096, CW_CNT = 8192, CW_Q = 9216, CW_NRM = 12288;
constexpr int CHUNK_TILES = 128;

constexpr int RING_BYTES = 131072;
constexpr int MISC_OFF = RING_BYTES;
constexpr int LDS_BYTES = 147456;
constexpr int VN_OFF = MISC_OFF + 2048;
static_assert(VN_OFF + 8192 <= LDS_BYTES, "LDS map");

#define XB_TMO      128
#define XB_XCNT(j)  (256  + 64 * (j))
#define XB_XSUB(j)  (1280 + 64 * (j))
#define XB_XGEN(j)  (2304 + 64 * (j))
#define XB_TOP      3328
#define XB_TOPGEN   3392
#define XCD_BAR_WORDS 3456
#define XB_SPIN_CAP (1u << 18)
__device__ __forceinline__ unsigned xb_ld(unsigned* p)              { return __hip_atomic_load(p, __ATOMIC_RELAXED, __HIP_MEMORY_SCOPE_AGENT); }
__device__ __forceinline__ unsigned xb_add(unsigned* p, unsigned v) { return __hip_atomic_fetch_add(p, v, __ATOMIC_RELAXED, __HIP_MEMORY_SCOPE_AGENT); }
__device__ __forceinline__ unsigned xb_xcc_id() { return (unsigned)__builtin_amdgcn_s_getreg((3 << 11) | 20) & 0xFu; }
#define XB_SPIN(cond, bar) do { unsigned _sp = 0; while (cond) { __builtin_amdgcn_s_sleep(1); \
    if ((++_sp & 255u) == 0u) { if (xb_ld(&(bar)[XB_TMO])) break; if (_sp > XB_SPIN_CAP) { atomicAdd(&(bar)[XB_TMO], 1u); break; } } } } while (0)
struct XcdBarrier { unsigned* bar; unsigned x; volatile LAS unsigned* st; };
__device__ __forceinline__ XcdBarrier xcd_barrier_post(unsigned* bar, volatile LAS unsigned* st, bool t0) {
    XcdBarrier b; b.bar = bar; b.x = xb_xcc_id(); b.st = st;
    if (t0) (void)xb_add(&bar[XB_XCNT(b.x)], 1u);
    return b;
}
__device__ __forceinline__ void xcd_barrier_complete(unsigned* bar, unsigned x, unsigned& nloc, unsigned& nx) {
    const unsigned G = gridDim.x * gridDim.y * gridDim.z;
    unsigned sum, cnt, mine, sp = 0u;
    for (;;) {
        sum = 0u; cnt = 0u; mine = 0u;
#pragma unroll
        for (unsigned j = 0; j < 16; ++j) { const unsigned c = xb_ld(&bar[XB_XCNT(j)]); sum += c; cnt += (c > 0u) ? 1u : 0u; mine = (j == x) ? c : mine; }
        if (sum == G) break;
        __builtin_amdgcn_s_sleep(1);
        if ((++sp & 255u) == 0u) { if (xb_ld(&bar[XB_TMO])) break; if (sp > XB_SPIN_CAP) { atomicAdd(&bar[XB_TMO], 1u); break; } }
    }
    nloc = mine > 0u ? mine : 1u; nx = cnt > 0u ? cnt : 1u;
}
__device__ __forceinline__ void xcd_barrier(const XcdBarrier& b, bool t0) {
    asm volatile("s_waitcnt vmcnt(0)" ::: "memory");
    __syncthreads();
    if (t0) {
        unsigned* bar = b.bar; asm volatile("" : "+s"(bar));
        __builtin_amdgcn_s_waitcnt(0);
        unsigned nloc = b.st[0], nx = b.st[1];
        unsigned bx = b.x; asm volatile("" : "+s"(bx));
        if (nloc == 0u) { xcd_barrier_complete(bar, bx, nloc, nx); b.st[0] = nloc; b.st[1] = nx; }
        const unsigned old = xb_add(&bar[XB_XSUB(bx)], 1u);
        const unsigned gen = old / nloc;
        if (old + 1u == (gen + 1u) * nloc) {
            __builtin_amdgcn_fence(__ATOMIC_RELEASE, "agent");
            asm volatile("s_waitcnt vmcnt(0)" ::: "memory");
            const unsigned og = xb_add(&bar[XB_TOP], 1u);
            const unsigned tg = og / nx;
            if (og + 1u == (tg + 1u) * nx) xb_add(&bar[XB_TOPGEN], 1u);
            else XB_SPIN(xb_ld(&bar[XB_TOPGEN]) == tg, bar);
            __builtin_amdgcn_fence(__ATOMIC_ACQUIRE, "agent");
            xb_add(&bar[XB_XGEN(bx)], 1u);
            asm volatile("s_waitcnt vmcnt(0)" ::: "memory");
        } else {
            XB_SPIN(xb_ld(&bar[XB_XGEN(bx)]) == gen, bar);
            __builtin_amdgcn_fence(__ATOMIC_ACQUIRE, "agent");
            asm volatile("s_waitcnt vmcnt(0)" ::: "memory");
        }
    }
    __syncthreads();
}

namespace pg8 {
constexpr int BM = 256, BK = 64, HALF = 128, HTB = HALF * BK * 2, STAGE_BYTES = 8 * HTB, NXCD = 8, WGM = 8;
__device__ __forceinline__ int lds_byte(int r, int c) { const int st = (r >> 4) * 2 + (c >> 5), rr = r & 15, cc = c & 31, ob = rr * 64 + cc * 2; return st * 1024 + (ob ^ (((ob >> 9) & 1) << 5)); }
__device__ __forceinline__ void stage_rc(int b, int& R, int& C) { const int st = b / 1024, sb = b % 1024, swz = sb ^ (((sb >> 9) & 1) << 5); R = (st >> 1) * 16 + swz / 64; C = (st & 1) * 32 + (swz % 64) / 2; }
__device__ __forceinline__ int perm32(int rho) { const int n = rho >> 4, i = rho & 15; return 8 * (i >> 2) + 4 * n + (i & 3); }

struct Unit { int pm, pn, e, p0, cnt; };
struct Gemm { const void* A; const void* Bt; int K; size_t estride; };

__device__ __forceinline__ bool grid_order(int i, int G, int c, int nM, int nN, int& pm, int& pn) {
    const int nwg = nM * nN; const long L = (long)i * G + c; if (L >= nwg) return false;
    int wgid = (int)L; { const int q = nwg / NXCD, r = nwg % NXCD, xcd = wgid % NXCD, off = wgid / NXCD; wgid = (xcd < r ? xcd * (q + 1) : r * (q + 1) + (xcd - r) * q) + off; }
    const int nig = WGM * nN, gid = wgid / nig, fm = gid * WGM, gsz = (nM - fm) < WGM ? (nM - fm) : WGM;
    pm = fm + ((wgid % nig) % gsz); pn = (wgid % nig) / gsz; return true;
}
struct StaticOrder {
    int nM, nN, G, c;
    __device__ void init(int Mrows, int N, int G_, int c_) { nM = Mrows / BM; nN = N / BM; G = G_; c = c_; }
    __device__ __forceinline__ bool next(int i, Unit& u) const { u.e = 0; u.p0 = 0; u.cnt = 0; return grid_order(i, G, c, nM, nN, u.pm, u.pn); }
    __device__ __forceinline__ int arow(const Unit& u, int r) const { return u.pm * BM + r; }
};

template <class Epi, class Sched, bool ALIGN_EPI, bool GATHER = false, int ES = 2>
__device__ __forceinline__ void gemm_phase(LAS unsigned char* lds, const Gemm g, const Sched& S, const Epi& E, int wave0) {
    int tid = wave0 * 64 + lane_id(); asm volatile("" : "+v"(tid));
    const int wid = __builtin_amdgcn_readfirstlane(tid >> 6), lane = tid & 63, wr = wid >> 2, wc = wid & 3, fr = lane & 15, fq = lane >> 4;
    const int K = g.K, nt = K * ES / 128;
    unsigned voffA, voffB;
    { int R, C; stage_rc(tid * 16, R, C); const int Rb = Epi::PERM ? ((R & ~31) + perm32(R & 31)) : R; voffA = (unsigned)(R * K * ES + C * 2); voffB = (unsigned)(Rb * K * ES + C * 2); }
    const unsigned pstep = (unsigned)(64 * K * ES);
    const unsigned kstep = 128u;
    const unsigned hstep = (unsigned)(HALF * K * ES);
    const unsigned tstep = 2u * hstep;
    const unsigned ldsw = (unsigned)wid * 1024u;
    const unsigned lp = (unsigned)lds_byte(fr, fq * 8); const unsigned aS = (unsigned)wr * 8192u, bS = (unsigned)wc * 4096u;
#define PG8_ADDR(soff) ({ unsigned _t = lp; asm volatile("" : "+v"(_t)); _t + (soff); })
    const __amdgpu_buffer_rsrc_t rA = __builtin_amdgcn_make_buffer_rsrc(const_cast<void*>(g.A), 0, 0x7fffffff, 0x00020000);
    const __amdgpu_buffer_rsrc_t rB = __builtin_amdgcn_make_buffer_rsrc(const_cast<void*>(g.Bt), 0, 0x7fffffff, 0x00020000);
#define PG8_SA(b, h) (((b) * 2 + (h)) * HTB)
#define PG8_SB(b, h) ((4 + (b) * 2 + (h)) * HTB)
#define PG8_STAGE(bufoff, rsrc, soff, voff) do { _Pragma("unroll") for (int _i = 0; _i < 2; ++_i) \
        __builtin_amdgcn_raw_ptr_buffer_load_lds(rsrc, (LAS unsigned*)(lds + (bufoff) + ldsw + _i * 8192), 16, (voff), (int)((soff) + _i * pstep), 0, 0); } while (0)
#define PG8_STAGE_G(bufoff, rsrc, soff, V) do { _Pragma("unroll") for (int _i = 0; _i < 2; ++_i) \
        __builtin_amdgcn_raw_ptr_buffer_load_lds(rsrc, (LAS unsigned*)(lds + (bufoff) + ldsw + _i * 8192), 16, (V)[_i], (int)(soff), 0, 0); } while (0)
#define PG8_STAGE_A(bufoff, uo, kb, h, V) do { if constexpr (GATHER) { PG8_STAGE_G(bufoff, rA, (kb), (V)[h]); } else { PG8_STAGE(bufoff, rA, (uo) + (kb) + (h) * hstep, voffA); } } while (0)
#define PG8_AOFF(dst, u) do { const int _t = wid * 64 + lane_id(); _Pragma("unroll") for (int _i = 0; _i < 2; ++_i) { int _R, _C; stage_rc(_t * 16 + _i * 8192, _R, _C); _Pragma("unroll") for (int _h = 0; _h < 2; ++_h) \
        dst[_h][_i] = (unsigned)S.arow(u, _R + _h * HALF) * (unsigned)(K * ES) + (unsigned)_C * 2u; } } while (0)
#define PG8_FR(p) (*(const LAS bf16x8*)(p))
#define PG8_FR8(p) __builtin_shufflevector(__builtin_bit_cast(i32x4, PG8_FR(p)), __builtin_bit_cast(i32x4, PG8_FR((p) + 1024)), 0, 1, 2, 3, 4, 5, 6, 7)
#define PG8_LDA(dst, b, h) do { const unsigned aoff = PG8_ADDR(aS); _Pragma("unroll") for (int m = 0; m < 4; ++m) { if constexpr (ES == 2) { _Pragma("unroll") for (int k = 0; k < 2; ++k) dst[m][k] = PG8_FR(lds + PG8_SA(b, h) + aoff + m * 2048 + k * 1024); } \
        else dst##8[m] = PG8_FR8(lds + PG8_SA(b, h) + aoff + m * 2048); } } while (0)
#define PG8_LDB(dst, b, h) do { const unsigned boff = PG8_ADDR(bS); _Pragma("unroll") for (int n = 0; n < 2; ++n) { if constexpr (ES == 2) { _Pragma("unroll") for (int k = 0; k < 2; ++k) dst[n][k] = PG8_FR(lds + PG8_SB(b, h) + boff + n * 2048 + k * 1024); } \
        else dst##8[n] = PG8_FR8(lds + PG8_SB(b, h) + boff + n * 2048); } } while (0)
#define PG8_MMA(ai, bj, At, Bt) do { __builtin_amdgcn_s_setprio(1); _Pragma("unroll") for (int m = 0; m < 4; ++m) _Pragma("unroll") for (int n = 0; n < 2; ++n) { \
        if constexpr (ES == 2) { _Pragma("unroll") for (int k = 0; k < 2; ++k) acc[ai][bj][m][n] = __builtin_amdgcn_mfma_f32_16x16x32_bf16(Bt[n][k], At[m][k], acc[ai][bj][m][n], 0, 0, 0); } \
        else { asm volatile("v_mfma_f32_16x16x128_f8f6f4 %0, %1, %2, %0" : "+v"(acc[ai][bj][m][n]) : "v"(Bt##8[n]), "v"(At##8[m])); } } \
        __builtin_amdgcn_s_setprio(0); } while (0)
#define PG8_WAIT_V(n) asm volatile("s_waitcnt vmcnt(" #n ")" ::: "memory")
#define PG8_WAIT_L(n) asm volatile("s_waitcnt lgkmcnt(" #n ")" ::: "memory")
#define PG8_BAR __builtin_amdgcn_s_barrier()
#define PG8_SCHED __builtin_amdgcn_sched_barrier(0)
    Unit cur, nxt; int ui = 0;
    if (!S.next(0, cur)) return;
    f32x4 acc[2][2][4][2];
#pragma unroll
    for (int a = 0; a < 2; ++a)
#pragma unroll
        for (int b = 0; b < 2; ++b)
#pragma unroll
            for (int m = 0; m < 4; ++m)
#pragma unroll
                for (int n = 0; n < 2; ++n) acc[a][b][m][n] = (f32x4){0.f, 0.f, 0.f, 0.f};
    bf16x8 At[4][2], B0[2][2], B1[2][2];
    i32x8 At8[4], B08[2], B18[2];
    unsigned vc[2][2];
    LAS u32x4* vstash = (LAS u32x4*)(lds + VN_OFF - 0) + tid;
    if constexpr (GATHER) { PG8_AOFF(vc, cur); }
    unsigned cA = GATHER ? 0u : (unsigned)S.arow(cur, 0) * (unsigned)(K * ES);
    unsigned cB = (unsigned)cur.e * (unsigned)g.estride + (unsigned)cur.pn * tstep;
    PG8_STAGE(PG8_SB(0, 0), rB, cB, voffB); PG8_STAGE(PG8_SB(0, 1), rB, cB + hstep, voffB); PG8_STAGE_A(PG8_SA(0, 0), cA, 0u, 0, vc); PG8_STAGE_A(PG8_SA(0, 1), cA, 0u, 1, vc);
    if (wr == 1) PG8_BAR;
    PG8_WAIT_V(2); PG8_BAR;
    PG8_STAGE(PG8_SB(1, 0), rB, cB + kstep, voffB); PG8_STAGE_A(PG8_SA(1, 0), cA, kstep, 0, vc); PG8_STAGE(PG8_SB(1, 1), rB, cB + hstep + kstep, voffB);
    PG8_WAIT_V(6); PG8_BAR;
    for (;;) {
        const bool has_next = S.next(ui + 1, nxt);
        if constexpr (GATHER) { unsigned vn[2][2];
            if (has_next) { PG8_AOFF(vn, nxt); } else {
#pragma unroll
                for (int h = 0; h < 2; ++h)
#pragma unroll
                    for (int i = 0; i < 2; ++i) vn[h][i] = vc[h][i]; }
            *vstash = (u32x4){vn[0][0], vn[0][1], vn[1][0], vn[1][1]}; }
        const unsigned nA = GATHER ? 0u : (has_next ? (unsigned)S.arow(nxt, 0) * (unsigned)(K * ES) : cA);
        const unsigned nB = has_next ? (unsigned)nxt.e * (unsigned)g.estride + (unsigned)nxt.pn * tstep : cB;
        for (int t = 0; t < nt; t += 2) {
            const bool last = (t == nt - 2);
            const unsigned k1 = (unsigned)(t + 1) * kstep;
            const unsigned k2 = last ? 0u : (unsigned)(t + 2) * kstep, k3 = k2 + kstep;
            const unsigned a2 = last ? nA : cA;
            const unsigned b2 = last ? nB : cB + (unsigned)(t + 2) * kstep, b3 = b2 + kstep;
            PG8_LDB(B0, 0, 0); PG8_LDB(B1, 0, 1); PG8_SCHED; PG8_LDA(At, 0, 0); PG8_STAGE_A(PG8_SA(1, 1), cA, k1, 1, vc);
            if constexpr (GATHER) { if (last) { const u32x4 vv = *vstash; vc[0][0] = vv[0]; vc[0][1] = vv[1]; vc[1][0] = vv[2]; vc[1][1] = vv[3]; } }
            PG8_WAIT_V(8); PG8_WAIT_L(0); PG8_BAR; PG8_MMA(0, 0, At, B0); PG8_MMA(0, 1, At, B1); PG8_BAR; PG8_SCHED;
            PG8_LDA(At, 0, 1); PG8_STAGE(PG8_SB(0, 0), rB, b2, voffB); PG8_STAGE(PG8_SB(0, 1), rB, b2 + hstep, voffB); PG8_STAGE_A(PG8_SA(0, 0), a2, k2, 0, vc);
            PG8_WAIT_V(8); PG8_WAIT_L(0); PG8_BAR; PG8_MMA(1, 0, At, B0); PG8_MMA(1, 1, At, B1); PG8_BAR; PG8_SCHED;
            PG8_LDB(B0, 1, 0); PG8_LDB(B1, 1, 1); PG8_SCHED; PG8_LDA(At, 1, 0); PG8_STAGE_A(PG8_SA(0, 1), a2, k2, 1, vc);
            PG8_WAIT_V(8); PG8_WAIT_L(0); PG8_BAR; PG8_MMA(0, 0, At, B0); PG8_MMA(0, 1, At, B1); PG8_BAR; PG8_SCHED;
            PG8_LDA(At, 1, 1); PG8_STAGE(PG8_SB(1, 0), rB, b3, voffB); PG8_STAGE(PG8_SB(1, 1), rB, b3 + hstep, voffB); PG8_STAGE_A(PG8_SA(1, 0), a2, k3, 0, vc);
            PG8_WAIT_V(8); PG8_WAIT_L(0); PG8_BAR; PG8_MMA(1, 0, At, B0); PG8_MMA(1, 1, At, B1); PG8_BAR; PG8_SCHED;
        }
        if constexpr (ALIGN_EPI) { if (wr == 0) PG8_BAR; }
        if constexpr (ES == 1) asm volatile("s_nop 15\n\ts_nop 15" ::: "memory");
        { const int l2 = lane_id(); E(acc, cur, wr, wc, l2 & 15, l2 >> 4); }
        if (!has_next) break;
#pragma unroll
        for (int a = 0; a < 2; ++a)
#pragma unroll
            for (int b = 0; b < 2; ++b)
#pragma unroll
                for (int m = 0; m < 4; ++m)
#pragma unroll
                    for (int n = 0; n < 2; ++n) acc[a][b][m][n] = (f32x4){0.f, 0.f, 0.f, 0.f};
        cur = nxt; cA = nA; cB = nB; ++ui;
        if constexpr (ALIGN_EPI) { if (wr == 1) PG8_BAR; }
    }
    PG8_WAIT_V(0);
    if constexpr (!ALIGN_EPI) { if (wr == 0) PG8_BAR; }
    PG8_BAR;
#undef PG8_SA
#undef PG8_SB
#undef PG8_STAGE
#undef PG8_STAGE_G
#undef PG8_STAGE_A
#undef PG8_AOFF
#undef PG8_LDA
#undef PG8_LDB
#undef PG8_MMA
#undef PG8_FR
#undef PG8_ADDR
#undef PG8_FR8
#undef PG8_WAIT_V
#undef PG8_WAIT_L
#undef PG8_BAR
#undef PG8_SCHED
}

struct EpiProj {
    static constexpr bool PERM = true;
    bf16_t* PJ; const float* qn; const float* kn; const float* ropec; const float* ropes; unsigned* nrm;
    __device__ __forceinline__ void operator()(const f32x4 (&acc)[2][2][4][2], const Unit& u, int wr, int wc, int fr, int fq) const {
        const int row0 = u.pm * BM + wr * 64 + fr, pn = u.pn;
        const bool htype = (pn == 1) || (pn == 2);
        const bool roped = (pn == 1) || (pn == 2 && wc < 2);
        if (!htype) {
            const float sc = (pn == 3) ? 0.17677669529663687f * LOG2E : (pn == 6 ? 0.125f * LOG2E : 1.f);
            const int col0 = pn * BM + wc * 32 + 8 * fq;
            float nmax[2] = {0.f, 0.f};
#pragma unroll
            for (int ai = 0; ai < 2; ++ai)
#pragma unroll
                for (int m = 0; m < 4; ++m) { bf16_t* rowp = PJ + (size_t)(row0 + ai * HALF + m * 16) * D_IN + col0;
#pragma unroll
                    for (int bj = 0; bj < 2; ++bj) { const f32x4 v0 = acc[ai][bj][m][0] * sc, v1 = acc[ai][bj][m][1] * sc;
                        u32x4 w; w.x = pkbf(v0[0], v0[1]); w.y = pkbf(v0[2], v0[3]); w.z = pkbf(v1[0], v1[1]); w.w = pkbf(v1[2], v1[3]);
                        *(u32x4*)(rowp + bj * HALF) = w;
                        if (pn == 3 || pn == 4) { float ss = (v0[0] * v0[0] + v0[1] * v0[1]) + (v0[2] * v0[2] + v0[3] * v0[3]) + (v1[0] * v1[0] + v1[1] * v1[1]) + (v1[2] * v1[2] + v1[3] * v1[3]);
                            ss += xor_lane<16>(ss); ss = sum_xor32(ss); nmax[bj] = __builtin_fmaxf(nmax[bj], ss); } } }
            if (pn == 3 || pn == 4) {
#pragma unroll
                for (int bj = 0; bj < 2; ++bj) { float v = nmax[bj]; v = __builtin_fmaxf(v, xor_lane<1>(v)); v = __builtin_fmaxf(v, xor_lane<2>(v)); v = __builtin_fmaxf(v, xor_lane<4>(v)); v = __builtin_fmaxf(v, xor_lane<8>(v));
                    if (fr == 0 && fq == 0) { const int b = (u.pm * BM) / SEQ, h = 2 * bj + (wc >> 1), c = wc & 1;
                        __hip_atomic_fetch_max(nrm + ((pn - 3) * 16 + b) * 8 + h * 2 + c, __float_as_uint(v), __ATOMIC_RELAXED, __HIP_MEMORY_SCOPE_AGENT); } }
            }
        } else {
            const int colh = pn * BM + wc * 64 + 8 * fq;
            if (!roped) {
#pragma unroll
                for (int ai = 0; ai < 2; ++ai)
#pragma unroll
                    for (int m = 0; m < 4; ++m) { bf16_t* rowp = PJ + (size_t)(row0 + ai * HALF + m * 16) * D_IN + colh;
#pragma unroll
                        for (int bj = 0; bj < 2; ++bj) { const f32x4 v0 = acc[ai][bj][m][0], v1 = acc[ai][bj][m][1];
                            u32x4 w; w.x = pkbf(v0[0], v0[1]); w.y = pkbf(v0[2], v0[3]); w.z = pkbf(v1[0], v1[1]); w.w = pkbf(v1[2], v1[3]);
                            *(u32x4*)(rowp + bj * 32) = w; } }
            } else {
                const float* nw = (pn == 1) ? qn : kn; const float osc = (pn == 1) ? 0.125f * LOG2E : 1.f;
                f32x4 w1[2], w2[2];
#pragma unroll
                for (int bj = 0; bj < 2; ++bj) { w1[bj] = *(const f32x4*)(nw + 32 * bj + 4 * fq); w2[bj] = *(const f32x4*)(nw + 32 * bj + 16 + 4 * fq); }
#pragma unroll
                for (int ai = 0; ai < 2; ++ai)
#pragma unroll
                    for (int m = 0; m < 4; ++m) {
                        const int row = row0 + ai * HALF + m * 16, s = row & (SEQ - 1);
                        float ss = 0.f;
#pragma unroll
                        for (int bj = 0; bj < 2; ++bj)
#pragma unroll
                            for (int n = 0; n < 2; ++n) { const f32x4 x = acc[ai][bj][m][n]; ss += (x[0] * x[0] + x[1] * x[1]) + (x[2] * x[2] + x[3] * x[3]); }
                        ss += xor_lane<16>(ss); ss = sum_xor32(ss);
                        const float rinv = 1.0f / sqrtf(ss * (1.f / 64.f) + RMS_EPS);
                        bf16_t* rowp = PJ + (size_t)row * D_IN + colh;
#pragma unroll
                        for (int bj = 0; bj < 2; ++bj) {
                            const f32x4 c = *(const f32x4*)(ropec + s * 32 + bj * 16 + 4 * fq), sn = *(const f32x4*)(ropes + s * 32 + bj * 16 + 4 * fq);
                            const f32x4 x1 = acc[ai][bj][m][0] * rinv * w1[bj], x2 = acc[ai][bj][m][1] * rinv * w2[bj];
                            const f32x4 o1 = (x1 * c - x2 * sn) * osc, o2 = (x2 * c + x1 * sn) * osc;
                            u32x4 w; w.x = pkbf(o1[0], o1[1]); w.y = pkbf(o1[2], o1[3]); w.z = pkbf(o2[0], o2[1]); w.w = pkbf(o2[2], o2[3]);
                            *(u32x4*)(rowp + bj * 32) = w; }
                    }
            }
        }
    }
};
struct EpiResid {
    static constexpr bool PERM = false;
    float* X; float sc;
    __device__ __forceinline__ void operator()(const f32x4 (&acc)[2][2][4][2], const Unit& u, int wr, int wc, int fr, int fq) const {
        const int row0 = u.pm * BM + wr * 64 + fr, col0 = u.pn * BM + wc * 32 + 4 * fq;
#pragma unroll
        for (int ai = 0; ai < 2; ++ai)
#pragma unroll
            for (int m = 0; m < 4; ++m) { float* rowp = X + (size_t)(row0 + ai * HALF + m * 16) * DM + col0;
#pragma unroll
                for (int bj = 0; bj < 2; ++bj)
#pragma unroll
                    for (int n = 0; n < 2; ++n) { f32x4* p = (f32x4*)(rowp + bj * HALF + n * 16); *p = *p * ALPHA + acc[ai][bj][m][n] * sc; } }
    }
};
template <bool OUT8>
struct EpiSwiGLU {
    static constexpr bool PERM = true;
    void* H; int ldh; int rt0;
    __device__ __forceinline__ void operator()(const f32x4 (&acc)[2][2][4][2], const Unit& u, int wr, int wc, int fr, int fq) const {
        const int row0 = (u.pm - rt0) * BM + wr * 64 + fr, col0 = u.pn * HALF + wc * 32 + 8 * fq;
#pragma unroll
        for (int ai = 0; ai < 2; ++ai)
#pragma unroll
            for (int m = 0; m < 4; ++m) {
                float o[8];
#pragma unroll
                for (int n = 0; n < 2; ++n)
#pragma unroll
                    for (int j = 0; j < 4; ++j) { const float isc = OUT8 ? 1.0f / EGU_SCALE : 1.0f; const float gv = acc[ai][0][m][n][j] * isc, uv = acc[ai][1][m][n][j] * isc;
                        o[4 * n + j] = gv * __builtin_amdgcn_rcpf(1.0f + __builtin_amdgcn_exp2f(-gv * LOG2E)) * uv; }
                if constexpr (OUT8) { u32x2 w; w.x = pk4_fp8(o[0], o[1], o[2], o[3]); w.y = pk4_fp8(o[4], o[5], o[6], o[7]);
                    *(u32x2*)((unsigned char*)H + (size_t)(row0 + ai * HALF + m * 16) * ldh + col0) = w; }
                else { u32x4 w; w.x = pkbf(o[0], o[1]); w.y = pkbf(o[2], o[3]); w.z = pkbf(o[4], o[5]); w.w = pkbf(o[6], o[7]);
                    *(u32x4*)((bf16_t*)H + (size_t)(row0 + ai * HALF + m * 16) * ldh + col0) = w; } }
    }
};
struct EpiBf16 {
    static constexpr bool PERM = true;
    bf16_t* O; int ldc; float sc;
    __device__ __forceinline__ void operator()(const f32x4 (&acc)[2][2][4][2], const Unit& u, int wr, int wc, int fr, int fq) const {
        const int row0 = u.pm * BM + wr * 64 + fr, col0 = u.pn * BM + wc * 32 + 8 * fq;
#pragma unroll
        for (int ai = 0; ai < 2; ++ai)
#pragma unroll
            for (int m = 0; m < 4; ++m) { bf16_t* rowp = O + (size_t)(row0 + ai * HALF + m * 16) * ldc + col0;
#pragma unroll
                for (int bj = 0; bj < 2; ++bj) { const f32x4 v0 = acc[ai][bj][m][0] * sc, v1 = acc[ai][bj][m][1] * sc;
                    u32x4 w; w.x = pkbf(v0[0], v0[1]); w.y = pkbf(v0[2], v0[3]); w.z = pkbf(v1[0], v1[1]); w.w = pkbf(v1[2], v1[3]);
                    *(u32x4*)(rowp + bj * HALF) = w; } }
    }
};
}

struct MoeTable { volatile LAS int* T; };
__device__ __forceinline__ int moe_expert_of(const MoeTable& t, int rt) { int e = 0;
#pragma unroll
    for (int j = 1; j < 8; ++j) e += (rt >= t.T[j]) ? 1 : 0;
    return __builtin_amdgcn_readfirstlane(e); }
struct MoeOrder {
    MoeTable tab; int rt_lo, nM, nN, G, c; const int* ltok; bool gather;
    __device__ __forceinline__ bool next(int i, pg8::Unit& u) const {
        int pm, pn; if (!pg8::grid_order(i, G, c, nM, nN, pm, pn)) return false;
        u.pm = rt_lo + pm; u.pn = pn; u.e = moe_expert_of(tab, u.pm); u.p0 = __builtin_amdgcn_readfirstlane((u.pm - tab.T[u.e]) * 256); u.cnt = __builtin_amdgcn_readfirstlane(tab.T[16 + u.e]); return true; }
    __device__ __forceinline__ int arow(const pg8::Unit& u, int r) const {
        if (gather) { const int p = u.p0 + r; return p < u.cnt ? ltok[u.e * M + p] : 0; }
        return (u.pm - rt_lo) * 256 + r; }
};

namespace att {
constexpr int PJP = D_IN, MXP = DM, SLOTB = 8192;
constexpr int NSLOT = 3;
constexpr int L_K = 0, L_V = NSLOT * SLOTB, L_WS = 2 * NSLOT * SLOTB, L_OST = L_WS + 8 * 512, OST_W = 32 * 68 * 4, L_BYTES = L_OST + 8 * OST_W;
static_assert(L_BYTES <= RING_BYTES, "attention scratch");
constexpr float THR = 8.0f;
__device__ __forceinline__ int crow(int r, int hi) { return (r & 3) + 8 * (r >> 2) + 4 * hi; }
__device__ __forceinline__ void glds16(const void* gsrc, unsigned lds_dst) { unsigned keep;
    asm volatile("s_mov_b32 %0, m0\n\ts_mov_b32 m0, %2\n\ts_nop 0\n\tglobal_load_lds_dwordx4 %1, off\n\ts_mov_b32 m0, %0" : "=&s"(keep) : "v"(gsrc), "s"(lds_dst) : "memory"); }
#define ATT_MX3(a, b, c) __builtin_fmaxf(__builtin_fmaxf((a), (b)), (c))
__device__ __forceinline__ float rowmax(const f32x16& p0, const f32x16& p1) {
    float a = ATT_MX3(p0[0], p0[1], p1[0]), b = ATT_MX3(p0[2], p0[3], p1[1]); a = ATT_MX3(a, p1[2], p1[3]);
#pragma unroll
    for (int r = 4; r < 16; r += 4) { a = ATT_MX3(a, p0[r], p0[r + 1]); b = ATT_MX3(b, p0[r + 2], p0[r + 3]); a = ATT_MX3(a, p1[r], p1[r + 1]); b = ATT_MX3(b, p1[r + 2], p1[r + 3]); }
    float m = __builtin_fmaxf(a, b); auto rr = __builtin_amdgcn_permlane32_swap(__float_as_uint(m), __float_as_uint(m), false, false);
    return __builtin_fmaxf(__uint_as_float(rr[0]), __uint_as_float(rr[1])); }
template <int D0, int NS>
__device__ __forceinline__ void qkt(f32x16& p0, f32x16& p1, const LAS unsigned char* Kslot, const bf16x8* qr, const f32x16& cinit, int r32, int hi) {
    const LAS unsigned char* kb = Kslot + hi * 1024 + r32 * 16;
#pragma unroll
    for (int s = 0; s < NS; ++s) { const int d0 = D0 + s;
        const bf16x8 b0 = *(const LAS bf16x8*)(kb + d0 * 2048), b1 = *(const LAS bf16x8*)(kb + d0 * 2048 + 512);
        if (s == 0) { p0 = __builtin_amdgcn_mfma_f32_32x32x16_bf16(b0, qr[d0], cinit, 0, 0, 0); p1 = __builtin_amdgcn_mfma_f32_32x32x16_bf16(b1, qr[d0], cinit, 0, 0, 0); }
        else { p0 = __builtin_amdgcn_mfma_f32_32x32x16_bf16(b0, qr[d0], p0, 0, 0, 0); p1 = __builtin_amdgcn_mfma_f32_32x32x16_bf16(b1, qr[d0], p1, 0, 0, 0); } }
}
__device__ __forceinline__ void pv(f32x16* o, int vb, bf16x8 pa0, bf16x8 pa1, bf16x8 pa2, bf16x8 pa3) {
#pragma unroll
    for (int d0 = 0; d0 < 2; ++d0) { s16x4 lo[4], hi[4];
#pragma unroll
        for (int ks = 0; ks < 4; ++ks) {
            asm volatile("ds_read_b64_tr_b16 %0,%1 offset:%c2" : "=&v"(lo[ks]) : "v"(vb), "i"(d0 * 4096 + ks * 1024) : "memory");
            asm volatile("ds_read_b64_tr_b16 %0,%1 offset:%c2" : "=&v"(hi[ks]) : "v"(vb), "i"(d0 * 4096 + ks * 1024 + 512) : "memory"); }
        asm volatile("s_waitcnt lgkmcnt(0)" ::: "memory"); __builtin_amdgcn_sched_barrier(0);
#define ATT_PK(k) (bf16x8){lo[k][0], lo[k][1], lo[k][2], lo[k][3], hi[k][0], hi[k][1], hi[k][2], hi[k][3]}
        o[d0] = __builtin_amdgcn_mfma_f32_32x32x16_bf16(pa0, ATT_PK(0), o[d0], 0, 0, 0);
        o[d0] = __builtin_amdgcn_mfma_f32_32x32x16_bf16(pa1, ATT_PK(1), o[d0], 0, 0, 0);
        o[d0] = __builtin_amdgcn_mfma_f32_32x32x16_bf16(pa2, ATT_PK(2), o[d0], 0, 0, 0);
        o[d0] = __builtin_amdgcn_mfma_f32_32x32x16_bf16(pa3, ATT_PK(3), o[d0], 0, 0, 0);
#undef ATT_PK
    }
}
struct Par { float slope2; float sink2; float lam; float oscale; const float* subln; int dcut; };
template <int VAR>
__device__ __forceinline__ void unit(int b, int h, int qb, const bf16_t* PJ, bf16_t* MIX, LAS unsigned char* shm, const Par P, int wave0) {
    constexpr int NC = (VAR == 1) ? 2 : 1;
    constexpr int QC = VAR == 0 ? 256 : (VAR == 1 ? 768 : 1536), KC = VAR == 0 ? 512 : (VAR == 1 ? 1024 : 1792), VC = VAR == 0 ? 640 : (VAR == 1 ? 1280 : 1920), OC = VAR == 0 ? 256 : (VAR == 1 ? 512 : 768);
    int tid = wave0 * 64 + lane_id(); asm volatile("" : "+v"(tid));
    const int lane = tid & 63, r32 = lane & 31, hi = lane >> 5; const int wid = __builtin_amdgcn_readfirstlane(tid >> 6);
    const long rowbase = (long)b * SEQ; const int q0 = qb * 256;
    const int kvh = (VAR == 1) ? h : (h >> 1);
    const bf16_t* Qw = PJ + (rowbase + q0 + wid * 32) * PJP + QC + h * 64;
    const bf16_t* Kh = PJ + rowbase * PJP + KC + kvh * 64; const bf16_t* Vh = PJ + rowbase * PJP + VC + kvh * 64;
    const unsigned lds0 = (unsigned)(uintptr_t)shm;
    LAS float* wsf = (LAS float*)(shm + L_WS) + wid * 128;
    const bf16_t* ksrc = Kh + (long)lane * PJP + wid * 8;
    const bf16_t* vsrc = Vh + (long)(16 * (wid & 3) + (lane >> 2)) * PJP + (wid >> 2) * 32 + (lane & 3) * 8;
    const unsigned kdst = lds0 + L_K + wid * 1024, vdst = lds0 + L_V + wid * 1024;
#define ATT_DMA_K(t, so) glds16(ksrc + (long)(t) * 64 * PJP, (unsigned)__builtin_amdgcn_readfirstlane(kdst + (so)))
#define ATT_DMA_V(t, so) glds16(vsrc + (long)(t) * 64 * PJP, (unsigned)__builtin_amdgcn_readfirstlane(vdst + (so)))
    const int vb0 = (int)(lds0 + L_V) + ((lane >> 4) & 1) * 32 + (lane & 3) * 8 + (4 * hi + ((lane & 15) >> 2)) * 64;
    int t_lo = 0, t_hi = 31;
    if (VAR == 2) { t_lo = q0 / 64 - 2; if (t_lo < 0) t_lo = 0; t_hi = q0 / 64 + 5; if (t_hi > 31) t_hi = 31; }
    if (VAR == 1) { t_lo = (q0 - P.dcut) >> 6; if (t_lo < 0) t_lo = 0; t_hi = (q0 + 255 + P.dcut) >> 6; if (t_hi > 31) t_hi = 31; }
    bf16x8 qr[4];
#pragma unroll
    for (int d0 = 0; d0 < 4; ++d0) qr[d0] = *reinterpret_cast<const bf16x8*>(&Qw[(long)r32 * PJP + d0 * 16 + hi * 8]);
    ATT_DMA_K(t_lo, 0); ATT_DMA_V(t_lo, 0);
    if (t_lo < t_hi) { ATT_DMA_K(t_lo + 1, SLOTB); ATT_DMA_V(t_lo + 1, SLOTB); }
    float mh[NC], lsum[NC]; f32x16 o[NC][2];
    float zf = 0.f; asm volatile("" : "+v"(zf));
#pragma unroll
    for (int c = 0; c < NC; ++c) { mh[c] = (VAR == 2) ? P.sink2 : 0.f; lsum[c] = (VAR == 2 && hi == 0) ? 1.f : 0.f;
#pragma unroll
        for (int r = 0; r < 16; ++r) { o[c][0][r] = zf; o[c][1][r] = zf; } }
    const int qpos = q0 + wid * 32 + r32, qw = q0 + wid * 32;
    bool started = false;
    int so = 0, so2 = 2 * SLOTB;
    for (int t = t_lo; t <= t_hi; ++t) {
        if (t < t_hi) asm volatile("s_waitcnt vmcnt(2) lgkmcnt(0)\n\ts_barrier" ::: "memory"); else asm volatile("s_waitcnt vmcnt(0) lgkmcnt(0)\n\ts_barrier" ::: "memory");
        if (t + 2 <= t_hi) { ATT_DMA_K(t + 2, so2); ATT_DMA_V(t + 2, so2); }
        bool rel = true;
        if (VAR == 2) rel = (64 * t + 63 >= qw - 128) && (64 * t <= qw + 31 + 128);
        if (VAR == 1) rel = (64 * t + 63 >= qw - P.dcut) && (64 * t <= qw + 31 + P.dcut);
        if (rel) {
            const bool first = (VAR != 2) && !started; started = true;
#pragma unroll
            for (int c = 0; c < NC; ++c) {
                f32x16 cinit;
#pragma unroll
                for (int r = 0; r < 16; ++r) cinit[r] = -mh[c];
                f32x16 p0, p1;
                if (VAR == 1) { if (c == 0) qkt<0, 2>(p0, p1, shm + L_K + so, qr, cinit, r32, hi); else qkt<2, 2>(p0, p1, shm + L_K + so, qr, cinit, r32, hi); }
                else qkt<0, 4>(p0, p1, shm + L_K + so, qr, cinit, r32, hi);
                if (VAR != 0) {
                    const float qk = (float)(qpos - 64 * t - 4 * hi), ns = -P.slope2;
                    const bool need_mask = (VAR == 2) && ((64 * t + 63 - qw > 128) || (qw + 31 - 64 * t > 128));
#pragma unroll
                    for (int r = 0; r < 16; ++r) { const float c = (float)((r & 3) + 8 * (r >> 2));
                        const float d0 = qk - c, d1 = qk - (c + 32.f);
                        p0[r] = __builtin_fmaf(ns, __builtin_fabsf(d0), p0[r]); p1[r] = __builtin_fmaf(ns, __builtin_fabsf(d1), p1[r]);
                        if (need_mask) { if (__builtin_fabsf(d0) > 128.f) p0[r] = -INFINITY; if (__builtin_fabsf(d1) > 128.f) p1[r] = -INFINITY; } }
                }
                const float rm = rowmax(p0, p1);
                if (first) {
                    mh[c] = rm;
#pragma unroll
                    for (int r = 0; r < 16; ++r) { p0[r] -= rm; p1[r] -= rm; }
                } else if (__any(rm > THR)) {
                    const float dl = __builtin_fmaxf(rm, 0.f); mh[c] += dl;
#pragma unroll
                    for (int r = 0; r < 16; ++r) { p0[r] -= dl; p1[r] -= dl; }
                    const float f = __builtin_amdgcn_exp2f(-dl); lsum[c] *= f;
                    if (hi == 0) wsf[r32] = f;
                    asm volatile("s_waitcnt lgkmcnt(0)" ::: "memory");
#pragma unroll
                    for (int r = 0; r < 16; ++r) { const float fr_ = wsf[crow(r, hi)]; o[c][0][r] *= fr_; o[c][1][r] *= fr_; }
                }
                float sacc = 0.f;
#pragma unroll
                for (int r = 0; r < 16; ++r) { p0[r] = __builtin_amdgcn_exp2f(p0[r]); p1[r] = __builtin_amdgcn_exp2f(p1[r]); sacc += p0[r] + p1[r]; }
                lsum[c] += sacc;
                u32x4 pw0, pw1, pw2, pw3;
                pw0 = (u32x4){pkbf(p0[0], p0[1]), pkbf(p0[2], p0[3]), pkbf(p0[4], p0[5]), pkbf(p0[6], p0[7])};
                pw1 = (u32x4){pkbf(p0[8], p0[9]), pkbf(p0[10], p0[11]), pkbf(p0[12], p0[13]), pkbf(p0[14], p0[15])};
                pw2 = (u32x4){pkbf(p1[0], p1[1]), pkbf(p1[2], p1[3]), pkbf(p1[4], p1[5]), pkbf(p1[6], p1[7])};
                pw3 = (u32x4){pkbf(p1[8], p1[9]), pkbf(p1[10], p1[11]), pkbf(p1[12], p1[13]), pkbf(p1[14], p1[15])};
                pv(o[c], vb0 + so, __builtin_bit_cast(bf16x8, pw0), __builtin_bit_cast(bf16x8, pw1), __builtin_bit_cast(bf16x8, pw2), __builtin_bit_cast(bf16x8, pw3));
            }
        }
        so = (so == (NSLOT - 1) * SLOTB) ? 0 : so + SLOTB; so2 = (so2 == (NSLOT - 1) * SLOTB) ? 0 : so2 + SLOTB;
    }
#pragma unroll
    for (int c = 0; c < NC; ++c) { auto rr = __builtin_amdgcn_permlane32_swap(__float_as_uint(lsum[c]), __float_as_uint(lsum[c]), false, false);
        const float lt = __uint_as_float(rr[0]) + __uint_as_float(rr[1]); if (hi == 0) wsf[32 + 32 * c + r32] = lt; }
    asm volatile("s_waitcnt lgkmcnt(0)" ::: "memory");
    LAS float* stg = (LAS float*)(shm + L_OST + wid * OST_W);
#pragma unroll
    for (int r = 0; r < 16; ++r) { const int orow = crow(r, hi);
        const float rl0 = __builtin_amdgcn_rcpf(wsf[32 + orow]);
        float rl1 = 0.f; if (VAR == 1) rl1 = P.lam * __builtin_amdgcn_rcpf(wsf[64 + orow]);
#pragma unroll
        for (int d0 = 0; d0 < 2; ++d0) { float v = o[0][d0][r] * rl0; if (VAR == 1) v -= o[NC - 1][d0][r] * rl1; stg[orow * 68 + d0 * 32 + r32] = v; } }
    asm volatile("s_waitcnt lgkmcnt(0)" ::: "memory");
    {
        const int row = lane >> 1, half = lane & 1;
        f32x4 x[8];
#pragma unroll
        for (int k = 0; k < 8; ++k) x[k] = *(const LAS f32x4*)(stg + row * 68 + half * 32 + 4 * k);
        if (VAR == 1) {
            float ss = 0.f;
#pragma unroll
            for (int k = 0; k < 8; ++k) ss += (x[k][0] * x[k][0] + x[k][1] * x[k][1]) + (x[k][2] * x[k][2] + x[k][3] * x[k][3]);
            ss += xor_lane<1>(ss);
            const float rinv = P.oscale / sqrtf(ss * (1.f / 64.f) + RMS_EPS);
#pragma unroll
            for (int k = 0; k < 8; ++k) x[k] = x[k] * rinv * *(const f32x4*)(P.subln + half * 32 + 4 * k);
        }
        bf16_t* op = MIX + (rowbase + q0 + wid * 32 + row) * MXP + OC + h * 64 + half * 32;
#pragma unroll
        for (int k = 0; k < 4; ++k) { u32x4 w; w.x = pkbf(x[2 * k][0], x[2 * k][1]); w.y = pkbf(x[2 * k][2], x[2 * k][3]); w.z = pkbf(x[2 * k + 1][0], x[2 * k + 1][1]); w.w = pkbf(x[2 * k + 1][2], x[2 * k + 1][3]);
            *(u32x4*)(op + 8 * k) = w; }
    }
    asm volatile("s_waitcnt lgkmcnt(0)\n\ts_barrier" ::: "memory");
#undef ATT_DMA_K
#undef ATT_DMA_V
}
}

struct Frame {
    LAS unsigned char* lds; volatile LAS unsigned* MISC; gu32* ctl;
    int tid, lane, wave, vcu, G;
};
struct Args { const float* in[26]; float* out; unsigned char* ws; };
constexpr int PT_OFF = MISC_OFF + 1024;
__device__ __forceinline__ unsigned long long ldp_raw(LAS unsigned char* lds, int i) {
    unsigned z = 0u; asm volatile("" : "+v"(z));
    const unsigned a = z + (unsigned)(uintptr_t)lds + PT_OFF + 8u * (unsigned)i;
    const unsigned long long v = *(volatile LAS unsigned long long*)(uintptr_t)a;
    const unsigned lo = __builtin_amdgcn_readfirstlane((unsigned)v), hi = __builtin_amdgcn_readfirstlane((unsigned)(v >> 32));
    return ((unsigned long long)hi << 32) | lo; }
#define INP(i) ((const float*)ldp_raw(F.lds, (i)))
#define OUTP() ((float*)ldp_raw(F.lds, 26))
#define WSP() ((unsigned char*)ldp_raw(F.lds, 27))

__device__ __forceinline__ int winmap(int n) {
    const int tile = n >> 8, p = n & 255;
    if (tile != 1 && tile != 2) return n;
    const int hh = p >> 6, dim = p & 63, bj = dim >> 5, w = dim & 31;
    int fq, e;
    if (tile == 1 || hh < 2) { const int ehi = w >> 4, i = w & 15; fq = i >> 2; e = (i & 3) + 4 * ehi; }
    else { fq = w >> 3; e = w & 7; }
    return tile * 256 + 128 * bj + 32 * hh + 8 * fq + e;
}
template <int MAP> __device__ __forceinline__ int rowmap(int n) {
    if (MAP == 1) return winmap(n);
    if (MAP == 2) return (n >> 7) * 256 + (n & 127);
    if (MAP == 3) return (n >> 7) * 256 + 128 + (n & 127);
    return n;
}
__device__ __forceinline__ void tr_write(bf16_t* WT, int K, int k0, LAS float* scr, int lane, const int (&drow)[4]) {
    const int c = lane & 7;
#pragma unroll
    for (int j = 0; j < 4; ++j) { const int n = (lane >> 3) + 8 * j; const LAS float* s = scr + (8 * c) * 33 + n;
        u32x4 o; o.x = pkbf(s[0 * 33], s[1 * 33]); o.y = pkbf(s[2 * 33], s[3 * 33]); o.z = pkbf(s[4 * 33], s[5 * 33]); o.w = pkbf(s[6 * 33], s[7 * 33]);
        *(u32x4*)(WT + (size_t)drow[j] * K + k0 + 8 * c) = o; }
    asm volatile("s_waitcnt lgkmcnt(0)" ::: "memory");
}
template <int MAP>
__device__ __forceinline__ void tr_item(const float* W, int K, int N, int ncol0, bf16_t* WT, LAS float* scr, int item, int lane) {
    const int nblk = (N - ncol0) / 32, kb = item / nblk, nb = item % nblk, k0 = 64 * kb, n0 = ncol0 + 32 * nb;
    f32x4 v[8];
#pragma unroll
    for (int i = 0; i < 8; ++i) v[i] = __builtin_nontemporal_load((const f32x4*)(W + (size_t)(k0 + 8 * i + (lane >> 3)) * N + n0 + (lane & 7) * 4));
#pragma unroll
    for (int i = 0; i < 8; ++i) { LAS float* d = scr + (8 * i + (lane >> 3)) * 33 + (lane & 7) * 4; d[0] = v[i][0]; d[1] = v[i][1]; d[2] = v[i][2]; d[3] = v[i][3]; }
    asm volatile("s_waitcnt lgkmcnt(0)" ::: "memory");
    int drow[4];
#pragma unroll
    for (int j = 0; j < 4; ++j) drow[j] = rowmap<MAP>(n0 + (lane >> 3) + 8 * j);
    tr_write(WT, K, k0, scr, lane, drow);
}
template <int MAP>
__device__ __forceinline__ void tr_item8(const float* W, int K, int N, unsigned char* WT, float sc, LAS float* scr, int item, int lane) {
    const int nblk = N / 32, kb = item / nblk, nb = item % nblk, k0 = 64 * kb, n0 = 32 * nb;
    f32x4 v[8];
#pragma unroll
    for (int i = 0; i < 8; ++i) v[i] = __builtin_nontemporal_load((const f32x4*)(W + (size_t)(k0 + 8 * i + (lane >> 3)) * N + n0 + (lane & 7) * 4));
#pragma unroll
    for (int i = 0; i < 8; ++i) { LAS float* d = scr + (8 * i + (lane >> 3)) * 33 + (lane & 7) * 4; d[0] = v[i][0]; d[1] = v[i][1]; d[2] = v[i][2]; d[3] = v[i][3]; }
    asm volatile("s_waitcnt lgkmcnt(0)" ::: "memory");
    const int c = lane & 7;
#pragma unroll
    for (int j = 0; j < 4; ++j) { const int n = (lane >> 3) + 8 * j; const LAS float* s = scr + (8 * c) * 33 + n;
        u32x2 o; o.x = pk4_fp8(s[0 * 33] * sc, s[1 * 33] * sc, s[2 * 33] * sc, s[3 * 33] * sc); o.y = pk4_fp8(s[4 * 33] * sc, s[5 * 33] * sc, s[6 * 33] * sc, s[7 * 33] * sc);
        *(u32x2*)(WT + (size_t)rowmap<MAP>(n0 + n) * K + k0 + 8 * c) = o; }
    asm volatile("s_waitcnt lgkmcnt(0)" ::: "memory");
}
__device__ __forceinline__ void tr_item_pool_wg(const float* W, const float* wp, const float* scale, bf16_t* WT, LAS float* scr, int item, int tid) {
    const int kb = item / 8, nb = item % 8, k0 = 64 * kb, n0 = 32 * nb, g = n0 >> 6, kk = tid >> 3, nq = (tid & 7) * 4;
    const float* wrow = W + (size_t)(k0 + kk) * D_IN + 64 * g; const float* wpc = wp + (size_t)g * 4096 + (n0 & 63) + nq;
    f32x4 acc = {0.f, 0.f, 0.f, 0.f};
#pragma unroll 8
    for (int c = 0; c < 64; ++c) acc += *(const f32x4*)(wpc + c * 64) * wrow[c];
    acc = acc * *(const f32x4*)(scale + n0 + nq);
    LAS float* d = scr + kk * 33 + nq; d[0] = acc[0]; d[1] = acc[1]; d[2] = acc[2]; d[3] = acc[3];
    __syncthreads();
    if (tid < 64) { int drow[4];
#pragma unroll
        for (int j = 0; j < 4; ++j) drow[j] = n0 + (tid >> 3) + 8 * j;
        tr_write(WT, DM, k0, scr, tid, drow); }
    __syncthreads();
}
__device__ __forceinline__ void ln_core(f32x4 (&v)[4], const f32x4 (&g4)[4], const f32x4 (&b4)[4]) {
    float s = 0.f;
#pragma unroll
    for (int j = 0; j < 4; ++j) s += (v[j][0] + v[j][1]) + (v[j][2] + v[j][3]);
    const float mean = wave_sum(s) * (1.f / DM); float s2 = 0.f;
#pragma unroll
    for (int j = 0; j < 4; ++j) { v[j] = v[j] - mean; s2 += (v[j][0] * v[j][0] + v[j][1] * v[j][1]) + (v[j][2] * v[j][2] + v[j][3] * v[j][3]); }
    const float rstd = 1.f / sqrtf(wave_sum(s2) * (1.f / DM) + LN_EPS);
#pragma unroll
    for (int j = 0; j < 4; ++j) v[j] = v[j] * rstd * g4[j] + b4[j];
}
__device__ __forceinline__ void ln_store(const f32x4 (&v)[4], float* xo, bf16_t* xn, int lane) {
#pragma unroll
    for (int j = 0; j < 4; ++j) {
        if (xo) *((f32x4*)xo + lane + 64 * j) = v[j];
        if (xn) { u32x2 w; w.x = pkbf(v[j][0], v[j][1]); w.y = pkbf(v[j][2], v[j][3]); *((u32x2*)xn + lane + 64 * j) = w; } }
}

__global__ void __launch_bounds__(NWAVES * 64, 2) mega_fwd(Args args) {
    extern __shared__ __attribute__((aligned(16))) unsigned char lds_raw[];
    Frame F;
    F.lds = (LAS unsigned char*)lds_raw;
    F.MISC = (volatile LAS unsigned*)(F.lds + MISC_OFF);
    const int wave0 = __builtin_amdgcn_readfirstlane((int)threadIdx.x >> 6);
    F.ctl = (gu32*)(args.ws + WS_CTL);
    { const int t = wave0 * 64 + lane_id();
      for (int u = t; u < 256; u += NWAVES * 64) F.MISC[u] = 0u;
      if (t == 0) { volatile LAS unsigned long long* PT = (volatile LAS unsigned long long*)(F.lds + PT_OFF);
#pragma unroll
        for (int i = 0; i < 26; ++i) PT[i] = (unsigned long long)args.in[i];
        PT[26] = (unsigned long long)args.out; PT[27] = (unsigned long long)args.ws; } }
    __syncthreads();
    XcdBarrier bar = xcd_barrier_post((unsigned*)(F.ctl + CW_BAR), F.MISC + 8, wave0 == 0 && lane_id() == 0);
#define GRID_BAR() xcd_barrier(bar, wave0 == 0 && lane_id() == 0)
#define PHASE_LOCALS() int tid_ = wave0 * 64 + lane_id(); asm volatile("" : "+v"(tid_)); int bid_ = blockIdx.x, G_ = gridDim.x; asm volatile("" : "+s"(bid_), "+s"(G_)); \
    const int lane = tid_ & 63, wave = __builtin_amdgcn_readfirstlane(tid_ >> 6), vcu = (G_ % 8 == 0) ? (bid_ % 8) * (G_ / 8) + bid_ / 8 : bid_, gw = vcu * NWAVES + wave, NGW = G_ * NWAVES; \
    (void)lane; (void)gw; (void)NGW; (void)vcu; (void)wave

        asm volatile("; MARK_P0" ::: "memory");
    for (int dup = 0; dup < DUP_P0; ++dup) {
        PHASE_LOCALS();
        LAS float* scr = (LAS float*)(F.lds + wave * 16384);
        unsigned char* ws = WSP();
        const float* x_in = INP(0); const float* ln_in_g = INP(1); const float* ln_in_b = INP(2); const float* w_in = INP(3); const float* w_pool = INP(4); const float* pool_scale = INP(5);
        const float* w_out = INP(14); const float* w_gate = INP(17); const float* w_up = INP(18); const float* w_down = INP(19); const float* e_gate = INP(21); const float* e_up = INP(22); const float* e_down = INP(23);
        float* X = OUTP(); float* ropec = (float*)(ws + WS_ROPEC); float* ropes = (float*)(ws + WS_ROPES);
        bf16_t* Win_t = (bf16_t*)(ws + WS_WIN); bf16_t* Wout_t = (bf16_t*)(ws + WS_WOUT); bf16_t* Wgu_t = (bf16_t*)(ws + WS_WGU); bf16_t* Wd_t = (bf16_t*)(ws + WS_WD);
        unsigned char* Egu8 = ws + WS_EGU; unsigned char* Ed8 = ws + WS_ED; bf16_t* XN = (bf16_t*)(ws + WS_XN);
        constexpr int I_WIN = 16 * 56, I_POOL = 16 * 8, I_WOUT = 16 * 32, I_G = 16 * 88, I_D = 44 * 32, I_EG = 16 * 112, I_ED = 56 * 32;
        constexpr int N0 = 2 * I_WIN, N1 = N0 + 2 * I_WOUT, N2 = N1 + 2 * I_G, N3 = N2 + I_D, N4 = N3 + 16 * I_EG, N5 = N4 + 8 * I_ED;
        for (int pi = vcu; pi < 2 * I_POOL; pi += G_) { const int l = pi / I_POOL;
            tr_item_pool_wg(w_in + (size_t)l * DM * D_IN, w_pool + (size_t)l * 4 * 4096, pool_scale + l * 256, Win_t + (size_t)l * D_IN * DM, (LAS float*)F.lds, pi - l * I_POOL, tid_); }
        for (int it = gw; it < N5; it += NGW) {
            int r = it;
            if (r < N0) { const int l = r / I_WIN; r -= l * I_WIN; tr_item<1>(w_in + (size_t)l * DM * D_IN, DM, D_IN, 256, Win_t + (size_t)l * D_IN * DM, scr, r, lane); continue; }
            if (r < N1) { r -= N0; const int l = r / I_WOUT; r -= l * I_WOUT; tr_item<0>(w_out + (size_t)l * DM * DM, DM, DM, 0, Wout_t + (size_t)l * DM * DM, scr, r, lane); continue; }
            if (r < N2) { r -= N1; const int which = r / I_G; r -= which * I_G;
#if DENSE_FP8
                if (which == 0) tr_item8<2>(w_gate, DM, D_FF, (unsigned char*)Wgu_t, EGU_SCALE, scr, r, lane); else tr_item8<3>(w_up, DM, D_FF, (unsigned char*)Wgu_t, EGU_SCALE, scr, r, lane);
                continue; }
            if (r < N3) { r -= N2; tr_item8<0>(w_down, D_FF, DM, (unsigned char*)Wd_t, ED_SCALE, scr, r, lane); continue; }
#else
                if (which == 0) tr_item<2>(w_gate, DM, D_FF, 0, Wgu_t, scr, r, lane); else tr_item<3>(w_up, DM, D_FF, 0, Wgu_t, scr, r, lane);
                continue; }
            if (r < N3) { r -= N2; tr_item<0>(w_down, D_FF, DM, 0, Wd_t, scr, r, lane); continue; }
#endif
            if (r < N4) { r -= N3; const int idx = r / I_EG; r -= idx * I_EG; const int e = idx >> 1;
                if ((idx & 1) == 0) tr_item8<2>(e_gate + (size_t)e * DM * D_FFE, DM, D_FFE, Egu8 + (size_t)e * 2 * D_FFE * DM, EGU_SCALE, scr, r, lane);
                else tr_item8<3>(e_up + (size_t)e * DM * D_FFE, DM, D_FFE, Egu8 + (size_t)e * 2 * D_FFE * DM, EGU_SCALE, scr, r, lane);
                continue; }
            { r -= N4; const int e = r / I_ED; r -= e * I_ED; tr_item8<0>(e_down + (size_t)e * D_FFE * DM, D_FFE, DM, Ed8 + (size_t)e * DM * D_FFE, ED_SCALE, scr, r, lane); }
        }
        for (int idx = bid_ * 512 + tid_; idx < SEQ * 32; idx += G_ * 512) { const int s = idx >> 5, ax = (idx >> 4) & 1, i = idx & 15;
            const float pos = ax == 0 ? (float)(s / 64) : (float)(s % 64); const float inv_freq = powf(10000.0f, -(float)(2 * i) / 32.0f); const float ang = pos * inv_freq;
            ropec[idx] = cosf(ang); ropes[idx] = sinf(ang); }
        f32x4 g4[4], b4[4];
#pragma unroll
        for (int j = 0; j < 4; ++j) { g4[j] = *((const f32x4*)ln_in_g + lane + 64 * j); b4[j] = *((const f32x4*)ln_in_b + lane + 64 * j); }
        for (int m = gw; m < M; m += NGW) { f32x4 v[4];
#pragma unroll
            for (int j = 0; j < 4; ++j) v[j] = *((const f32x4*)(x_in + (size_t)m * DM) + lane + 64 * j);
            ln_core(v, g4, b4); ln_store(v, X + (size_t)m * DM, XN + (size_t)m * DM, lane); }
    }
    GRID_BAR();

#pragma clang loop unroll(full)
    for (int l = 0; l < DEPTH; ++l) {
        asm volatile("; MARK_P1" ::: "memory");
        for (int dup = 0; dup < DUP_P1; ++dup) {
            PHASE_LOCALS();
            unsigned char* ws = WSP(); const float* qn_w = INP(6); const float* kn_w = INP(7);
            bf16_t* XN = (bf16_t*)(ws + WS_XN); bf16_t* Win_t = (bf16_t*)(ws + WS_WIN); bf16_t* PJ = (bf16_t*)(ws + WS_PJ); const float* ropec = (const float*)(ws + WS_ROPEC); const float* ropes = (const float*)(ws + WS_ROPES);
            pg8::Gemm g{XN, Win_t + (size_t)l * D_IN * DM, DM, 0};
            pg8::StaticOrder S; S.init(M, D_IN, G_, bid_);
            pg8::EpiProj E{PJ, qn_w + l * 64, kn_w + l * 64, ropec, ropes, (unsigned*)(ws + WS_CTL) + CW_NRM + l * 256};
            pg8::gemm_phase<pg8::EpiProj, pg8::StaticOrder, true>(F.lds, g, S, E, wave0);
        }
        GRID_BAR();
        asm volatile("; MARK_P2" ::: "memory");
        for (int dup = 0; dup < DUP_P2; ++dup) {
            PHASE_LOCALS();
            unsigned char* ws = WSP(); const float* lam_q1 = INP(8); const float* lam_k1 = INP(9); const float* lam_q2 = INP(10); const float* lam_k2 = INP(11); const float* subln_w = INP(12); const float* sink = INP(13);
            bf16_t* PJ = (bf16_t*)(ws + WS_PJ); bf16_t* MIX = (bf16_t*)(ws + WS_MIX);
            const float lam_init = 0.8f - 0.6f * expf(-0.3f * (float)l);
            float a = lane < 32 ? lam_q1[l * 32 + lane] * lam_k1[l * 32 + lane] : 0.f, c = lane < 32 ? lam_q2[l * 32 + lane] * lam_k2[l * 32 + lane] : 0.f;
            const float lam = expf(wave_sum(a)) - expf(wave_sum(c)) + lam_init;
            unsigned* qhead = (unsigned*)(ws + WS_CTL) + CW_Q + 64 * l; const unsigned* nrm = (const unsigned*)(ws + WS_CTL) + CW_NRM + l * 256;
            volatile LAS unsigned* qslot = F.MISC + 32;
            for (;;) {
                if (wave0 == 0 && lane_id() == 0) *qslot = __hip_atomic_fetch_add(qhead, 1u, __ATOMIC_RELAXED, __HIP_MEMORY_SCOPE_AGENT);
                __syncthreads();
                const int idx = __builtin_amdgcn_readfirstlane((int)*qslot);
                __syncthreads();
                if (idx >= 1792) break;
                if (idx < 256 || (idx >= 768 && idx < 1024)) {
                    const int h = idx < 128 ? 3 : (idx < 256 ? 2 : (idx < 896 ? 1 : 0)), k = idx & 127, b = k >> 3, qb = k & 7;
                    const float slope2 = exp2f(-(float)(2 * h + 1)) * LOG2E;
                    const float q0n = __uint_as_float(nrm[(0 * 16 + b) * 8 + h * 2]), q1n = __uint_as_float(nrm[(0 * 16 + b) * 8 + h * 2 + 1]), k0n = __uint_as_float(nrm[(1 * 16 + b) * 8 + h * 2]), k1n = __uint_as_float(nrm[(1 * 16 + b) * 8 + h * 2 + 1]);
                    const float bound = sqrtf(__builtin_fmaxf(q0n * k0n, q1n * k1n));
                    float dc = (2.1f * bound + 40.0f) / slope2; if (dc > 4096.f) dc = 4096.f;
                    att::Par P{slope2, 0.f, lam, 1.0f - lam_init, subln_w + l * 64, (int)dc + 1};
                    for (int d_ = 0; d_ < DUP_C; ++d_) att::unit<1>(b, h, qb, PJ, MIX, F.lds, P, wave0);
                } else if (idx < 768) {
                    const int k = idx - 256, qb = k & 7, h = (k >> 3) & 3, b = k >> 5;
                    att::Par P{0.f, 0.f, 0.f, 0.f, nullptr, 0};
                    for (int d_ = 0; d_ < DUP_B; ++d_) att::unit<0>(b, h, qb, PJ, MIX, F.lds, P, wave0);
                } else if (idx < 1536) {
                    const int k = idx - 1024, qb = k & 7, h = (k >> 3) & 3, b = k >> 5;
                    att::Par P{exp2f(-(float)(2 * h + 2)) * LOG2E, sink[l * 4 + h] * LOG2E, 0.f, 0.f, nullptr, 0};
                    for (int d_ = 0; d_ < DUP_D; ++d_) att::unit<2>(b, h, qb, PJ, MIX, F.lds, P, wave0);
                } else {
                    const int ch = idx - 1536;
                    for (int it = wave0 * 64 + lane_id(); it < 128 * 32; it += NWAVES * 64) { const int t = ch * 128 + (it >> 5), cg = it & 31, c0 = cg * 8, s = t & (SEQ - 1), base = t - s;
                        const int w = 2 << (c0 >> 6); int lo = s - w / 2, hi = lo + w; if (lo < 0) lo = 0; if (hi > SEQ) hi = SEQ;
                        float acc[8];
#pragma unroll
                        for (int j = 0; j < 8; ++j) acc[j] = 0.f;
                        for (int j = lo; j < hi; ++j) { const u32x4 zz = *(const u32x4*)(PJ + (size_t)(base + j) * D_IN + c0);
                            acc[0] += bf_lo(zz.x); acc[1] += bf_hi(zz.x); acc[2] += bf_lo(zz.y); acc[3] += bf_hi(zz.y); acc[4] += bf_lo(zz.z); acc[5] += bf_hi(zz.z); acc[6] += bf_lo(zz.w); acc[7] += bf_hi(zz.w); }
                        const float inv = 1.0f / (float)(hi - lo); const u32x4 zs = *(const u32x4*)(PJ + (size_t)t * D_IN + c0);
                        u32x4 o; o.x = pkbf(acc[0] * inv - bf_lo(zs.x), acc[1] * inv - bf_hi(zs.x)); o.y = pkbf(acc[2] * inv - bf_lo(zs.y), acc[3] * inv - bf_hi(zs.y));
                        o.z = pkbf(acc[4] * inv - bf_lo(zs.z), acc[5] * inv - bf_hi(zs.z)); o.w = pkbf(acc[6] * inv - bf_lo(zs.w), acc[7] * inv - bf_hi(zs.w));
                        *(u32x4*)(MIX + (size_t)t * DM + c0) = o; }
                }
            }
        }
        GRID_BAR();
        asm volatile("; MARK_P3" ::: "memory");
        {
            PHASE_LOCALS();
            unsigned char* ws = WSP(); float* X = OUTP(); bf16_t* MIX = (bf16_t*)(ws + WS_MIX); bf16_t* Wout_t = (bf16_t*)(ws + WS_WOUT);
            pg8::Gemm g{MIX, Wout_t + (size_t)l * DM * DM, DM, 0};
            pg8::StaticOrder S; S.init(M, DM, G_, bid_);
            pg8::EpiResid E{X, 1.0f};
            pg8::gemm_phase<pg8::EpiResid, pg8::StaticOrder, true>(F.lds, g, S, E, wave0);
        }
        GRID_BAR();
        asm volatile("; MARK_LN1" ::: "memory");
        {
            PHASE_LOCALS();
            unsigned char* ws = WSP(); float* X = OUTP(); const float* ln1_g = INP(15); const float* ln1_b = INP(16); const float* w_router = INP(20);
            bf16_t* XN = (bf16_t*)(ws + WS_XN); int* ltok = (int*)(ws + WS_LTOK); int* tpos = (int*)(ws + WS_TPOS); float* tgate = (float*)(ws + WS_TGATE);
            f32x4 g4[4], b4[4];
#pragma unroll
            for (int j = 0; j < 4; ++j) { g4[j] = *((const f32x4*)(ln1_g + l * DM) + lane + 64 * j); b4[j] = *((const f32x4*)(ln1_b + l * DM) + lane + 64 * j); }
            int me1 = -1, me2 = -1; float mg1 = 0.f, mg2 = 0.f;
            const int rows_per_wave = M / NGW;
            for (int ri = 0; ri < rows_per_wave; ++ri) { const int m = gw * rows_per_wave + ri; f32x4 v[4];
#pragma unroll
                for (int j = 0; j < 4; ++j) v[j] = *((const f32x4*)(X + (size_t)m * DM) + lane + 64 * j);
                ln_core(v, g4, b4);
                if (l == 0 && !DENSE_FP8) ln_store(v, X + (size_t)m * DM, XN + (size_t)m * DM, lane);
                else { ln_store(v, X + (size_t)m * DM, nullptr, lane);
#pragma unroll
                    for (int j = 0; j < 4; ++j) *((unsigned*)((unsigned char*)XN + (size_t)m * DM) + lane + 64 * j) = pk4_fp8(v[j][0], v[j][1], v[j][2], v[j][3]); }
                if (l == 1) {
                    float lg[8];
#pragma unroll
                    for (int e = 0; e < 8; ++e) lg[e] = 0.f;
#pragma unroll
                    for (int j = 0; j < 4; ++j)
#pragma unroll
                        for (int q = 0; q < 4; ++q) { const int c = 4 * lane + 256 * j + q; const f32x4 wa = *(const f32x4*)(w_router + c * 8), wb = *(const f32x4*)(w_router + c * 8 + 4); const float xv = v[j][q];
                            lg[0] += xv * wa[0]; lg[1] += xv * wa[1]; lg[2] += xv * wa[2]; lg[3] += xv * wa[3]; lg[4] += xv * wb[0]; lg[5] += xv * wb[1]; lg[6] += xv * wb[2]; lg[7] += xv * wb[3]; }
#pragma unroll
                    for (int e = 0; e < 8; ++e) lg[e] = wave_sum(lg[e]);
                    int i1 = 0; float v1 = lg[0];
#pragma unroll
                    for (int e = 1; e < 8; ++e) if (lg[e] > v1) { v1 = lg[e]; i1 = e; }
                    int i2 = 0; float v2 = -INFINITY;
#pragma unroll
                    for (int e = 0; e < 8; ++e) if (e != i1 && lg[e] > v2) { v2 = lg[e]; i2 = e; }
                    const float ex = expf(v2 - v1), ga = 1.f / (1.f + ex), gb = ex / (1.f + ex);
                    if (lane == ri) { me1 = i1; me2 = i2; mg1 = ga; mg2 = gb; }
                }
            }
            if (l == 1) {
                const int myrow = gw * rows_per_wave + lane;
#pragma unroll
                for (int e = 0; e < 8; ++e) {
                    const bool has = (lane < rows_per_wave) && (me1 == e || me2 == e);
                    const unsigned long long mask = __ballot(has);
                    const int n = __popcll(mask);
                    if (n) {
                        int base = 0;
                        if (lane == 0) base = (int)__hip_atomic_fetch_add((unsigned*)(ws + WS_CTL) + CW_CNT + 64 * e, (unsigned)n, __ATOMIC_RELAXED, __HIP_MEMORY_SCOPE_AGENT);
                        base = __builtin_amdgcn_readfirstlane(base);
                        if (has) { const int p = base + (int)__builtin_amdgcn_mbcnt_hi((unsigned)(mask >> 32), __builtin_amdgcn_mbcnt_lo((unsigned)mask, 0u)); const int k = (me1 == e) ? 0 : 1;
                            ltok[e * M + p] = myrow; tpos[myrow * 2 + k] = (e << 20) | p; tgate[myrow * 2 + k] = k == 0 ? mg1 : mg2; }
                    }
                }
            }
        }
        GRID_BAR();
        if (l == 0) {
        asm volatile("; MARK_DENSE" ::: "memory");
            for (int dup = 0; dup < DUP_GU; ++dup) {
                PHASE_LOCALS();
                unsigned char* ws = WSP(); bf16_t* XN = (bf16_t*)(ws + WS_XN); bf16_t* Wgu_t = (bf16_t*)(ws + WS_WGU); bf16_t* Hd = (bf16_t*)(ws + WS_H);
                pg8::Gemm g{XN, Wgu_t, DM, 0};
                pg8::StaticOrder S; S.init(M, 2 * D_FF, G_, bid_);
#if DENSE_FP8
                pg8::EpiSwiGLU<true> E{Hd, D_FF, 0};
                pg8::gemm_phase<pg8::EpiSwiGLU<true>, pg8::StaticOrder, true, false, 1>(F.lds, g, S, E, wave0);
#else
                pg8::EpiSwiGLU<false> E{Hd, D_FF, 0};
                pg8::gemm_phase<pg8::EpiSwiGLU<false>, pg8::StaticOrder, true>(F.lds, g, S, E, wave0);
#endif
            }
            GRID_BAR();
            {
                PHASE_LOCALS();
                unsigned char* ws = WSP(); float* X = OUTP(); bf16_t* Wd_t = (bf16_t*)(ws + WS_WD); bf16_t* Hd = (bf16_t*)(ws + WS_H);
                pg8::Gemm g{Hd, Wd_t, D_FF, 0};
                pg8::StaticOrder S; S.init(M, DM, G_, bid_);
#if DENSE_FP8
                pg8::EpiResid E{X, 1.0f / ED_SCALE};
                pg8::gemm_phase<pg8::EpiResid, pg8::StaticOrder, true, false, 1>(F.lds, g, S, E, wave0);
#else
                pg8::EpiResid E{X, 1.0f};
                pg8::gemm_phase<pg8::EpiResid, pg8::StaticOrder, true>(F.lds, g, S, E, wave0);
#endif
            }
            GRID_BAR();
        asm volatile("; MARK_LN2" ::: "memory");
            {
                PHASE_LOCALS();
                unsigned char* ws = WSP(); float* X = OUTP(); const float* ln2_g = INP(24); const float* ln2_b = INP(25); bf16_t* XN = (bf16_t*)(ws + WS_XN);
                f32x4 g4[4], b4[4];
#pragma unroll
                for (int j = 0; j < 4; ++j) { g4[j] = *((const f32x4*)(ln2_g + l * DM) + lane + 64 * j); b4[j] = *((const f32x4*)(ln2_b + l * DM) + lane + 64 * j); }
                for (int m = gw; m < M; m += NGW) { f32x4 v[4];
#pragma unroll
                    for (int j = 0; j < 4; ++j) v[j] = *((const f32x4*)(X + (size_t)m * DM) + lane + 64 * j);
                    ln_core(v, g4, b4); ln_store(v, X + (size_t)m * DM, XN + (size_t)m * DM, lane); }
            }
            GRID_BAR();
        } else {
        asm volatile("; MARK_MOE" ::: "memory");
            volatile LAS int* T = (volatile LAS int*)(F.MISC + 64);
            if (wave0 == 0 && lane_id() == 0) { int acc = 0; unsigned* ctlw = (unsigned*)(WSP() + WS_CTL);
                for (int e = 0; e < 8; ++e) { const int c = (int)__hip_atomic_load(ctlw + CW_CNT + 64 * e, __ATOMIC_RELAXED, __HIP_MEMORY_SCOPE_AGENT); T[e] = acc; T[16 + e] = c; acc += (c + 255) >> 8; }
                T[8] = acc; }
            __syncthreads();
            MoeTable tab{T};
            const int total_tiles = __builtin_amdgcn_readfirstlane(T[8]);
            for (int dup = 0; dup < DUP_MOE; ++dup)
            for (int rt_lo = 0; rt_lo < total_tiles; rt_lo += CHUNK_TILES) {
                const int nrt = (total_tiles - rt_lo) < CHUNK_TILES ? (total_tiles - rt_lo) : CHUNK_TILES;
                {
                    PHASE_LOCALS();
                    unsigned char* ws = WSP(); unsigned char* XN8 = ws + WS_XN; unsigned char* Egu8 = ws + WS_EGU; unsigned char* HC = ws + WS_HC; const int* ltok = (const int*)(ws + WS_LTOK);
                    pg8::Gemm g{XN8, Egu8, DM, (size_t)2 * D_FFE * DM};
                    MoeOrder S{tab, rt_lo, nrt, 2 * D_FFE / 256, G_, bid_, ltok, true};
                    pg8::EpiSwiGLU<true> E{HC, D_FFE, rt_lo};
                    pg8::gemm_phase<pg8::EpiSwiGLU<true>, MoeOrder, true, true, 1>(F.lds, g, S, E, wave0);
                }
                GRID_BAR();
                {
                    PHASE_LOCALS();
                    unsigned char* ws = WSP(); unsigned char* Ed8 = ws + WS_ED; unsigned char* HC = ws + WS_HC; bf16_t* Y = (bf16_t*)(ws + WS_Y); const int* ltok = (const int*)(ws + WS_LTOK);
                    pg8::Gemm g{HC, Ed8, D_FFE, (size_t)DM * D_FFE};
                    MoeOrder S{tab, rt_lo, nrt, DM / 256, G_, bid_, ltok, false};
                    pg8::EpiBf16 E{Y, DM, 1.0f / ED_SCALE};
                    pg8::gemm_phase<pg8::EpiBf16, MoeOrder, true, false, 1>(F.lds, g, S, E, wave0);
                }
                GRID_BAR();
            }
        asm volatile("; MARK_COMB" ::: "memory");
            {
                PHASE_LOCALS();
                unsigned char* ws = WSP(); float* X = OUTP(); const float* ln2_g = INP(24); const float* ln2_b = INP(25);
                const bf16_t* Y = (const bf16_t*)(ws + WS_Y); const int* tpos = (const int*)(ws + WS_TPOS); const float* tgate = (const float*)(ws + WS_TGATE);
                f32x4 g4[4], b4[4];
#pragma unroll
                for (int j = 0; j < 4; ++j) { g4[j] = *((const f32x4*)(ln2_g + l * DM) + lane + 64 * j); b4[j] = *((const f32x4*)(ln2_b + l * DM) + lane + 64 * j); }
                for (int m = gw; m < M; m += NGW) {
                    const int pa = tpos[m * 2], pb = tpos[m * 2 + 1]; const float ga = tgate[m * 2], gb = tgate[m * 2 + 1];
                    const size_t ra = (size_t)T[pa >> 20] * 256 + (pa & 0xfffff), rb = (size_t)T[pb >> 20] * 256 + (pb & 0xfffff);
                    f32x4 v[4];
#pragma unroll
                    for (int j = 0; j < 4; ++j) { const u32x2 ya = *((const u32x2*)(Y + ra * DM) + lane + 64 * j), yb = *((const u32x2*)(Y + rb * DM) + lane + 64 * j);
                        const f32x4 xv = *((const f32x4*)(X + (size_t)m * DM) + lane + 64 * j);
                        v[j][0] = ALPHA * xv[0] + ga * bf_lo(ya.x) + gb * bf_lo(yb.x); v[j][1] = ALPHA * xv[1] + ga * bf_hi(ya.x) + gb * bf_hi(yb.x);
                        v[j][2] = ALPHA * xv[2] + ga * bf_lo(ya.y) + gb * bf_lo(yb.y); v[j][3] = ALPHA * xv[3] + ga * bf_hi(ya.y) + gb * bf_hi(yb.y); }
                    ln_core(v, g4, b4); ln_store(v, X + (size_t)m * DM, nullptr, lane); }
            }
        }
    }
}

extern "C" void kernel_launch(void* const* d_in, const int* in_sizes, int n_in, void* d_out, int out_size, void* d_ws, size_t ws_size, hipStream_t stream) {
    static int grid = 0;
    if (grid == 0) {
        if (n_in != 26 || in_sizes[0] != M * DM || out_size != M * DM || ws_size < WS_END) { fprintf(stderr, "kernel_launch: unexpected shapes (n_in %d, ws %zu < %zu)\n", n_in, ws_size, (size_t)WS_END); grid = -1; return; }
        int dev = 0, cus = 0, per_cu = 0;
        if (hipGetDevice(&dev) != hipSuccess || hipDeviceGetAttribute(&cus, hipDeviceAttributeMultiprocessorCount, dev) != hipSuccess) { grid = -1; return; }
        if (hipFuncSetAttribute((const void*)mega_fwd, hipFuncAttributeMaxDynamicSharedMemorySize, LDS_BYTES) != hipSuccess) { fprintf(stderr, "kernel_launch: hipFuncSetAttribute failed\n"); grid = -1; return; }
        if (hipOccupancyMaxActiveBlocksPerMultiprocessor(&per_cu, (const void*)mega_fwd, NWAVES * 64, LDS_BYTES) != hipSuccess || per_cu < 1) { fprintf(stderr, "kernel_launch: occupancy query says %d\n", per_cu); }
        (void)hipGetLastError();
        grid = cus;
    }
    if (grid < 0) return;
    if (hipMemsetAsync((char*)d_ws + WS_CTL, 0, CTL_ZERO_BYTES, stream) != hipSuccess) return;
    Args a{};
    for (int i = 0; i < 26; ++i) a.in[i] = (const float*)d_in[i];
    a.out = (float*)d_out; a.ws = (unsigned char*)d_ws;
    hipLaunchKernelGGL(mega_fwd, dim3(grid), dim3(NWAVES * 64), LDS_BYTES, stream, a);
}
```

```cpp
#include <hip/hip_runtime.h>
#include <cstdio>
#include <cstdint>
#include <cmath>

constexpr int BATCH = 16, SEQ = 2048, DM = 1024, M = BATCH * SEQ, DEPTH = 2;
constexpr int D_IN = 2048, D_FF = 2816, N_EXP = 8, D_FFE = 3584;
constexpr float LN_EPS = 1e-5f, RMS_EPS = 1e-6f;
constexpr float ALPHA = 1.41421356237309515f;
constexpr float LOG2E = 1.4426950408889634f;
constexpr float EGU_SCALE = 64.f, ED_SCALE = 128.f;
constexpr int NWAVES = 8;
#ifndef DENSE_FP8
#define DENSE_FP8 0
#endif
#ifndef DUP_P0
#define DUP_P0 1
#endif
#ifndef DUP_P1
#define DUP_P1 1
#endif
#ifndef DUP_P2
#define DUP_P2 1
#endif
#ifndef DUP_B
#define DUP_B 1
#endif
#ifndef DUP_C
#define DUP_C 1
#endif
#ifndef DUP_D
#define DUP_D 1
#endif
#ifndef DUP_GU
#define DUP_GU 1
#endif
#ifndef DUP_MOE
#define DUP_MOE 1
#endif

#define GAS __attribute__((address_space(1)))
#define LAS __attribute__((address_space(3)))
typedef unsigned short bf16_t;
typedef short bf16x8 __attribute__((ext_vector_type(8)));
typedef float f32x4 __attribute__((ext_vector_type(4)));
typedef float f32x2 __attribute__((ext_vector_type(2)));
typedef float f32x16 __attribute__((ext_vector_type(16)));
typedef unsigned u32x4 __attribute__((ext_vector_type(4)));
typedef unsigned u32x2 __attribute__((ext_vector_type(2)));
typedef short s16x4 __attribute__((ext_vector_type(4)));
typedef __bf16 bf16x2_t __attribute__((ext_vector_type(2)));
typedef GAS unsigned gu32;

__device__ __forceinline__ unsigned pkbf(float lo, float hi) { f32x2 v = {lo, hi}; bf16x2_t b = __builtin_convertvector(v, bf16x2_t); return __builtin_bit_cast(unsigned, b); }
typedef int i32x4 __attribute__((ext_vector_type(4)));
typedef int i32x8 __attribute__((ext_vector_type(8)));
__device__ __forceinline__ float clamp8(float v) { return __builtin_fminf(__builtin_fmaxf(v, -448.f), 448.f); }
__device__ __forceinline__ unsigned pk4_fp8(float a, float b, float c, float d) { int w = __builtin_amdgcn_cvt_pk_fp8_f32(clamp8(a), clamp8(b), 0, false); w = __builtin_amdgcn_cvt_pk_fp8_f32(clamp8(c), clamp8(d), w, true); return (unsigned)w; }
__device__ __forceinline__ float bf_lo(unsigned w) { return __uint_as_float(w << 16); }
__device__ __forceinline__ float bf_hi(unsigned w) { return __uint_as_float(w & 0xffff0000u); }
__device__ __forceinline__ int lane_id() { int l; asm volatile("v_mbcnt_lo_u32_b32 %0, -1, 0\n\tv_mbcnt_hi_u32_b32 %0, -1, %0" : "=v"(l)); return l; }
template <int K> __device__ __forceinline__ float xor_lane(float v) { return __int_as_float(__builtin_amdgcn_ds_swizzle(__float_as_int(v), (K << 10) | 0x1f)); }
__device__ __forceinline__ float sum_xor32(float v) { auto rr = __builtin_amdgcn_permlane32_swap(__float_as_uint(v), __float_as_uint(v), false, false); return __uint_as_float(rr[0]) + __uint_as_float(rr[1]); }
__device__ __forceinline__ float wave_sum(float v) {
    v += xor_lane<1>(v); v += xor_lane<2>(v); v += xor_lane<4>(v); v += xor_lane<8>(v); v += xor_lane<16>(v);
    return sum_xor32(v);
}

constexpr size_t MiB = 1u << 20;
constexpr size_t WS_CTL = 0, CTL_ZERO_BYTES = 1 * MiB;
constexpr size_t WS_ROPEC = 1 * MiB, WS_ROPES = 1 * MiB + 256 * 1024;
constexpr size_t WS_LTOK = 2 * MiB;
constexpr size_t WS_TPOS = 3 * MiB, WS_TGATE = 3 * MiB + 512 * 1024;
constexpr size_t WS_WIN = 4 * MiB;
constexpr size_t WS_WOUT = 12 * MiB;
constexpr size_t WS_WGU = 16 * MiB;
constexpr size_t WS_WD = 27 * MiB;
constexpr size_t WS_EGU = 33 * MiB;
constexpr size_t WS_ED = 89 * MiB;
constexpr size_t WS_XN = 201 * MiB;
constexpr size_t WS_R = 265 * MiB;
constexpr size_t WS_PJ = WS_R;
constexpr size_t WS_MIX = WS_R + 128 * MiB;
constexpr size_t WS_H = WS_R;
constexpr size_t WS_XN8 = 117 * MiB;
constexpr size_t WS_Y = 149 * MiB;
constexpr size_t WS_HC = 281 * MiB;
constexpr size_t WS_END = 512 * MiB;
static_assert(WS_ED + (size_t)8 * DM * D_FFE <= WS_XN8 && WS_HC + (size_t)264 * 256 * D_FFE <= WS_END && WS_R + 192 * MiB <= WS_END, "ws map (MoE overlay)");
static_assert(WS_WD + (size_t)DM * D_FF * 2 <= WS_EGU && WS_EGU + (size_t)16 * DM * D_FFE <= WS_ED && WS_ED + (size_t)8 * DM * D_FFE <= WS_XN, "ws map");
constexpr int CW_TMO = 0, CW_BAR = 4096, CW_CNT = 8192, CW_Q = 9216, CW_NRM = 12288;
constexpr int CHUNK_TILES = 264;

constexpr int RING_BYTES = 131072;
constexpr int MISC_OFF = RING_BYTES;
constexpr int LDS_BYTES = 147456;
constexpr int VN_OFF = MISC_OFF + 2048;
static_assert(VN_OFF + 8192 <= LDS_BYTES, "LDS map");

#define XB_TMO      128
#define XB_XCNT(j)  (256  + 64 * (j))
#define XB_XSUB(j)  (1280 + 64 * (j))
#define XB_XGEN(j)  (2304 + 64 * (j))
#define XB_TOP      3328
#define XB_TOPGEN   3392
#define XCD_BAR_WORDS 3456
#define XB_SPIN_CAP (1u << 18)
__device__ __forceinline__ unsigned xb_ld(unsigned* p)              { return __hip_atomic_load(p, __ATOMIC_RELAXED, __HIP_MEMORY_SCOPE_AGENT); }
__device__ __forceinline__ unsigned xb_add(unsigned* p, unsigned v) { return __hip_atomic_fetch_add(p, v, __ATOMIC_RELAXED, __HIP_MEMORY_SCOPE_AGENT); }
__device__ __forceinline__ unsigned xb_xcc_id() { return (unsigned)__builtin_amdgcn_s_getreg((3 << 11) | 20) & 0xFu; }
#define XB_SPIN(cond, bar) do { unsigned _sp = 0; while (cond) { __builtin_amdgcn_s_sleep(1); \
    if ((++_sp & 255u) == 0u) { if (xb_ld(&(bar)[XB_TMO])) break; if (_sp > XB_SPIN_CAP) { atomicAdd(&(bar)[XB_TMO], 1u); break; } } } } while (0)
struct XcdBarrier { unsigned* bar; unsigned x; volatile LAS unsigned* st; };
__device__ __forceinline__ XcdBarrier xcd_barrier_post(unsigned* bar, volatile LAS unsigned* st, bool t0) {
    XcdBarrier b; b.bar = bar; b.x = xb_xcc_id(); b.st = st;
    if (t0) (void)xb_add(&bar[XB_XCNT(b.x)], 1u);
    return b;
}
__device__ __forceinline__ void xcd_barrier_complete(unsigned* bar, unsigned x, unsigned& nloc, unsigned& nx) {
    const unsigned G = gridDim.x * gridDim.y * gridDim.z;
    unsigned sum, cnt, mine, sp = 0u;
    for (;;) {
        sum = 0u; cnt = 0u; mine = 0u;
#pragma unroll
        for (unsigned j = 0; j < 16; ++j) { const unsigned c = xb_ld(&bar[XB_XCNT(j)]); sum += c; cnt += (c > 0u) ? 1u : 0u; mine = (j == x) ? c : mine; }
        if (sum == G) break;
        __builtin_amdgcn_s_sleep(1);
        if ((++sp & 255u) == 0u) { if (xb_ld(&bar[XB_TMO])) break; if (sp > XB_SPIN_CAP) { atomicAdd(&bar[XB_TMO], 1u); break; } }
    }
    nloc = mine > 0u ? mine : 1u; nx = cnt > 0u ? cnt : 1u;
}
__device__ __forceinline__ void xcd_barrier(const XcdBarrier& b, bool t0) {
    asm volatile("s_waitcnt vmcnt(0)" ::: "memory");
    __syncthreads();
    if (t0) {
        unsigned* bar = b.bar; asm volatile("" : "+s"(bar));
        __builtin_amdgcn_s_waitcnt(0);
        unsigned nloc = b.st[0], nx = b.st[1];
        unsigned bx = b.x; asm volatile("" : "+s"(bx));
        if (nloc == 0u) { xcd_barrier_complete(bar, bx, nloc, nx); b.st[0] = nloc; b.st[1] = nx; }
        const unsigned old = xb_add(&bar[XB_XSUB(bx)], 1u);
        const unsigned gen = old / nloc;
        if (old + 1u == (gen + 1u) * nloc) {
            __builtin_amdgcn_fence(__ATOMIC_RELEASE, "agent");
            asm volatile("s_waitcnt vmcnt(0)" ::: "memory");
            const unsigned og = xb_add(&bar[XB_TOP], 1u);
            const unsigned tg = og / nx;
            if (og + 1u == (tg + 1u) * nx) xb_add(&bar[XB_TOPGEN], 1u);
            else XB_SPIN(xb_ld(&bar[XB_TOPGEN]) == tg, bar);
            __builtin_amdgcn_fence(__ATOMIC_ACQUIRE, "agent");
            xb_add(&bar[XB_XGEN(bx)], 1u);
            asm volatile("s_waitcnt vmcnt(0)" ::: "memory");
        } else {
            XB_SPIN(xb_ld(&bar[XB_XGEN(bx)]) == gen, bar);
            __builtin_amdgcn_fence(__ATOMIC_ACQUIRE, "agent");
            asm volatile("s_waitcnt vmcnt(0)" ::: "memory");
        }
    }
    __syncthreads();
}

namespace pg8 {
constexpr int BM = 256, BK = 64, HALF = 128, HTB = HALF * BK * 2, STAGE_BYTES = 8 * HTB, NXCD = 8, WGM = 8;
__device__ __forceinline__ int lds_byte(int r, int c) { const int st = (r >> 4) * 2 + (c >> 5), rr = r & 15, cc = c & 31, ob = rr * 64 + cc * 2; return st * 1024 + (ob ^ (((ob >> 9) & 1) << 5)); }
__device__ __forceinline__ void stage_rc(int b, int& R, int& C) { const int st = b / 1024, sb = b % 1024, swz = sb ^ (((sb >> 9) & 1) << 5); R = (st >> 1) * 16 + swz / 64; C = (st & 1) * 32 + (swz % 64) / 2; }
__device__ __forceinline__ int perm32(int rho) { const int n = rho >> 4, i = rho & 15; return 8 * (i >> 2) + 4 * n + (i & 3); }

struct Unit { int pm, pn, e, p0, cnt; };
struct Gemm { const void* A; const void* Bt; int K; size_t estride; };

__device__ __forceinline__ bool grid_order(int i, int G, int c, int nM, int nN, int& pm, int& pn) {
    const int nwg = nM * nN; const long L = (long)i * G + c; if (L >= nwg) return false;
    int wgid = (int)L; { const int q = nwg / NXCD, r = nwg % NXCD, xcd = wgid % NXCD, off = wgid / NXCD; wgid = (xcd < r ? xcd * (q + 1) : r * (q + 1) + (xcd - r) * q) + off; }
    const int nig = WGM * nN, gid = wgid / nig, fm = gid * WGM, gsz = (nM - fm) < WGM ? (nM - fm) : WGM;
    pm = fm + ((wgid % nig) % gsz); pn = (wgid % nig) / gsz; return true;
}
struct StaticOrder {
    int nM, nN, G, c;
    __device__ void init(int Mrows, int N, int G_, int c_) { nM = Mrows / BM; nN = N / BM; G = G_; c = c_; }
    __device__ __forceinline__ bool next(int i, Unit& u) const { u.e = 0; u.p0 = 0; u.cnt = 0; return grid_order(i, G, c, nM, nN, u.pm, u.pn); }
    __device__ __forceinline__ int arow(const Unit& u, int r) const { return u.pm * BM + r; }
};

template <class Epi, class Sched, bool ALIGN_EPI, bool GATHER = false, int ES = 2>
__device__ __forceinline__ void gemm_phase(LAS unsigned char* lds, const Gemm g, const Sched& S, const Epi& E, int wave0) {
    int tid = wave0 * 64 + lane_id(); asm volatile("" : "+v"(tid));
    const int wid = __builtin_amdgcn_readfirstlane(tid >> 6), lane = tid & 63, wr = wid >> 2, wc = wid & 3, fr = lane & 15, fq = lane >> 4;
    const int K = g.K, nt = K * ES / 128;
    unsigned voffA, voffB;
    { int R, C; stage_rc(tid * 16, R, C); const int Rb = Epi::PERM ? ((R & ~31) + perm32(R & 31)) : R; voffA = (unsigned)(R * K * ES + C * 2); voffB = (unsigned)(Rb * K * ES + C * 2); }
    const unsigned pstep = (unsigned)(64 * K * ES);
    const unsigned kstep = 128u;
    const unsigned hstep = (unsigned)(HALF * K * ES);
    const unsigned tstep = 2u * hstep;
    const unsigned ldsw = (unsigned)wid * 1024u;
    const unsigned lp = (unsigned)lds_byte(fr, fq * 8); const unsigned aS = (unsigned)wr * 8192u, bS = (unsigned)wc * 4096u;
#define PG8_ADDR(soff) ({ unsigned _t = lp; asm volatile("" : "+v"(_t)); _t + (soff); })
    const __amdgpu_buffer_rsrc_t rA = __builtin_amdgcn_make_buffer_rsrc(const_cast<void*>(g.A), 0, 0x7fffffff, 0x00020000);
    const __amdgpu_buffer_rsrc_t rB = __builtin_amdgcn_make_buffer_rsrc(const_cast<void*>(g.Bt), 0, 0x7fffffff, 0x00020000);
#define PG8_SA(b, h) (((b) * 2 + (h)) * HTB)
#define PG8_SB(b, h) ((4 + (b) * 2 + (h)) * HTB)
#define PG8_STAGE(bufoff, rsrc, soff, voff) do { _Pragma("unroll") for (int _i = 0; _i < 2; ++_i) \
        __builtin_amdgcn_raw_ptr_buffer_load_lds(rsrc, (LAS unsigned*)(lds + (bufoff) + ldsw + _i * 8192), 16, (voff), (int)((soff) + _i * pstep), 0, 0); } while (0)
#define PG8_STAGE_G(bufoff, rsrc, soff, V) do { _Pragma("unroll") for (int _i = 0; _i < 2; ++_i) \
        __builtin_amdgcn_raw_ptr_buffer_load_lds(rsrc, (LAS unsigned*)(lds + (bufoff) + ldsw + _i * 8192), 16, (V)[_i], (int)(soff), 0, 0); } while (0)
#define PG8_STAGE_A(bufoff, uo, kb, h, V) do { if constexpr (GATHER) { PG8_STAGE_G(bufoff, rA, (kb), (V)[h]); } else { PG8_STAGE(bufoff, rA, (uo) + (kb) + (h) * hstep, voffA); } } while (0)
#define PG8_AOFF(dst, u) do { const int _t = wid * 64 + lane_id(); _Pragma("unroll") for (int _i = 0; _i < 2; ++_i) { int _R, _C; stage_rc(_t * 16 + _i * 8192, _R, _C); _Pragma("unroll") for (int _h = 0; _h < 2; ++_h) \
        dst[_h][_i] = (unsigned)S.arow(u, _R + _h * HALF) * (unsigned)(K * ES) + (unsigned)_C * 2u; } } while (0)
#define PG8_FR(p) (*(const LAS bf16x8*)(p))
#define PG8_FR8(p) __builtin_shufflevector(__builtin_bit_cast(i32x4, PG8_FR(p)), __builtin_bit_cast(i32x4, PG8_FR((p) + 1024)), 0, 1, 2, 3, 4, 5, 6, 7)
#define PG8_LDA(dst, b, h) do { const unsigned aoff = PG8_ADDR(aS); _Pragma("unroll") for (int m = 0; m < 4; ++m) { if constexpr (ES == 2) { _Pragma("unroll") for (int k = 0; k < 2; ++k) dst[m][k] = PG8_FR(lds + PG8_SA(b, h) + aoff + m * 2048 + k * 1024); } \
        else dst##8[m] = PG8_FR8(lds + PG8_SA(b, h) + aoff + m * 2048); } } while (0)
#define PG8_LDB(dst, b, h) do { const unsigned boff = PG8_ADDR(bS); _Pragma("unroll") for (int n = 0; n < 2; ++n) { if constexpr (ES == 2) { _Pragma("unroll") for (int k = 0; k < 2; ++k) dst[n][k] = PG8_FR(lds + PG8_SB(b, h) + boff + n * 2048 + k * 1024); } \
        else dst##8[n] = PG8_FR8(lds + PG8_SB(b, h) + boff + n * 2048); } } while (0)
#define PG8_MMA(ai, bj, At, Bt) do { __builtin_amdgcn_s_setprio(1); _Pragma("unroll") for (int m = 0; m < 4; ++m) _Pragma("unroll") for (int n = 0; n < 2; ++n) { \
        if constexpr (ES == 2) { _Pragma("unroll") for (int k = 0; k < 2; ++k) acc[ai][bj][m][n] = __builtin_amdgcn_mfma_f32_16x16x32_bf16(Bt[n][k], At[m][k], acc[ai][bj][m][n], 0, 0, 0); } \
        else { asm volatile("v_mfma_f32_16x16x128_f8f6f4 %0, %1, %2, %0" : "+v"(acc[ai][bj][m][n]) : "v"(Bt##8[n]), "v"(At##8[m])); } } \
        __builtin_amdgcn_s_setprio(0); } while (0)
#define PG8_WAIT_V(n) asm volatile("s_waitcnt vmcnt(" #n ")" ::: "memory")
#define PG8_WAIT_L(n) asm volatile("s_waitcnt lgkmcnt(" #n ")" ::: "memory")
#define PG8_BAR __builtin_amdgcn_s_barrier()
#define PG8_SCHED __builtin_amdgcn_sched_barrier(0)
    Unit cur, nxt; int ui = 0;
    if (!S.next(0, cur)) return;
    f32x4 acc[2][2][4][2];
#pragma unroll
    for (int a = 0; a < 2; ++a)
#pragma unroll
        for (int b = 0; b < 2; ++b)
#pragma unroll
            for (int m = 0; m < 4; ++m)
#pragma unroll
                for (int n = 0; n < 2; ++n) acc[a][b][m][n] = (f32x4){0.f, 0.f, 0.f, 0.f};
    bf16x8 At[4][2], B0[2][2], B1[2][2];
    i32x8 At8[4], B08[2], B18[2];
    unsigned vc[2][2];
    LAS u32x4* vstash = (LAS u32x4*)(lds + VN_OFF - 0) + tid;
    if constexpr (GATHER) { PG8_AOFF(vc, cur); }
    unsigned cA = GATHER ? 0u : (unsigned)S.arow(cur, 0) * (unsigned)(K * ES);
    unsigned cB = (unsigned)cur.e * (unsigned)g.estride + (unsigned)cur.pn * tstep;
    PG8_STAGE(PG8_SB(0, 0), rB, cB, voffB); PG8_STAGE(PG8_SB(0, 1), rB, cB + hstep, voffB); PG8_STAGE_A(PG8_SA(0, 0), cA, 0u, 0, vc); PG8_STAGE_A(PG8_SA(0, 1), cA, 0u, 1, vc);
    if (wr == 1) PG8_BAR;
    PG8_WAIT_V(2); PG8_BAR;
    PG8_STAGE(PG8_SB(1, 0), rB, cB + kstep, voffB); PG8_STAGE_A(PG8_SA(1, 0), cA, kstep, 0, vc); PG8_STAGE(PG8_SB(1, 1), rB, cB + hstep + kstep, voffB);
    PG8_WAIT_V(6); PG8_BAR;
    for (;;) {
        const bool has_next = S.next(ui + 1, nxt);
        if constexpr (GATHER) { unsigned vn[2][2];
            if (has_next) { PG8_AOFF(vn, nxt); } else {
#pragma unroll
                for (int h = 0; h < 2; ++h)
#pragma unroll
                    for (int i = 0; i < 2; ++i) vn[h][i] = vc[h][i]; }
            *vstash = (u32x4){vn[0][0], vn[0][1], vn[1][0], vn[1][1]}; }
        const unsigned nA = GATHER ? 0u : (has_next ? (unsigned)S.arow(nxt, 0) * (unsigned)(K * ES) : cA);
        const unsigned nB = has_next ? (unsigned)nxt.e * (unsigned)g.estride + (unsigned)nxt.pn * tstep : cB;
        for (int t = 0; t < nt; t += 2) {
            const bool last = (t == nt - 2);
            const unsigned k1 = (unsigned)(t + 1) * kstep;
            const unsigned k2 = last ? 0u : (unsigned)(t + 2) * kstep, k3 = k2 + kstep;
            const unsigned a2 = last ? nA : cA;
            const unsigned b2 = last ? nB : cB + (unsigned)(t + 2) * kstep, b3 = b2 + kstep;
            PG8_LDB(B0, 0, 0); PG8_LDB(B1, 0, 1); PG8_SCHED; PG8_LDA(At, 0, 0); PG8_STAGE_A(PG8_SA(1, 1), cA, k1, 1, vc);
            if constexpr (GATHER) { if (last) { const u32x4 vv = *vstash; vc[0][0] = vv[0]; vc[0][1] = vv[1]; vc[1][0] = vv[2]; vc[1][1] = vv[3]; } }
            PG8_WAIT_V(8); PG8_WAIT_L(0); PG8_BAR; PG8_MMA(0, 0, At, B0); PG8_MMA(0, 1, At, B1); PG8_BAR; PG8_SCHED;
            PG8_LDA(At, 0, 1); PG8_STAGE(PG8_SB(0, 0), rB, b2, voffB); PG8_STAGE(PG8_SB(0, 1), rB, b2 + hstep, voffB); PG8_STAGE_A(PG8_SA(0, 0), a2, k2, 0, vc);
            PG8_WAIT_V(8); PG8_WAIT_L(0); PG8_BAR; PG8_MMA(1, 0, At, B0); PG8_MMA(1, 1, At, B1); PG8_BAR; PG8_SCHED;
            PG8_LDB(B0, 1, 0); PG8_LDB(B1, 1, 1); PG8_SCHED; PG8_LDA(At, 1, 0); PG8_STAGE_A(PG8_SA(0, 1), a2, k2, 1, vc);
            PG8_WAIT_V(8); PG8_WAIT_L(0); PG8_BAR; PG8_MMA(0, 0, At, B0); PG8_MMA(0, 1, At, B1); PG8_BAR; PG8_SCHED;
            PG8_LDA(At, 1, 1); PG8_STAGE(PG8_SB(1, 0), rB, b3, voffB); PG8_STAGE(PG8_SB(1, 1), rB, b3 + hstep, voffB); PG8_STAGE_A(PG8_SA(1, 0), a2, k3, 0, vc);
            PG8_WAIT_V(8); PG8_WAIT_L(0); PG8_BAR; PG8_MMA(1, 0, At, B0); PG8_MMA(1, 1, At, B1); PG8_BAR; PG8_SCHED;
        }
        if constexpr (ALIGN_EPI) { if (wr == 0) PG8_BAR; }
        if constexpr (ES == 1) asm volatile("s_nop 15\n\ts_nop 15" ::: "memory");
        { const int l2 = lane_id(); E(acc, cur, wr, wc, l2 & 15, l2 >> 4); }
        if (!has_next) break;
#pragma unroll
        for (int a = 0; a < 2; ++a)
#pragma unroll
            for (int b = 0; b < 2; ++b)
#pragma unroll
                for (int m = 0; m < 4; ++m)
#pragma unroll
                    for (int n = 0; n < 2; ++n) acc[a][b][m][n] = (f32x4){0.f, 0.f, 0.f, 0.f};
        cur = nxt; cA = nA; cB = nB; ++ui;
        if constexpr (ALIGN_EPI) { if (wr == 1) PG8_BAR; }
    }
    PG8_WAIT_V(0);
    if constexpr (!ALIGN_EPI) { if (wr == 0) PG8_BAR; }
    PG8_BAR;
#undef PG8_SA
#undef PG8_SB
#undef PG8_STAGE
#undef PG8_STAGE_G
#undef PG8_STAGE_A
#undef PG8_AOFF
#undef PG8_LDA
#undef PG8_LDB
#undef PG8_MMA
#undef PG8_FR
#undef PG8_ADDR
#undef PG8_FR8
#undef PG8_WAIT_V
#undef PG8_WAIT_L
#undef PG8_BAR
#undef PG8_SCHED
}

struct EpiProj {
    static constexpr bool PERM = true;
    bf16_t* PJ; const float* qn; const float* kn; const float* ropec; const float* ropes; unsigned* nrm;
    __device__ __forceinline__ void operator()(const f32x4 (&acc)[2][2][4][2], const Unit& u, int wr, int wc, int fr, int fq) const {
        const int row0 = u.pm * BM + wr * 64 + fr, pn = u.pn;
        const bool htype = (pn == 1) || (pn == 2);
        const bool roped = (pn == 1) || (pn == 2 && wc < 2);
        if (!htype) {
            const float sc = (pn == 3) ? 0.17677669529663687f * LOG2E : (pn == 6 ? 0.125f * LOG2E : 1.f);
            const int col0 = pn * BM + wc * 32 + 8 * fq;
            float nmax[2] = {0.f, 0.f};
#pragma unroll
            for (int ai = 0; ai < 2; ++ai)
#pragma unroll
                for (int m = 0; m < 4; ++m) { bf16_t* rowp = PJ + (size_t)(row0 + ai * HALF + m * 16) * D_IN + col0;
#pragma unroll
                    for (int bj = 0; bj < 2; ++bj) { const f32x4 v0 = acc[ai][bj][m][0] * sc, v1 = acc[ai][bj][m][1] * sc;
                        u32x4 w; w.x = pkbf(v0[0], v0[1]); w.y = pkbf(v0[2], v0[3]); w.z = pkbf(v1[0], v1[1]); w.w = pkbf(v1[2], v1[3]);
                        *(u32x4*)(rowp + bj * HALF) = w;
                        if (pn == 3 || pn == 4) { float ss = (v0[0] * v0[0] + v0[1] * v0[1]) + (v0[2] * v0[2] + v0[3] * v0[3]) + (v1[0] * v1[0] + v1[1] * v1[1]) + (v1[2] * v1[2] + v1[3] * v1[3]);
                            ss += xor_lane<16>(ss); ss = sum_xor32(ss); nmax[bj] = __builtin_fmaxf(nmax[bj], ss); } } }
            if (pn == 3 || pn == 4) {
#pragma unroll
                for (int bj = 0; bj < 2; ++bj) { float v = nmax[bj]; v = __builtin_fmaxf(v, xor_lane<1>(v)); v = __builtin_fmaxf(v, xor_lane<2>(v)); v = __builtin_fmaxf(v, xor_lane<4>(v)); v = __builtin_fmaxf(v, xor_lane<8>(v));
                    if (fr == 0 && fq == 0) { const int b = (u.pm * BM) / SEQ, h = 2 * bj + (wc >> 1), c = wc & 1;
                        __hip_atomic_fetch_max(nrm + ((pn - 3) * 16 + b) * 8 + h * 2 + c, __float_as_uint(v), __ATOMIC_RELAXED, __HIP_MEMORY_SCOPE_AGENT); } }
            }
        } else {
            const int colh = pn * BM + wc * 64 + 8 * fq;
            if (!roped) {
#pragma unroll
                for (int ai = 0; ai < 2; ++ai)
#pragma unroll
                    for (int m = 0; m < 4; ++m) { bf16_t* rowp = PJ + (size_t)(row0 + ai * HALF + m * 16) * D_IN + colh;
#pragma unroll
                        for (int bj = 0; bj < 2; ++bj) { const f32x4 v0 = acc[ai][bj][m][0], v1 = acc[ai][bj][m][1];
                            u32x4 w; w.x = pkbf(v0[0], v0[1]); w.y = pkbf(v0[2], v0[3]); w.z = pkbf(v1[0], v1[1]); w.w = pkbf(v1[2], v1[3]);
                            *(u32x4*)(rowp + bj * 32) = w; } }
            } else {
                const float* nw = (pn == 1) ? qn : kn; const float osc = (pn == 1) ? 0.125f * LOG2E : 1.f;
                f32x4 w1[2], w2[2];
#pragma unroll
                for (int bj = 0; bj < 2; ++bj) { w1[bj] = *(const f32x4*)(nw + 32 * bj + 4 * fq); w2[bj] = *(const f32x4*)(nw + 32 * bj + 16 + 4 * fq); }
#pragma unroll
                for (int ai = 0; ai < 2; ++ai)
#pragma unroll
                    for (int m = 0; m < 4; ++m) {
                        const int row = row0 + ai * HALF + m * 16, s = row & (SEQ - 1);
                        float ss = 0.f;
#pragma unroll
                        for (int bj = 0; bj < 2; ++bj)
#pragma unroll
                            for (int n = 0; n < 2; ++n) { const f32x4 x = acc[ai][bj][m][n]; ss += (x[0] * x[0] + x[1] * x[1]) + (x[2] * x[2] + x[3] * x[3]); }
                        ss += xor_lane<16>(ss); ss = sum_xor32(ss);
                        const float rinv = 1.0f / sqrtf(ss * (1.f / 64.f) + RMS_EPS);
                        bf16_t* rowp = PJ + (size_t)row * D_IN + colh;
#pragma unroll
                        for (int bj = 0; bj < 2; ++bj) {
                            const f32x4 c = *(const f32x4*)(ropec + s * 32 + bj * 16 + 4 * fq), sn = *(const f32x4*)(ropes + s * 32 + bj * 16 + 4 * fq);
                            const f32x4 x1 = acc[ai][bj][m][0] * rinv * w1[bj], x2 = acc[ai][bj][m][1] * rinv * w2[bj];
                            const f32x4 o1 = (x1 * c - x2 * sn) * osc, o2 = (x2 * c + x1 * sn) * osc;
                            u32x4 w; w.x = pkbf(o1[0], o1[1]); w.y = pkbf(o1[2], o1[3]); w.z = pkbf(o2[0], o2[1]); w.w = pkbf(o2[2], o2[3]);
                            *(u32x4*)(rowp + bj * 32) = w; }
                    }
            }
        }
    }
};
struct EpiResid {
    static constexpr bool PERM = false;
    float* X; float sc;
    __device__ __forceinline__ void operator()(const f32x4 (&acc)[2][2][4][2], const Unit& u, int wr, int wc, int fr, int fq) const {
        const int row0 = u.pm * BM + wr * 64 + fr, col0 = u.pn * BM + wc * 32 + 4 * fq;
#pragma unroll
        for (int ai = 0; ai < 2; ++ai)
#pragma unroll
            for (int m = 0; m < 4; ++m) { float* rowp = X + (size_t)(row0 + ai * HALF + m * 16) * DM + col0;
#pragma unroll
                for (int bj = 0; bj < 2; ++bj)
#pragma unroll
                    for (int n = 0; n < 2; ++n) { f32x4* p = (f32x4*)(rowp + bj * HALF + n * 16); *p = *p * ALPHA + acc[ai][bj][m][n] * sc; } }
    }
};
template <bool OUT8>
struct EpiSwiGLU {
    static constexpr bool PERM = true;
    void* H; int ldh; int rt0;
    __device__ __forceinline__ void operator()(const f32x4 (&acc)[2][2][4][2], const Unit& u, int wr, int wc, int fr, int fq) const {
        const int row0 = (u.pm - rt0) * BM + wr * 64 + fr, col0 = u.pn * HALF + wc * 32 + 8 * fq;
#pragma unroll
        for (int ai = 0; ai < 2; ++ai)
#pragma unroll
            for (int m = 0; m < 4; ++m) {
                float o[8];
#pragma unroll
                for (int n = 0; n < 2; ++n)
#pragma unroll
                    for (int j = 0; j < 4; ++j) { const float isc = OUT8 ? 1.0f / EGU_SCALE : 1.0f; const float gv = acc[ai][0][m][n][j] * isc, uv = acc[ai][1][m][n][j] * isc;
                        o[4 * n + j] = gv * __builtin_amdgcn_rcpf(1.0f + __builtin_amdgcn_exp2f(-gv * LOG2E)) * uv; }
                if constexpr (OUT8) { u32x2 w; w.x = pk4_fp8(o[0], o[1], o[2], o[3]); w.y = pk4_fp8(o[4], o[5], o[6], o[7]);
                    *(u32x2*)((unsigned char*)H + (size_t)(row0 + ai * HALF + m * 16) * ldh + col0) = w; }
                else { u32x4 w; w.x = pkbf(o[0], o[1]); w.y = pkbf(o[2], o[3]); w.z = pkbf(o[4], o[5]); w.w = pkbf(o[6], o[7]);
                    *(u32x4*)((bf16_t*)H + (size_t)(row0 + ai * HALF + m * 16) * ldh + col0) = w; } }
    }
};
struct EpiBf16 {
    static constexpr bool PERM = true;
    bf16_t* O; int ldc; float sc;
    __device__ __forceinline__ void operator()(const f32x4 (&acc)[2][2][4][2], const Unit& u, int wr, int wc, int fr, int fq) const {
        const int row0 = u.pm * BM + wr * 64 + fr, col0 = u.pn * BM + wc * 32 + 8 * fq;
#pragma unroll
        for (int ai = 0; ai < 2; ++ai)
#pragma unroll
            for (int m = 0; m < 4; ++m) { bf16_t* rowp = O + (size_t)(row0 + ai * HALF + m * 16) * ldc + col0;
#pragma unroll
                for (int bj = 0; bj < 2; ++bj) { const f32x4 v0 = acc[ai][bj][m][0] * sc, v1 = acc[ai][bj][m][1] * sc;
                    u32x4 w; w.x = pkbf(v0[0], v0[1]); w.y = pkbf(v0[2], v0[3]); w.z = pkbf(v1[0], v1[1]); w.w = pkbf(v1[2], v1[3]);
                    *(u32x4*)(rowp + bj * HALF) = w; } }
    }
};
}

struct MoeTable { volatile LAS int* T; };
__device__ __forceinline__ int moe_expert_of(const MoeTable& t, int rt) { int e = 0;
#pragma unroll
    for (int j = 1; j < 8; ++j) e += (rt >= t.T[j]) ? 1 : 0;
    return __builtin_amdgcn_readfirstlane(e); }
struct MoeOrder {
    MoeTable tab; int rt_lo, nM, nN, G, c; const int* ltok; bool gather;
    __device__ __forceinline__ bool next(int i, pg8::Unit& u) const {
        int pm, pn; if (!pg8::grid_order(i, G, c, nM, nN, pm, pn)) return false;
        u.pm = rt_lo + pm; u.pn = pn; u.e = moe_expert_of(tab, u.pm); u.p0 = __builtin_amdgcn_readfirstlane((u.pm - tab.T[u.e]) * 256); u.cnt = __builtin_amdgcn_readfirstlane(tab.T[16 + u.e]); return true; }
    __device__ __forceinline__ int arow(const pg8::Unit& u, int r) const {
        if (gather) { const int p = u.p0 + r; return p < u.cnt ? ltok[u.e * M + p] : 0; }
        return (u.pm - rt_lo) * 256 + r; }
};

namespace att {
constexpr int PJP = D_IN, MXP = DM, SLOTB = 8192;
constexpr int NSLOT = 3;
constexpr int L_K = 0, L_V = NSLOT * SLOTB, L_WS = 2 * NSLOT * SLOTB, L_OST = L_WS + 8 * 512, OST_W = 32 * 68 * 4, L_BYTES = L_OST + 8 * OST_W;
static_assert(L_BYTES <= RING_BYTES, "attention scratch");
constexpr float THR = 8.0f;
__device__ __forceinline__ int crow(int r, int hi) { return (r & 3) + 8 * (r >> 2) + 4 * hi; }
__device__ __forceinline__ void glds16(const void* gsrc, unsigned lds_dst) { unsigned keep;
    asm volatile("s_mov_b32 %0, m0\n\ts_mov_b32 m0, %2\n\ts_nop 0\n\tglobal_load_lds_dwordx4 %1, off\n\ts_mov_b32 m0, %0" : "=&s"(keep) : "v"(gsrc), "s"(lds_dst) : "memory"); }
#define ATT_MX3(a, b, c) __builtin_fmaxf(__builtin_fmaxf((a), (b)), (c))
__device__ __forceinline__ float rowmax(const f32x16& p0, const f32x16& p1) {
    float a = ATT_MX3(p0[0], p0[1], p1[0]), b = ATT_MX3(p0[2], p0[3], p1[1]); a = ATT_MX3(a, p1[2], p1[3]);
#pragma unroll
    for (int r = 4; r < 16; r += 4) { a = ATT_MX3(a, p0[r], p0[r + 1]); b = ATT_MX3(b, p0[r + 2], p0[r + 3]); a = ATT_MX3(a, p1[r], p1[r + 1]); b = ATT_MX3(b, p1[r + 2], p1[r + 3]); }
    float m = __builtin_fmaxf(a, b); auto rr = __builtin_amdgcn_permlane32_swap(__float_as_uint(m), __float_as_uint(m), false, false);
    return __builtin_fmaxf(__uint_as_float(rr[0]), __uint_as_float(rr[1])); }
template <int D0, int NS>
__device__ __forceinline__ void qkt(f32x16& p0, f32x16& p1, const LAS unsigned char* Kslot, const bf16x8* qr, const f32x16& ci0, const f32x16& ci1, int r32, int hi) {
    const LAS unsigned char* kb = Kslot + hi * 1024 + r32 * 16;
#pragma unroll
    for (int s = 0; s < NS; ++s) { const int d0 = D0 + s;
        const bf16x8 b0 = *(const LAS bf16x8*)(kb + d0 * 2048), b1 = *(const LAS bf16x8*)(kb + d0 * 2048 + 512);
        if (s == 0) { p0 = __builtin_amdgcn_mfma_f32_32x32x16_bf16(b0, qr[d0], ci0, 0, 0, 0); p1 = __builtin_amdgcn_mfma_f32_32x32x16_bf16(b1, qr[d0], ci1, 0, 0, 0); }
        else { p0 = __builtin_amdgcn_mfma_f32_32x32x16_bf16(b0, qr[d0], p0, 0, 0, 0); p1 = __builtin_amdgcn_mfma_f32_32x32x16_bf16(b1, qr[d0], p1, 0, 0, 0); } }
}
__device__ __forceinline__ void pv(f32x16* o, int vb, bf16x8 pa0, bf16x8 pa1, bf16x8 pa2, bf16x8 pa3) {
#pragma unroll
    for (int d0 = 0; d0 < 2; ++d0) { s16x4 lo[4], hi[4];
#pragma unroll
        for (int ks = 0; ks < 4; ++ks) {
            asm volatile("ds_read_b64_tr_b16 %0,%1 offset:%c2" : "=&v"(lo[ks]) : "v"(vb), "i"(d0 * 4096 + ks * 1024) : "memory");
            asm volatile("ds_read_b64_tr_b16 %0,%1 offset:%c2" : "=&v"(hi[ks]) : "v"(vb), "i"(d0 * 4096 + ks * 1024 + 512) : "memory"); }
        asm volatile("s_waitcnt lgkmcnt(0)" ::: "memory"); __builtin_amdgcn_sched_barrier(0);
#define ATT_PK(k) (bf16x8){lo[k][0], lo[k][1], lo[k][2], lo[k][3], hi[k][0], hi[k][1], hi[k][2], hi[k][3]}
        o[d0] = __builtin_amdgcn_mfma_f32_32x32x16_bf16(pa0, ATT_PK(0), o[d0], 0, 0, 0);
        o[d0] = __builtin_amdgcn_mfma_f32_32x32x16_bf16(pa1, ATT_PK(1), o[d0], 0, 0, 0);
        o[d0] = __builtin_amdgcn_mfma_f32_32x32x16_bf16(pa2, ATT_PK(2), o[d0], 0, 0, 0);
        o[d0] = __builtin_amdgcn_mfma_f32_32x32x16_bf16(pa3, ATT_PK(3), o[d0], 0, 0, 0);
#undef ATT_PK
    }
}
template <int NC>
__device__ __forceinline__ void pvn(f32x16 (&o)[NC][2], f32x16 (&ol)[NC], int vb, const u32x4 (&pw)[NC][4]) {
    { const bf16x8 ones = (bf16x8){0x3f80, 0x3f80, 0x3f80, 0x3f80, 0x3f80, 0x3f80, 0x3f80, 0x3f80};
#pragma unroll
      for (int ks = 0; ks < 4; ++ks)
#pragma unroll
        for (int c = 0; c < NC; ++c) ol[c] = __builtin_amdgcn_mfma_f32_32x32x16_bf16(__builtin_bit_cast(bf16x8, pw[c][ks]), ones, ol[c], 0, 0, 0); }
#pragma unroll
    for (int d0 = 0; d0 < 2; ++d0) { s16x4 lo[4], hi[4];
#pragma unroll
        for (int ks = 0; ks < 4; ++ks) {
            asm volatile("ds_read_b64_tr_b16 %0,%1 offset:%c2" : "=&v"(lo[ks]) : "v"(vb), "i"(d0 * 4096 + ks * 1024) : "memory");
            asm volatile("ds_read_b64_tr_b16 %0,%1 offset:%c2" : "=&v"(hi[ks]) : "v"(vb), "i"(d0 * 4096 + ks * 1024 + 512) : "memory"); }
        asm volatile("s_waitcnt lgkmcnt(0)" ::: "memory"); __builtin_amdgcn_sched_barrier(0);
#pragma unroll
        for (int ks = 0; ks < 4; ++ks) { const bf16x8 vf = (bf16x8){lo[ks][0], lo[ks][1], lo[ks][2], lo[ks][3], hi[ks][0], hi[ks][1], hi[ks][2], hi[ks][3]};
#pragma unroll
            for (int c = 0; c < NC; ++c) o[c][d0] = __builtin_amdgcn_mfma_f32_32x32x16_bf16(__builtin_bit_cast(bf16x8, pw[c][ks]), vf, o[c][d0], 0, 0, 0); }
    }
}
struct Par { float slope2; float sink2; float lam; float oscale; const float* subln; int dcut; };
template <int VAR>
__device__ __forceinline__ void unit(int b, int h, int qb, const bf16_t* PJ, bf16_t* MIX, LAS unsigned char* shm, const Par P, int wave0) {
    constexpr int NC = (VAR == 1) ? 2 : 1;
    constexpr int QC = VAR == 0 ? 256 : (VAR == 1 ? 768 : 1536), KC = VAR == 0 ? 512 : (VAR == 1 ? 1024 : 1792), VC = VAR == 0 ? 640 : (VAR == 1 ? 1280 : 1920), OC = VAR == 0 ? 256 : (VAR == 1 ? 512 : 768);
    int tid = wave0 * 64 + lane_id(); asm volatile("" : "+v"(tid));
    const int lane = tid & 63, r32 = lane & 31, hi = lane >> 5; const int wid = __builtin_amdgcn_readfirstlane(tid >> 6);
    const long rowbase = (long)b * SEQ; const int q0 = qb * 256;
    const int kvh = (VAR == 1) ? h : (h >> 1);
    const bf16_t* Qw = PJ + (rowbase + q0 + wid * 32) * PJP + QC + h * 64;
    const bf16_t* Kh = PJ + rowbase * PJP + KC + kvh * 64; const bf16_t* Vh = PJ + rowbase * PJP + VC + kvh * 64;
    const unsigned lds0 = (unsigned)(uintptr_t)shm;
    LAS float* wsf = (LAS float*)(shm + L_WS) + wid * 128;
    const bf16_t* ksrc = Kh + (long)lane * PJP + wid * 8;
    const bf16_t* vsrc = Vh + (long)(16 * (wid & 3) + (lane >> 2)) * PJP + (wid >> 2) * 32 + (lane & 3) * 8;
    const unsigned kdst = lds0 + L_K + wid * 1024, vdst = lds0 + L_V + wid * 1024;
#define ATT_DMA_K(t, so) glds16(ksrc + (long)(t) * 64 * PJP, (unsigned)__builtin_amdgcn_readfirstlane(kdst + (so)))
#define ATT_DMA_V(t, so) glds16(vsrc + (long)(t) * 64 * PJP, (unsigned)__builtin_amdgcn_readfirstlane(vdst + (so)))
    const int vb0 = (int)(lds0 + L_V) + ((lane >> 4) & 1) * 32 + (lane & 3) * 8 + (4 * hi + ((lane & 15) >> 2)) * 64;
    int t_lo = 0, t_hi = 31;
    if (VAR == 2) { t_lo = q0 / 64 - 2; if (t_lo < 0) t_lo = 0; t_hi = q0 / 64 + 5; if (t_hi > 31) t_hi = 31; }
    if (VAR == 1) { t_lo = (q0 - P.dcut) >> 6; if (t_lo < 0) t_lo = 0; t_hi = (q0 + 255 + P.dcut) >> 6; if (t_hi > 31) t_hi = 31; }
    bf16x8 qr[4];
#pragma unroll
    for (int d0 = 0; d0 < 4; ++d0) qr[d0] = *reinterpret_cast<const bf16x8*>(&Qw[(long)r32 * PJP + d0 * 16 + hi * 8]);
    ATT_DMA_K(t_lo, 0); ATT_DMA_V(t_lo, 0);
    if (t_lo < t_hi) { ATT_DMA_K(t_lo + 1, SLOTB); ATT_DMA_V(t_lo + 1, SLOTB); }
    float mh[NC]; f32x16 o[NC][2], ol[NC], negm[NC];
    float zf = 0.f; asm volatile("" : "+v"(zf));
#pragma unroll
    for (int c = 0; c < NC; ++c) { mh[c] = (VAR == 2) ? P.sink2 : 0.f;
#pragma unroll
        for (int r = 0; r < 16; ++r) { o[c][0][r] = zf; o[c][1][r] = zf; ol[c][r] = (VAR == 2) ? zf + 1.0f : zf; negm[c][r] = zf; } }
    const float K32 = (VAR != 0) ? P.slope2 * 32.f : 0.f;
    const int qpos = q0 + wid * 32 + r32, qw = q0 + wid * 32;
    bool started = false;
    int so = 0, so2 = 2 * SLOTB;
    for (int t = t_lo; t <= t_hi; ++t) {
        if (t < t_hi) asm volatile("s_waitcnt vmcnt(2) lgkmcnt(0)\n\ts_barrier" ::: "memory"); else asm volatile("s_waitcnt vmcnt(0) lgkmcnt(0)\n\ts_barrier" ::: "memory");
        if (t + 2 <= t_hi) { ATT_DMA_K(t + 2, so2); ATT_DMA_V(t + 2, so2); }
        bool rel = true;
        if (VAR == 2) rel = (64 * t + 63 >= qw - 128) && (64 * t <= qw + 31 + 128);
        if (VAR == 1) rel = (64 * t + 63 >= qw - P.dcut) && (64 * t <= qw + 31 + P.dcut);
        if (rel) {
            const bool first = (VAR != 2) && !started; started = true;
            f32x16 p0[NC], p1[NC];
#pragma unroll
            for (int c = 0; c < NC; ++c) {
                f32x16 ci0, ci1;
                if (VAR == 0) { ci0 = negm[c]; ci1 = negm[c]; }
                else {
                    const float qk = (float)(qpos - 64 * t - 4 * hi);
                    if (64 * t >= qw + 31) { const float A = __builtin_fmaf(P.slope2, qk, -mh[c]);
#pragma unroll
                        for (int r = 0; r < 16; ++r) { ci0[r] = __builtin_fmaf(-P.slope2, (float)((r & 3) + 8 * (r >> 2)), A); ci1[r] = ci0[r] - K32; } }
                    else if (64 * t + 63 <= qw) { const float A = __builtin_fmaf(-P.slope2, qk, -mh[c]);
#pragma unroll
                        for (int r = 0; r < 16; ++r) { ci0[r] = __builtin_fmaf(P.slope2, (float)((r & 3) + 8 * (r >> 2)), A); ci1[r] = ci0[r] + K32; } }
                    else {
#pragma unroll
                        for (int r = 0; r < 16; ++r) { const float cr = (float)((r & 3) + 8 * (r >> 2));
                            ci0[r] = __builtin_fmaf(-P.slope2, __builtin_fabsf(qk - cr), -mh[c]); ci1[r] = __builtin_fmaf(-P.slope2, __builtin_fabsf(qk - (cr + 32.f)), -mh[c]); } }
                }
                if (VAR == 1) { if (c == 0) qkt<0, 2>(p0[c], p1[c], shm + L_K + so, qr, ci0, ci1, r32, hi); else qkt<2, 2>(p0[c], p1[c], shm + L_K + so, qr, ci0, ci1, r32, hi); }
                else qkt<0, 4>(p0[c], p1[c], shm + L_K + so, qr, ci0, ci1, r32, hi);
            }
            u32x4 pw[NC][4];
#pragma unroll
            for (int c = 0; c < NC; ++c) {
                if (VAR == 2) {
                    const bool need_mask = (64 * t + 63 - qw > 128) || (qw + 31 - 64 * t > 128);
                    if (need_mask) { const float qk = (float)(qpos - 64 * t - 4 * hi);
#pragma unroll
                        for (int r = 0; r < 16; ++r) { const float cr = (float)((r & 3) + 8 * (r >> 2));
                            if (__builtin_fabsf(qk - cr) > 128.f) p0[c][r] = -INFINITY; if (__builtin_fabsf(qk - (cr + 32.f)) > 128.f) p1[c][r] = -INFINITY; } }
                }
                const float rm = rowmax(p0[c], p1[c]);
                if (first) {
                    mh[c] = rm;
#pragma unroll
                    for (int r = 0; r < 16; ++r) { p0[c][r] -= rm; p1[c][r] -= rm; if (VAR == 0) negm[c][r] = -rm; }
                } else if (__any(rm > THR)) {
                    const float dl = __builtin_fmaxf(rm, 0.f); mh[c] += dl;
#pragma unroll
                    for (int r = 0; r < 16; ++r) { p0[c][r] -= dl; p1[c][r] -= dl; if (VAR == 0) negm[c][r] = -mh[c]; }
                    const float f = __builtin_amdgcn_exp2f(-dl);
                    if (hi == 0) wsf[r32] = f;
                    asm volatile("s_waitcnt lgkmcnt(0)" ::: "memory");
#pragma unroll
                    for (int r = 0; r < 16; ++r) { const float fr_ = wsf[crow(r, hi)]; o[c][0][r] *= fr_; o[c][1][r] *= fr_; ol[c][r] *= fr_; }
                }
#pragma unroll
                for (int r = 0; r < 16; ++r) { p0[c][r] = __builtin_amdgcn_exp2f(p0[c][r]); p1[c][r] = __builtin_amdgcn_exp2f(p1[c][r]); }
                pw[c][0] = (u32x4){pkbf(p0[c][0], p0[c][1]), pkbf(p0[c][2], p0[c][3]), pkbf(p0[c][4], p0[c][5]), pkbf(p0[c][6], p0[c][7])};
                pw[c][1] = (u32x4){pkbf(p0[c][8], p0[c][9]), pkbf(p0[c][10], p0[c][11]), pkbf(p0[c][12], p0[c][13]), pkbf(p0[c][14], p0[c][15])};
                pw[c][2] = (u32x4){pkbf(p1[c][0], p1[c][1]), pkbf(p1[c][2], p1[c][3]), pkbf(p1[c][4], p1[c][5]), pkbf(p1[c][6], p1[c][7])};
                pw[c][3] = (u32x4){pkbf(p1[c][8], p1[c][9]), pkbf(p1[c][10], p1[c][11]), pkbf(p1[c][12], p1[c][13]), pkbf(p1[c][14], p1[c][15])};
            }
            pvn<NC>(o, ol, vb0 + so, pw);
        }
        so = (so == (NSLOT - 1) * SLOTB) ? 0 : so + SLOTB; so2 = (so2 == (NSLOT - 1) * SLOTB) ? 0 : so2 + SLOTB;
    }
    LAS float* stg = (LAS float*)(shm + L_OST + wid * OST_W);
#pragma unroll
    for (int r = 0; r < 16; ++r) { const int orow = crow(r, hi);
        const float rl0 = __builtin_amdgcn_rcpf(ol[0][r]);
        float rl1 = 0.f; if (VAR == 1) rl1 = P.lam * __builtin_amdgcn_rcpf(ol[NC - 1][r]);
#pragma unroll
        for (int d0 = 0; d0 < 2; ++d0) { float v = o[0][d0][r] * rl0; if (VAR == 1) v -= o[NC - 1][d0][r] * rl1; stg[orow * 68 + d0 * 32 + r32] = v; } }
    asm volatile("s_waitcnt lgkmcnt(0)" ::: "memory");
    {
        const int row = lane >> 1, half = lane & 1;
        f32x4 x[8];
#pragma unroll
        for (int k = 0; k < 8; ++k) x[k] = *(const LAS f32x4*)(stg + row * 68 + half * 32 + 4 * k);
        if (VAR == 1) {
            float ss = 0.f;
#pragma unroll
            for (int k = 0; k < 8; ++k) ss += (x[k][0] * x[k][0] + x[k][1] * x[k][1]) + (x[k][2] * x[k][2] + x[k][3] * x[k][3]);
            ss += xor_lane<1>(ss);
            const float rinv = P.oscale / sqrtf(ss * (1.f / 64.f) + RMS_EPS);
#pragma unroll
            for (int k = 0; k < 8; ++k) x[k] = x[k] * rinv * *(const f32x4*)(P.subln + half * 32 + 4 * k);
        }
        bf16_t* op = MIX + (rowbase + q0 + wid * 32 + row) * MXP + OC + h * 64 + half * 32;
#pragma unroll
        for (int k = 0; k < 4; ++k) { u32x4 w; w.x = pkbf(x[2 * k][0], x[2 * k][1]); w.y = pkbf(x[2 * k][2], x[2 * k][3]); w.z = pkbf(x[2 * k + 1][0], x[2 * k + 1][1]); w.w = pkbf(x[2 * k + 1][2], x[2 * k + 1][3]);
            *(u32x4*)(op + 8 * k) = w; }
    }
    asm volatile("s_waitcnt lgkmcnt(0)\n\ts_barrier" ::: "memory");
#undef ATT_DMA_K
#undef ATT_DMA_V
}
}

struct Frame {
    LAS unsigned char* lds; volatile LAS unsigned* MISC; gu32* ctl;
    int tid, lane, wave, vcu, G;
};
struct Args { const float* in[26]; float* out; unsigned char* ws; };
constexpr int PT_OFF = MISC_OFF + 1024;
__device__ __forceinline__ unsigned long long ldp_raw(LAS unsigned char* lds, int i) {
    unsigned z = 0u; asm volatile("" : "+v"(z));
    const unsigned a = z + (unsigned)(uintptr_t)lds + PT_OFF + 8u * (unsigned)i;
    const unsigned long long v = *(volatile LAS unsigned long long*)(uintptr_t)a;
    const unsigned lo = __builtin_amdgcn_readfirstlane((unsigned)v), hi = __builtin_amdgcn_readfirstlane((unsigned)(v >> 32));
    return ((unsigned long long)hi << 32) | lo; }
#define INP(i) ((const float*)ldp_raw(F.lds, (i)))
#define OUTP() ((float*)ldp_raw(F.lds, 26))
#define WSP() ((unsigned char*)ldp_raw(F.lds, 27))

__device__ __forceinline__ int winmap(int n) {
    const int tile = n >> 8, p = n & 255;
    if (tile != 1 && tile != 2) return n;
    const int hh = p >> 6, dim = p & 63, bj = dim >> 5, w = dim & 31;
    int fq, e;
    if (tile == 1 || hh < 2) { const int ehi = w >> 4, i = w & 15; fq = i >> 2; e = (i & 3) + 4 * ehi; }
    else { fq = w >> 3; e = w & 7; }
    return tile * 256 + 128 * bj + 32 * hh + 8 * fq + e;
}
template <int MAP> __device__ __forceinline__ int rowmap(int n) {
    if (MAP == 1) return winmap(n);
    if (MAP == 2) return (n >> 7) * 256 + (n & 127);
    if (MAP == 3) return (n >> 7) * 256 + 128 + (n & 127);
    return n;
}
__device__ __forceinline__ void tr_write(bf16_t* WT, int K, int k0, LAS float* scr, int lane, const int (&drow)[4]) {
    const int c = lane & 7;
#pragma unroll
    for (int j = 0; j < 4; ++j) { const int n = (lane >> 3) + 8 * j; const LAS float* s = scr + (8 * c) * 33 + n;
        u32x4 o; o.x = pkbf(s[0 * 33], s[1 * 33]); o.y = pkbf(s[2 * 33], s[3 * 33]); o.z = pkbf(s[4 * 33], s[5 * 33]); o.w = pkbf(s[6 * 33], s[7 * 33]);
        *(u32x4*)(WT + (size_t)drow[j] * K + k0 + 8 * c) = o; }
    asm volatile("s_waitcnt lgkmcnt(0)" ::: "memory");
}
template <int MAP>
__device__ __forceinline__ void tr_item(const float* W, int K, int N, int ncol0, bf16_t* WT, LAS float* scr, int item, int lane) {
    const int nblk = (N - ncol0) / 32, kb = item / nblk, nb = item % nblk, k0 = 64 * kb, n0 = ncol0 + 32 * nb;
    f32x4 v[8];
#pragma unroll
    for (int i = 0; i < 8; ++i) v[i] = __builtin_nontemporal_load((const f32x4*)(W + (size_t)(k0 + 8 * i + (lane >> 3)) * N + n0 + (lane & 7) * 4));
#pragma unroll
    for (int i = 0; i < 8; ++i) { LAS float* d = scr + (8 * i + (lane >> 3)) * 33 + (lane & 7) * 4; d[0] = v[i][0]; d[1] = v[i][1]; d[2] = v[i][2]; d[3] = v[i][3]; }
    asm volatile("s_waitcnt lgkmcnt(0)" ::: "memory");
    int drow[4];
#pragma unroll
    for (int j = 0; j < 4; ++j) drow[j] = rowmap<MAP>(n0 + (lane >> 3) + 8 * j);
    tr_write(WT, K, k0, scr, lane, drow);
}
template <int MAP>
__device__ __forceinline__ void tr_item8(const float* W, int K, int N, unsigned char* WT, float sc, LAS float* scr, int item, int lane) {
    const int nblk = N / 32, kb = item / nblk, nb = item % nblk, k0 = 64 * kb, n0 = 32 * nb;
    f32x4 v[8];
#pragma unroll
    for (int i = 0; i < 8; ++i) v[i] = __builtin_nontemporal_load((const f32x4*)(W + (size_t)(k0 + 8 * i + (lane >> 3)) * N + n0 + (lane & 7) * 4));
#pragma unroll
    for (int i = 0; i < 8; ++i) { LAS float* d = scr + (8 * i + (lane >> 3)) * 33 + (lane & 7) * 4; d[0] = v[i][0]; d[1] = v[i][1]; d[2] = v[i][2]; d[3] = v[i][3]; }
    asm volatile("s_waitcnt lgkmcnt(0)" ::: "memory");
    const int c = lane & 7;
#pragma unroll
    for (int j = 0; j < 4; ++j) { const int n = (lane >> 3) + 8 * j; const LAS float* s = scr + (8 * c) * 33 + n;
        u32x2 o; o.x = pk4_fp8(s[0 * 33] * sc, s[1 * 33] * sc, s[2 * 33] * sc, s[3 * 33] * sc); o.y = pk4_fp8(s[4 * 33] * sc, s[5 * 33] * sc, s[6 * 33] * sc, s[7 * 33] * sc);
        *(u32x2*)(WT + (size_t)rowmap<MAP>(n0 + n) * K + k0 + 8 * c) = o; }
    asm volatile("s_waitcnt lgkmcnt(0)" ::: "memory");
}
__device__ __forceinline__ void tr_item_pool_wg(const float* W, const float* wp, const float* scale, bf16_t* WT, LAS float* scr, int item, int tid) {
    const int kb = item / 8, nb = item % 8, k0 = 64 * kb, n0 = 32 * nb, g = n0 >> 6, kk = tid >> 3, nq = (tid & 7) * 4;
    const float* wrow = W + (size_t)(k0 + kk) * D_IN + 64 * g; const float* wpc = wp + (size_t)g * 4096 + (n0 & 63) + nq;
    f32x4 acc = {0.f, 0.f, 0.f, 0.f};
#pragma unroll 8
    for (int c = 0; c < 64; ++c) acc += *(const f32x4*)(wpc + c * 64) * wrow[c];
    acc = acc * *(const f32x4*)(scale + n0 + nq);
    LAS float* d = scr + kk * 33 + nq; d[0] = acc[0]; d[1] = acc[1]; d[2] = acc[2]; d[3] = acc[3];
    __syncthreads();
    if (tid < 64) { int drow[4];
#pragma unroll
        for (int j = 0; j < 4; ++j) drow[j] = n0 + (tid >> 3) + 8 * j;
        tr_write(WT, DM, k0, scr, tid, drow); }
    __syncthreads();
}
__device__ __forceinline__ void ln_core(f32x4 (&v)[4], const f32x4 (&g4)[4], const f32x4 (&b4)[4]) {
    float s = 0.f;
#pragma unroll
    for (int j = 0; j < 4; ++j) s += (v[j][0] + v[j][1]) + (v[j][2] + v[j][3]);
    const float mean = wave_sum(s) * (1.f / DM); float s2 = 0.f;
#pragma unroll
    for (int j = 0; j < 4; ++j) { v[j] = v[j] - mean; s2 += (v[j][0] * v[j][0] + v[j][1] * v[j][1]) + (v[j][2] * v[j][2] + v[j][3] * v[j][3]); }
    const float rstd = 1.f / sqrtf(wave_sum(s2) * (1.f / DM) + LN_EPS);
#pragma unroll
    for (int j = 0; j < 4; ++j) v[j] = v[j] * rstd * g4[j] + b4[j];
}
__device__ __forceinline__ void ln_store(const f32x4 (&v)[4], float* xo, bf16_t* xn, int lane) {
#pragma unroll
    for (int j = 0; j < 4; ++j) {
        if (xo) *((f32x4*)xo + lane + 64 * j) = v[j];
        if (xn) { u32x2 w; w.x = pkbf(v[j][0], v[j][1]); w.y = pkbf(v[j][2], v[j][3]); *((u32x2*)xn + lane + 64 * j) = w; } }
}

__global__ void __launch_bounds__(NWAVES * 64, 2) mega_fwd(Args args) {
    extern __shared__ __attribute__((aligned(16))) unsigned char lds_raw[];
    Frame F;
    F.lds = (LAS unsigned char*)lds_raw;
    F.MISC = (volatile LAS unsigned*)(F.lds + MISC_OFF);
    const int wave0 = __builtin_amdgcn_readfirstlane((int)threadIdx.x >> 6);
    F.ctl = (gu32*)(args.ws + WS_CTL);
    { const int t = wave0 * 64 + lane_id();
      for (int u = t; u < 256; u += NWAVES * 64) F.MISC[u] = 0u;
      if (t == 0) { volatile LAS unsigned long long* PT = (volatile LAS unsigned long long*)(F.lds + PT_OFF);
#pragma unroll
        for (int i = 0; i < 26; ++i) PT[i] = (unsigned long long)args.in[i];
        PT[26] = (unsigned long long)args.out; PT[27] = (unsigned long long)args.ws; } }
    __syncthreads();
    XcdBarrier bar = xcd_barrier_post((unsigned*)(F.ctl + CW_BAR), F.MISC + 8, wave0 == 0 && lane_id() == 0);
#define GRID_BAR() xcd_barrier(bar, wave0 == 0 && lane_id() == 0)
#define PHASE_LOCALS() int tid_ = wave0 * 64 + lane_id(); asm volatile("" : "+v"(tid_)); int bid_ = blockIdx.x, G_ = gridDim.x; asm volatile("" : "+s"(bid_), "+s"(G_)); \
    const int lane = tid_ & 63, wave = __builtin_amdgcn_readfirstlane(tid_ >> 6), vcu = (G_ % 8 == 0) ? (bid_ % 8) * (G_ / 8) + bid_ / 8 : bid_, gw = vcu * NWAVES + wave, NGW = G_ * NWAVES; \
    (void)lane; (void)gw; (void)NGW; (void)vcu; (void)wave

        asm volatile("; MARK_P0" ::: "memory");
    for (int dup = 0; dup < DUP_P0; ++dup) {
        PHASE_LOCALS();
        LAS float* scr = (LAS float*)(F.lds + wave * 16384);
        unsigned char* ws = WSP();
        const float* x_in = INP(0); const float* ln_in_g = INP(1); const float* ln_in_b = INP(2); const float* w_in = INP(3); const float* w_pool = INP(4); const float* pool_scale = INP(5);
        const float* w_out = INP(14); const float* w_gate = INP(17); const float* w_up = INP(18); const float* w_down = INP(19); const float* e_gate = INP(21); const float* e_up = INP(22); const float* e_down = INP(23);
        float* X = OUTP(); float* ropec = (float*)(ws + WS_ROPEC); float* ropes = (float*)(ws + WS_ROPES);
        bf16_t* Win_t = (bf16_t*)(ws + WS_WIN); bf16_t* Wout_t = (bf16_t*)(ws + WS_WOUT); bf16_t* Wgu_t = (bf16_t*)(ws + WS_WGU); bf16_t* Wd_t = (bf16_t*)(ws + WS_WD);
        unsigned char* Egu8 = ws + WS_EGU; unsigned char* Ed8 = ws + WS_ED; bf16_t* XN = (bf16_t*)(ws + WS_XN);
        constexpr int I_WIN = 16 * 56, I_POOL = 16 * 8, I_WOUT = 16 * 32, I_G = 16 * 88, I_D = 44 * 32, I_EG = 16 * 112, I_ED = 56 * 32;
        constexpr int N0 = 2 * I_WIN, N1 = N0 + 2 * I_WOUT, N2 = N1 + 2 * I_G, N3 = N2 + I_D, N4 = N3 + 16 * I_EG, N5 = N4 + 8 * I_ED;
        for (int pi = vcu; pi < 2 * I_POOL; pi += G_) { const int l = pi / I_POOL;
            tr_item_pool_wg(w_in + (size_t)l * DM * D_IN, w_pool + (size_t)l * 4 * 4096, pool_scale + l * 256, Win_t + (size_t)l * D_IN * DM, (LAS float*)F.lds, pi - l * I_POOL, tid_); }
        for (int it = gw; it < N5; it += NGW) {
            int r = it;
            if (r < N0) { const int l = r / I_WIN; r -= l * I_WIN; tr_item<1>(w_in + (size_t)l * DM * D_IN, DM, D_IN, 256, Win_t + (size_t)l * D_IN * DM, scr, r, lane); continue; }
            if (r < N1) { r -= N0; const int l = r / I_WOUT; r -= l * I_WOUT; tr_item<0>(w_out + (size_t)l * DM * DM, DM, DM, 0, Wout_t + (size_t)l * DM * DM, scr, r, lane); continue; }
            if (r < N2) { r -= N1; const int which = r / I_G; r -= which * I_G;
#if DENSE_FP8
                if (which == 0) tr_item8<2>(w_gate, DM, D_FF, (unsigned char*)Wgu_t, EGU_SCALE, scr, r, lane); else tr_item8<3>(w_up, DM, D_FF, (unsigned char*)Wgu_t, EGU_SCALE, scr, r, lane);
                continue; }
            if (r < N3) { r -= N2; tr_item8<0>(w_down, D_FF, DM, (unsigned char*)Wd_t, ED_SCALE, scr, r, lane); continue; }
#else
                if (which == 0) tr_item<2>(w_gate, DM, D_FF, 0, Wgu_t, scr, r, lane); else tr_item<3>(w_up, DM, D_FF, 0, Wgu_t, scr, r, lane);
                continue; }
            if (r < N3) { r -= N2; tr_item<0>(w_down, D_FF, DM, 0, Wd_t, scr, r, lane); continue; }
#endif
            if (r < N4) { r -= N3; const int idx = r / I_EG; r -= idx * I_EG; const int e = idx >> 1;
                if ((idx & 1) == 0) tr_item8<2>(e_gate + (size_t)e * DM * D_FFE, DM, D_FFE, Egu8 + (size_t)e * 2 * D_FFE * DM, EGU_SCALE, scr, r, lane);
                else tr_item8<3>(e_up + (size_t)e * DM * D_FFE, DM, D_FFE, Egu8 + (size_t)e * 2 * D_FFE * DM, EGU_SCALE, scr, r, lane);
                continue; }
            { r -= N4; const int e = r / I_ED; r -= e * I_ED; tr_item8<0>(e_down + (size_t)e * D_FFE * DM, D_FFE, DM, Ed8 + (size_t)e * DM * D_FFE, ED_SCALE, scr, r, lane); }
        }
        for (int idx = bid_ * 512 + tid_; idx < SEQ * 32; idx += G_ * 512) { const int s = idx >> 5, ax = (idx >> 4) & 1, i = idx & 15;
            const float pos = ax == 0 ? (float)(s / 64) : (float)(s % 64); const float inv_freq = powf(10000.0f, -(float)(2 * i) / 32.0f); const float ang = pos * inv_freq;
            ropec[idx] = cosf(ang); ropes[idx] = sinf(ang); }
        f32x4 g4[4], b4[4];
#pragma unroll
        for (int j = 0; j < 4; ++j) { g4[j] = *((const f32x4*)ln_in_g + lane + 64 * j); b4[j] = *((const f32x4*)ln_in_b + lane + 64 * j); }
        for (int m = gw; m < M; m += NGW) { f32x4 v[4];
#pragma unroll
            for (int j = 0; j < 4; ++j) v[j] = *((const f32x4*)(x_in + (size_t)m * DM) + lane + 64 * j);
            ln_core(v, g4, b4); ln_store(v, X + (size_t)m * DM, XN + (size_t)m * DM, lane); }
    }
    GRID_BAR();

#pragma clang loop unroll(full)
    for (int l = 0; l < DEPTH; ++l) {
        asm volatile("; MARK_P1" ::: "memory");
        for (int dup = 0; dup < DUP_P1; ++dup) {
            PHASE_LOCALS();
            unsigned char* ws = WSP(); const float* qn_w = INP(6); const float* kn_w = INP(7);
            bf16_t* XN = (bf16_t*)(ws + WS_XN); bf16_t* Win_t = (bf16_t*)(ws + WS_WIN); bf16_t* PJ = (bf16_t*)(ws + WS_PJ); const float* ropec = (const float*)(ws + WS_ROPEC); const float* ropes = (const float*)(ws + WS_ROPES);
            pg8::Gemm g{XN, Win_t + (size_t)l * D_IN * DM, DM, 0};
            pg8::StaticOrder S; S.init(M, D_IN, G_, bid_);
            pg8::EpiProj E{PJ, qn_w + l * 64, kn_w + l * 64, ropec, ropes, (unsigned*)(ws + WS_CTL) + CW_NRM + l * 256};
            pg8::gemm_phase<pg8::EpiProj, pg8::StaticOrder, true>(F.lds, g, S, E, wave0);
        }
        GRID_BAR();
        asm volatile("; MARK_P2" ::: "memory");
        for (int dup = 0; dup < DUP_P2; ++dup) {
            PHASE_LOCALS();
            unsigned char* ws = WSP(); const float* lam_q1 = INP(8); const float* lam_k1 = INP(9); const float* lam_q2 = INP(10); const float* lam_k2 = INP(11); const float* subln_w = INP(12); const float* sink = INP(13);
            bf16_t* PJ = (bf16_t*)(ws + WS_PJ); bf16_t* MIX = (bf16_t*)(ws + WS_MIX);
            const float lam_init = 0.8f - 0.6f * expf(-0.3f * (float)l);
            float a = lane < 32 ? lam_q1[l * 32 + lane] * lam_k1[l * 32 + lane] : 0.f, c = lane < 32 ? lam_q2[l * 32 + lane] * lam_k2[l * 32 + lane] : 0.f;
            const float lam = __int_as_float(__builtin_amdgcn_readfirstlane(__float_as_int(expf(wave_sum(a)) - expf(wave_sum(c)) + lam_init)));
            unsigned* qhead = (unsigned*)(ws + WS_CTL) + CW_Q + 64 * l; const unsigned* nrm = (const unsigned*)(ws + WS_CTL) + CW_NRM + l * 256;
            for (;;) {
                unsigned zq = 0u; asm volatile("" : "+v"(zq));
                volatile LAS unsigned* qslot = (volatile LAS unsigned*)(uintptr_t)(zq + (unsigned)(uintptr_t)F.lds + MISC_OFF + 128u);
                if (wave0 == 0 && lane_id() == 0) *qslot = __hip_atomic_fetch_add(qhead, 1u, __ATOMIC_RELAXED, __HIP_MEMORY_SCOPE_AGENT);
                __syncthreads();
                const int idx = __builtin_amdgcn_readfirstlane((int)*qslot);
                __syncthreads();
                if (idx >= 1792) break;
                if (idx < 256 || (idx >= 768 && idx < 1024)) {
                    const int h = idx < 128 ? 3 : (idx < 256 ? 2 : (idx < 896 ? 1 : 0)), k = idx & 127, b = k >> 3, qb = k & 7;
                    const float slope2 = exp2f(-(float)(2 * h + 1)) * LOG2E;
                    const float q0n = __uint_as_float(nrm[(0 * 16 + b) * 8 + h * 2]), q1n = __uint_as_float(nrm[(0 * 16 + b) * 8 + h * 2 + 1]), k0n = __uint_as_float(nrm[(1 * 16 + b) * 8 + h * 2]), k1n = __uint_as_float(nrm[(1 * 16 + b) * 8 + h * 2 + 1]);
                    const float bound = sqrtf(__builtin_fmaxf(q0n * k0n, q1n * k1n));
                    float dc = (2.1f * bound + 40.0f) / slope2; if (dc > 4096.f) dc = 4096.f;
                    att::Par P{slope2, 0.f, lam, 1.0f - lam_init, subln_w + l * 64, (int)dc + 1};
                    for (int d_ = 0; d_ < DUP_C; ++d_) att::unit<1>(b, h, qb, PJ, MIX, F.lds, P, wave0);
                } else if (idx < 768) {
                    const int k = idx - 256, qb = k & 7, h = (k >> 3) & 3, b = k >> 5;
                    att::Par P{0.f, 0.f, 0.f, 0.f, nullptr, 0};
                    for (int d_ = 0; d_ < DUP_B; ++d_) att::unit<0>(b, h, qb, PJ, MIX, F.lds, P, wave0);
                } else if (idx < 1536) {
                    const int k = idx - 1024, qb = k & 7, h = (k >> 3) & 3, b = k >> 5;
                    att::Par P{exp2f(-(float)(2 * h + 2)) * LOG2E, sink[l * 4 + h] * LOG2E, 0.f, 0.f, nullptr, 0};
                    for (int d_ = 0; d_ < DUP_D; ++d_) att::unit<2>(b, h, qb, PJ, MIX, F.lds, P, wave0);
                } else {
                    const int ch = idx - 1536;
                    for (int it = wave0 * 64 + lane_id(); it < 128 * 32; it += NWAVES * 64) { const int t = ch * 128 + (it >> 5), cg = it & 31, c0 = cg * 8, s = t & (SEQ - 1), base = t - s;
                        const int w = 2 << (c0 >> 6); int lo = s - w / 2, hi = lo + w; if (lo < 0) lo = 0; if (hi > SEQ) hi = SEQ;
                        float acc[8];
#pragma unroll
                        for (int j = 0; j < 8; ++j) acc[j] = 0.f;
                        for (int j = lo; j < hi; ++j) { const u32x4 zz = *(const u32x4*)(PJ + (size_t)(base + j) * D_IN + c0);
                            acc[0] += bf_lo(zz.x); acc[1] += bf_hi(zz.x); acc[2] += bf_lo(zz.y); acc[3] += bf_hi(zz.y); acc[4] += bf_lo(zz.z); acc[5] += bf_hi(zz.z); acc[6] += bf_lo(zz.w); acc[7] += bf_hi(zz.w); }
                        const float inv = 1.0f / (float)(hi - lo); const u32x4 zs = *(const u32x4*)(PJ + (size_t)t * D_IN + c0);
                        u32x4 o; o.x = pkbf(acc[0] * inv - bf_lo(zs.x), acc[1] * inv - bf_hi(zs.x)); o.y = pkbf(acc[2] * inv - bf_lo(zs.y), acc[3] * inv - bf_hi(zs.y));
                        o.z = pkbf(acc[4] * inv - bf_lo(zs.z), acc[5] * inv - bf_hi(zs.z)); o.w = pkbf(acc[6] * inv - bf_lo(zs.w), acc[7] * inv - bf_hi(zs.w));
                        *(u32x4*)(MIX + (size_t)t * DM + c0) = o; }
                }
            }
        }
        GRID_BAR();
        asm volatile("; MARK_P3" ::: "memory");
        {
            PHASE_LOCALS();
            unsigned char* ws = WSP(); bf16_t* MIX = (bf16_t*)(ws + WS_MIX); bf16_t* Wout_t = (bf16_t*)(ws + WS_WOUT); bf16_t* MO = (bf16_t*)(ws + WS_PJ);
            pg8::Gemm g{MIX, Wout_t + (size_t)l * DM * DM, DM, 0};
            pg8::StaticOrder S; S.init(M, DM, G_, bid_);
            pg8::EpiBf16 E{MO, DM, 1.0f};
            pg8::gemm_phase<pg8::EpiBf16, pg8::StaticOrder, true>(F.lds, g, S, E, wave0);
        }
        GRID_BAR();
        asm volatile("; MARK_LN1" ::: "memory");
        {
            PHASE_LOCALS();
            unsigned char* ws = WSP(); float* X = OUTP(); const float* ln1_g = INP(15); const float* ln1_b = INP(16); const float* w_router = INP(20);
            bf16_t* XN = (bf16_t*)(ws + WS_XN); int* ltok = (int*)(ws + WS_LTOK); int* tpos = (int*)(ws + WS_TPOS); float* tgate = (float*)(ws + WS_TGATE); const bf16_t* MO = (const bf16_t*)(ws + WS_PJ);
            f32x4 g4[4], b4[4];
#pragma unroll
            for (int j = 0; j < 4; ++j) { g4[j] = *((const f32x4*)(ln1_g + l * DM) + lane + 64 * j); b4[j] = *((const f32x4*)(ln1_b + l * DM) + lane + 64 * j); }
            int me1 = -1, me2 = -1; float mg1 = 0.f, mg2 = 0.f;
            const int rows_per_wave = M / NGW;
            for (int ri = 0; ri < rows_per_wave; ++ri) { const int m = gw * rows_per_wave + ri; f32x4 v[4];
#pragma unroll
                for (int j = 0; j < 4; ++j) { const f32x4 xv = *((const f32x4*)(X + (size_t)m * DM) + lane + 64 * j); const u32x2 mo = *((const u32x2*)(MO + (size_t)m * DM) + lane + 64 * j);
                    v[j][0] = ALPHA * xv[0] + bf_lo(mo.x); v[j][1] = ALPHA * xv[1] + bf_hi(mo.x); v[j][2] = ALPHA * xv[2] + bf_lo(mo.y); v[j][3] = ALPHA * xv[3] + bf_hi(mo.y); }
                ln_core(v, g4, b4);
                if (l == 0 && !DENSE_FP8) ln_store(v, X + (size_t)m * DM, XN + (size_t)m * DM, lane);
                else { ln_store(v, X + (size_t)m * DM, nullptr, lane);
#pragma unroll
                    for (int j = 0; j < 4; ++j) *((unsigned*)(ws + (DENSE_FP8 && l == 0 ? WS_XN : WS_XN8) + (size_t)m * DM) + lane + 64 * j) = pk4_fp8(v[j][0], v[j][1], v[j][2], v[j][3]); }
                if (l == 1) {
                    float lg[8];
#pragma unroll
                    for (int e = 0; e < 8; ++e) lg[e] = 0.f;
#pragma unroll
                    for (int j = 0; j < 4; ++j)
#pragma unroll
                        for (int q = 0; q < 4; ++q) { const int c = 4 * lane + 256 * j + q; const f32x4 wa = *(const f32x4*)(w_router + c * 8), wb = *(const f32x4*)(w_router + c * 8 + 4); const float xv = v[j][q];
                            lg[0] += xv * wa[0]; lg[1] += xv * wa[1]; lg[2] += xv * wa[2]; lg[3] += xv * wa[3]; lg[4] += xv * wb[0]; lg[5] += xv * wb[1]; lg[6] += xv * wb[2]; lg[7] += xv * wb[3]; }
#pragma unroll
                    for (int e = 0; e < 8; ++e) lg[e] = wave_sum(lg[e]);
                    int i1 = 0; float v1 = lg[0];
#pragma unroll
                    for (int e = 1; e < 8; ++e) if (lg[e] > v1) { v1 = lg[e]; i1 = e; }
                    int i2 = 0; float v2 = -INFINITY;
#pragma unroll
                    for (int e = 0; e < 8; ++e) if (e != i1 && lg[e] > v2) { v2 = lg[e]; i2 = e; }
                    const float ex = expf(v2 - v1), ga = 1.f / (1.f + ex), gb = ex / (1.f + ex);
                    if (lane == ri) { me1 = i1; me2 = i2; mg1 = ga; mg2 = gb; }
                }
            }
            if (l == 1) {
                const int myrow = gw * rows_per_wave + lane;
#pragma unroll
                for (int e = 0; e < 8; ++e) {
                    const bool has = (lane < rows_per_wave) && (me1 == e || me2 == e);
                    const unsigned long long mask = __ballot(has);
                    const int n = __popcll(mask);
                    if (n) {
                        int base = 0;
                        if (lane == 0) base = (int)__hip_atomic_fetch_add((unsigned*)(ws + WS_CTL) + CW_CNT + 64 * e, (unsigned)n, __ATOMIC_RELAXED, __HIP_MEMORY_SCOPE_AGENT);
                        base = __builtin_amdgcn_readfirstlane(base);
                        if (has) { const int p = base + (int)__builtin_amdgcn_mbcnt_hi((unsigned)(mask >> 32), __builtin_amdgcn_mbcnt_lo((unsigned)mask, 0u)); const int k = (me1 == e) ? 0 : 1;
                            ltok[e * M + p] = myrow; tpos[myrow * 2 + k] = (e << 20) | p; tgate[myrow * 2 + k] = k == 0 ? mg1 : mg2; }
                    }
                }
            }
        }
        GRID_BAR();
        if (l == 0) {
        asm volatile("; MARK_DENSE" ::: "memory");
            for (int dup = 0; dup < DUP_GU; ++dup) {
                PHASE_LOCALS();
                unsigned char* ws = WSP(); bf16_t* XN = (bf16_t*)(ws + WS_XN); bf16_t* Wgu_t = (bf16_t*)(ws + WS_WGU); bf16_t* Hd = (bf16_t*)(ws + WS_H);
                pg8::Gemm g{XN, Wgu_t, DM, 0};
                pg8::StaticOrder S; S.init(M, 2 * D_FF, G_, bid_);
#if DENSE_FP8
                pg8::EpiSwiGLU<true> E{Hd, D_FF, 0};
                pg8::gemm_phase<pg8::EpiSwiGLU<true>, pg8::StaticOrder, true, false, 1>(F.lds, g, S, E, wave0);
#else
                pg8::EpiSwiGLU<false> E{Hd, D_FF, 0};
                pg8::gemm_phase<pg8::EpiSwiGLU<false>, pg8::StaticOrder, true>(F.lds, g, S, E, wave0);
#endif
            }
            GRID_BAR();
            {
                PHASE_LOCALS();
                unsigned char* ws = WSP(); bf16_t* Wd_t = (bf16_t*)(ws + WS_WD); bf16_t* Hd = (bf16_t*)(ws + WS_H); bf16_t* MO = (bf16_t*)(ws + WS_XN);
                pg8::Gemm g{Hd, Wd_t, D_FF, 0};
                pg8::StaticOrder S; S.init(M, DM, G_, bid_);
#if DENSE_FP8
                pg8::EpiBf16 E{MO, DM, 1.0f / ED_SCALE};
                pg8::gemm_phase<pg8::EpiBf16, pg8::StaticOrder, true, false, 1>(F.lds, g, S, E, wave0);
#else
                pg8::EpiBf16 E{MO, DM, 1.0f};
                pg8::gemm_phase<pg8::EpiBf16, pg8::StaticOrder, true>(F.lds, g, S, E, wave0);
#endif
            }
            GRID_BAR();
        asm volatile("; MARK_LN2" ::: "memory");
            {
                PHASE_LOCALS();
                unsigned char* ws = WSP(); float* X = OUTP(); const float* ln2_g = INP(24); const float* ln2_b = INP(25); bf16_t* XN = (bf16_t*)(ws + WS_XN);
                f32x4 g4[4], b4[4];
#pragma unroll
                for (int j = 0; j < 4; ++j) { g4[j] = *((const f32x4*)(ln2_g + l * DM) + lane + 64 * j); b4[j] = *((const f32x4*)(ln2_b + l * DM) + lane + 64 * j); }
                for (int m = gw; m < M; m += NGW) { f32x4 v[4];
#pragma unroll
                    for (int j = 0; j < 4; ++j) { const f32x4 xv = *((const f32x4*)(X + (size_t)m * DM) + lane + 64 * j); const u32x2 mo = *((const u32x2*)(XN + (size_t)m * DM) + lane + 64 * j);
                        v[j][0] = ALPHA * xv[0] + bf_lo(mo.x); v[j][1] = ALPHA * xv[1] + bf_hi(mo.x); v[j][2] = ALPHA * xv[2] + bf_lo(mo.y); v[j][3] = ALPHA * xv[3] + bf_hi(mo.y); }
                    ln_core(v, g4, b4); ln_store(v, X + (size_t)m * DM, XN + (size_t)m * DM, lane); }
            }
            GRID_BAR();
        } else {
        asm volatile("; MARK_MOE" ::: "memory");
            volatile LAS int* T = (volatile LAS int*)(F.MISC + 64);
            if (wave0 == 0 && lane_id() == 0) { int acc = 0; unsigned* ctlw = (unsigned*)(WSP() + WS_CTL);
                for (int e = 0; e < 8; ++e) { const int c = (int)__hip_atomic_load(ctlw + CW_CNT + 64 * e, __ATOMIC_RELAXED, __HIP_MEMORY_SCOPE_AGENT); T[e] = acc; T[16 + e] = c; acc += (c + 255) >> 8; }
                T[8] = acc; }
            __syncthreads();
            MoeTable tab{T};
            const int total_tiles = __builtin_amdgcn_readfirstlane(T[8]);
            for (int dup = 0; dup < DUP_MOE; ++dup)
            for (int rt_lo = 0; rt_lo < total_tiles; rt_lo += CHUNK_TILES) {
                const int nrt = (total_tiles - rt_lo) < CHUNK_TILES ? (total_tiles - rt_lo) : CHUNK_TILES;
                {
                    PHASE_LOCALS();
                    unsigned char* ws = WSP(); unsigned char* XN8 = ws + WS_XN8; unsigned char* Egu8 = ws + WS_EGU; unsigned char* HC = ws + WS_HC; const int* ltok = (const int*)(ws + WS_LTOK);
                    pg8::Gemm g{XN8, Egu8, DM, (size_t)2 * D_FFE * DM};
                    MoeOrder S{tab, rt_lo, nrt, 2 * D_FFE / 256, G_, bid_, ltok, true};
                    pg8::EpiSwiGLU<true> E{HC, D_FFE, rt_lo};
                    pg8::gemm_phase<pg8::EpiSwiGLU<true>, MoeOrder, true, true, 1>(F.lds, g, S, E, wave0);
                }
                GRID_BAR();
                {
                    PHASE_LOCALS();
                    unsigned char* ws = WSP(); unsigned char* Ed8 = ws + WS_ED; unsigned char* HC = ws + WS_HC; bf16_t* Y = (bf16_t*)(ws + WS_Y); const int* ltok = (const int*)(ws + WS_LTOK);
                    pg8::Gemm g{HC, Ed8, D_FFE, (size_t)DM * D_FFE};
                    MoeOrder S{tab, rt_lo, nrt, DM / 256, G_, bid_, ltok, false};
                    pg8::EpiBf16 E{Y, DM, 1.0f / ED_SCALE};
                    pg8::gemm_phase<pg8::EpiBf16, MoeOrder, true, false, 1>(F.lds, g, S, E, wave0);
                }
                GRID_BAR();
            }
        asm volatile("; MARK_COMB" ::: "memory");
            {
                PHASE_LOCALS();
                unsigned char* ws = WSP(); float* X = OUTP(); const float* ln2_g = INP(24); const float* ln2_b = INP(25);
                const bf16_t* Y = (const bf16_t*)(ws + WS_Y); const int* tpos = (const int*)(ws + WS_TPOS); const float* tgate = (const float*)(ws + WS_TGATE);
                f32x4 g4[4], b4[4];
#pragma unroll
                for (int j = 0; j < 4; ++j) { g4[j] = *((const f32x4*)(ln2_g + l * DM) + lane + 64 * j); b4[j] = *((const f32x4*)(ln2_b + l * DM) + lane + 64 * j); }
                for (int m = gw; m < M; m += NGW) {
                    const int pa = tpos[m * 2], pb = tpos[m * 2 + 1]; const float ga = tgate[m * 2], gb = tgate[m * 2 + 1];
                    const size_t ra = (size_t)T[pa >> 20] * 256 + (pa & 0xfffff), rb = (size_t)T[pb >> 20] * 256 + (pb & 0xfffff);
                    f32x4 v[4];
#pragma unroll
                    for (int j = 0; j < 4; ++j) { const u32x2 ya = *((const u32x2*)(Y + ra * DM) + lane + 64 * j), yb = *((const u32x2*)(Y + rb * DM) + lane + 64 * j);
                        const f32x4 xv = *((const f32x4*)(X + (size_t)m * DM) + lane + 64 * j);
                        v[j][0] = ALPHA * xv[0] + ga * bf_lo(ya.x) + gb * bf_lo(yb.x); v[j][1] = ALPHA * xv[1] + ga * bf_hi(ya.x) + gb * bf_hi(yb.x);
                        v[j][2] = ALPHA * xv[2] + ga * bf_lo(ya.y) + gb * bf_lo(yb.y); v[j][3] = ALPHA * xv[3] + ga * bf_hi(ya.y) + gb * bf_hi(yb.y); }
                    ln_core(v, g4, b4); ln_store(v, X + (size_t)m * DM, nullptr, lane); }
            }
        }
    }
}

extern "C" void kernel_launch(void* const* d_in, const int* in_sizes, int n_in, void* d_out, int out_size, void* d_ws, size_t ws_size, hipStream_t stream) {
    static int grid = 0;
    if (grid == 0) {
        if (n_in != 26 || in_sizes[0] != M * DM || out_size != M * DM || ws_size < WS_END) { fprintf(stderr, "kernel_launch: unexpected shapes (n_in %d, ws %zu < %zu)\n", n_in, ws_size, (size_t)WS_END); grid = -1; return; }
        int dev = 0, cus = 0, per_cu = 0;
        if (hipGetDevice(&dev) != hipSuccess || hipDeviceGetAttribute(&cus, hipDeviceAttributeMultiprocessorCount, dev) != hipSuccess) { grid = -1; return; }
        if (hipFuncSetAttribute((const void*)mega_fwd, hipFuncAttributeMaxDynamicSharedMemorySize, LDS_BYTES) != hipSuccess) { fprintf(stderr, "kernel_launch: hipFuncSetAttribute failed\n"); grid = -1; return; }
        if (hipOccupancyMaxActiveBlocksPerMultiprocessor(&per_cu, (const void*)mega_fwd, NWAVES * 64, LDS_BYTES) != hipSuccess || per_cu < 1) { fprintf(stderr, "kernel_launch: occupancy query says %d\n", per_cu); }
        (void)hipGetLastError();
        grid = cus;
    }
    if (grid < 0) return;
    if (hipMemsetAsync((char*)d_ws + WS_CTL, 0, CTL_ZERO_BYTES, stream) != hipSuccess) return;
    Args a{};
    for (int i = 0; i < 26; ++i) a.in[i] = (const float*)d_in[i];
    a.out = (float*)d_out; a.ws = (unsigned char*)d_ws;
    hipLaunchKernelGGL(mega_fwd, dim3(grid), dim3(NWAVES * 64), LDS_BYTES, stream, a);
}
```

```cpp
#include <hip/hip_runtime.h>
#include <cstdio>
#include <cstdint>
#include <cmath>

constexpr int BATCH = 16, SEQ = 2048, DM = 1024, M = BATCH * SEQ, DEPTH = 2;
constexpr int D_IN = 2048, D_FF = 2816, N_EXP = 8, D_FFE = 3584;
constexpr float LN_EPS = 1e-5f, RMS_EPS = 1e-6f;
constexpr float ALPHA = 1.41421356237309515f;
constexpr float LOG2E = 1.4426950408889634f;
constexpr float EGU_SCALE = 64.f, ED_SCALE = 128.f;
constexpr int NWAVES = 8;
#ifndef DENSE_FP8
#define DENSE_FP8 0
#endif
#ifndef DUP_P0
#define DUP_P0 1
#endif
#ifndef DUP_P1
#define DUP_P1 1
#endif
#ifndef DUP_P2
#define DUP_P2 1
#endif
#ifndef DUP_B
#define DUP_B 1
#endif
#ifndef DUP_C
#define DUP_C 1
#endif
#ifndef DUP_D
#define DUP_D 1
#endif
#ifndef DUP_GU
#define DUP_GU 1
#endif
#ifndef DUP_MOE
#define DUP_MOE 1
#endif

#define GAS __attribute__((address_space(1)))
#define LAS __attribute__((address_space(3)))
typedef unsigned short bf16_t;
typedef short bf16x8 __attribute__((ext_vector_type(8)));
typedef float f32x4 __attribute__((ext_vector_type(4)));
typedef float f32x2 __attribute__((ext_vector_type(2)));
typedef float f32x16 __attribute__((ext_vector_type(16)));
typedef unsigned u32x4 __attribute__((ext_vector_type(4)));
typedef unsigned u32x2 __attribute__((ext_vector_type(2)));
typedef short s16x4 __attribute__((ext_vector_type(4)));
typedef __bf16 bf16x2_t __attribute__((ext_vector_type(2)));
typedef GAS unsigned gu32;

__device__ __forceinline__ unsigned pkbf(float lo, float hi) { f32x2 v = {lo, hi}; bf16x2_t b = __builtin_convertvector(v, bf16x2_t); return __builtin_bit_cast(unsigned, b); }
typedef int i32x4 __attribute__((ext_vector_type(4)));
typedef int i32x8 __attribute__((ext_vector_type(8)));
__device__ __forceinline__ float clamp8(float v) { return __builtin_fminf(__builtin_fmaxf(v, -448.f), 448.f); }
__device__ __forceinline__ unsigned pk4_fp8(float a, float b, float c, float d) { int w = __builtin_amdgcn_cvt_pk_fp8_f32(clamp8(a), clamp8(b), 0, false); w = __builtin_amdgcn_cvt_pk_fp8_f32(clamp8(c), clamp8(d), w, true); return (unsigned)w; }
__device__ __forceinline__ float bf_lo(unsigned w) { return __uint_as_float(w << 16); }
__device__ __forceinline__ float bf_hi(unsigned w) { return __uint_as_float(w & 0xffff0000u); }
__device__ __forceinline__ int lane_id() { int l; asm volatile("v_mbcnt_lo_u32_b32 %0, -1, 0\n\tv_mbcnt_hi_u32_b32 %0, -1, %0" : "=v"(l)); return l; }
template <int K> __device__ __forceinline__ float xor_lane(float v) { return __int_as_float(__builtin_amdgcn_ds_swizzle(__float_as_int(v), (K << 10) | 0x1f)); }
__device__ __forceinline__ float sum_xor32(float v) { auto rr = __builtin_amdgcn_permlane32_swap(__float_as_uint(v), __float_as_uint(v), false, false); return __uint_as_float(rr[0]) + __uint_as_float(rr[1]); }
__device__ __forceinline__ float wave_sum(float v) {
    v += xor_lane<1>(v); v += xor_lane<2>(v); v += xor_lane<4>(v); v += xor_lane<8>(v); v += xor_lane<16>(v);
    return sum_xor32(v);
}

constexpr size_t MiB = 1u << 20;
constexpr size_t WS_CTL = 0, CTL_ZERO_BYTES = 1 * MiB;
constexpr size_t WS_ROPEC = 1 * MiB, WS_ROPES = 1 * MiB + 256 * 1024;
constexpr size_t WS_LTOK = 2 * MiB;
constexpr size_t WS_TPOS = 3 * MiB, WS_TGATE = 3 * MiB + 512 * 1024;
constexpr size_t WS_WIN = 4 * MiB;
constexpr size_t WS_WOUT = 12 * MiB;
constexpr size_t WS_WGU = 16 * MiB;
constexpr size_t WS_WD = 27 * MiB;
constexpr size_t WS_EGU = 33 * MiB;
constexpr size_t WS_ED = 89 * MiB;
constexpr size_t WS_XN = 201 * MiB;
constexpr size_t WS_R = 265 * MiB;
constexpr size_t WS_PJ = WS_R;
constexpr size_t WS_MIX = WS_R + 128 * MiB;
constexpr size_t WS_H = WS_R;
constexpr size_t WS_FO = WS_R + 176 * MiB;
constexpr size_t WS_XN8 = 117 * MiB;
constexpr size_t WS_Y = 149 * MiB;
constexpr size_t WS_HC = 281 * MiB;
constexpr size_t WS_END = 512 * MiB;
static_assert(WS_ED + (size_t)8 * DM * D_FFE <= WS_XN8 && WS_HC + (size_t)264 * 256 * D_FFE <= WS_END && WS_R + 192 * MiB <= WS_END, "ws map (MoE overlay)");
static_assert(WS_WD + (size_t)DM * D_FF * 2 <= WS_EGU && WS_EGU + (size_t)16 * DM * D_FFE <= WS_ED && WS_ED + (size_t)8 * DM * D_FFE <= WS_XN, "ws map");
constexpr int CW_TMO = 0, CW_BAR = 4096, CW_CNT = 8192, CW_Q = 9216, CW_NRM = 12288;
constexpr int CHUNK_TILES = 264;

constexpr int RING_BYTES = 131072;
constexpr int MISC_OFF = RING_BYTES;
constexpr int LDS_BYTES = 147456;
constexpr int VN_OFF = MISC_OFF + 2048;
static_assert(VN_OFF + 8192 <= LDS_BYTES, "LDS map");

#define XB_TMO      128
#define XB_XCNT(j)  (256  + 64 * (j))
#define XB_XSUB(j)  (1280 + 64 * (j))
#define XB_XGEN(j)  (2304 + 64 * (j))
#define XB_TOP      3328
#define XB_TOPGEN   3392
#define XCD_BAR_WORDS 3456
#define XB_SPIN_CAP (1u << 18)
__device__ __forceinline__ unsigned xb_ld(unsigned* p)              { return __hip_atomic_load(p, __ATOMIC_RELAXED, __HIP_MEMORY_SCOPE_AGENT); }
__device__ __forceinline__ unsigned xb_add(unsigned* p, unsigned v) { return __hip_atomic_fetch_add(p, v, __ATOMIC_RELAXED, __HIP_MEMORY_SCOPE_AGENT); }
__device__ __forceinline__ unsigned xb_xcc_id() { return (unsigned)__builtin_amdgcn_s_getreg((3 << 11) | 20) & 0xFu; }
#define XB_SPIN(cond, bar) do { unsigned _sp = 0; while (cond) { __builtin_amdgcn_s_sleep(1); \
    if ((++_sp & 255u) == 0u) { if (xb_ld(&(bar)[XB_TMO])) break; if (_sp > XB_SPIN_CAP) { atomicAdd(&(bar)[XB_TMO], 1u); break; } } } } while (0)
struct XcdBarrier { unsigned* bar; unsigned x; volatile LAS unsigned* st; };
__device__ __forceinline__ XcdBarrier xcd_barrier_post(unsigned* bar, volatile LAS unsigned* st, bool t0) {
    XcdBarrier b; b.bar = bar; b.x = xb_xcc_id(); b.st = st;
    if (t0) (void)xb_add(&bar[XB_XCNT(b.x)], 1u);
    return b;
}
__device__ __forceinline__ void xcd_barrier_complete(unsigned* bar, unsigned x, unsigned& nloc, unsigned& nx) {
    const unsigned G = gridDim.x * gridDim.y * gridDim.z;
    unsigned sum, cnt, mine, sp = 0u;
    for (;;) {
        sum = 0u; cnt = 0u; mine = 0u;
#pragma unroll
        for (unsigned j = 0; j < 16; ++j) { const unsigned c = xb_ld(&bar[XB_XCNT(j)]); sum += c; cnt += (c > 0u) ? 1u : 0u; mine = (j == x) ? c : mine; }
        if (sum == G) break;
        __builtin_amdgcn_s_sleep(1);
        if ((++sp & 255u) == 0u) { if (xb_ld(&bar[XB_TMO])) break; if (sp > XB_SPIN_CAP) { atomicAdd(&bar[XB_TMO], 1u); break; } }
    }
    nloc = mine > 0u ? mine : 1u; nx = cnt > 0u ? cnt : 1u;
}
__device__ __forceinline__ void xcd_barrier(const XcdBarrier& b, bool t0) {
    asm volatile("s_waitcnt vmcnt(0)" ::: "memory");
    __syncthreads();
    if (t0) {
        unsigned* bar = b.bar; asm volatile("" : "+s"(bar));
        __builtin_amdgcn_s_waitcnt(0);
        unsigned nloc = b.st[0], nx = b.st[1];
        unsigned bx = b.x; asm volatile("" : "+s"(bx));
        if (nloc == 0u) { xcd_barrier_complete(bar, bx, nloc, nx); b.st[0] = nloc; b.st[1] = nx; }
        const unsigned old = xb_add(&bar[XB_XSUB(bx)], 1u);
        const unsigned gen = old / nloc;
        if (old + 1u == (gen + 1u) * nloc) {
            __builtin_amdgcn_fence(__ATOMIC_RELEASE, "agent");
            asm volatile("s_waitcnt vmcnt(0)" ::: "memory");
            const unsigned og = xb_add(&bar[XB_TOP], 1u);
            const unsigned tg = og / nx;
            if (og + 1u == (tg + 1u) * nx) xb_add(&bar[XB_TOPGEN], 1u);
            else XB_SPIN(xb_ld(&bar[XB_TOPGEN]) == tg, bar);
            __builtin_amdgcn_fence(__ATOMIC_ACQUIRE, "agent");
            xb_add(&bar[XB_XGEN(bx)], 1u);
            asm volatile("s_waitcnt vmcnt(0)" ::: "memory");
        } else {
            XB_SPIN(xb_ld(&bar[XB_XGEN(bx)]) == gen, bar);
            __builtin_amdgcn_fence(__ATOMIC_ACQUIRE, "agent");
            asm volatile("s_waitcnt vmcnt(0)" ::: "memory");
        }
    }
    __syncthreads();
}

namespace pg8 {
constexpr int BM = 256, BK = 64, HALF = 128, HTB = HALF * BK * 2, STAGE_BYTES = 8 * HTB, NXCD = 8, WGM = 8;
__device__ __forceinline__ int lds_byte(int r, int c) { const int st = (r >> 4) * 2 + (c >> 5), rr = r & 15, cc = c & 31, ob = rr * 64 + cc * 2; return st * 1024 + (ob ^ (((ob >> 9) & 1) << 5)); }
__device__ __forceinline__ void stage_rc(int b, int& R, int& C) { const int st = b / 1024, sb = b % 1024, swz = sb ^ (((sb >> 9) & 1) << 5); R = (st >> 1) * 16 + swz / 64; C = (st & 1) * 32 + (swz % 64) / 2; }
__device__ __forceinline__ int perm32(int rho) { const int n = rho >> 4, i = rho & 15; return 8 * (i >> 2) + 4 * n + (i & 3); }

struct Unit { int pm, pn, e, p0, cnt; };
struct Gemm { const void* A; const void* Bt; int K; size_t estride; };

__device__ __forceinline__ bool grid_order(int i, int G, int c, int nM, int nN, int& pm, int& pn) {
    const int nwg = nM * nN; const long L = (long)i * G + c; if (L >= nwg) return false;
    int wgid = (int)L; { const int q = nwg / NXCD, r = nwg % NXCD, xcd = wgid % NXCD, off = wgid / NXCD; wgid = (xcd < r ? xcd * (q + 1) : r * (q + 1) + (xcd - r) * q) + off; }
    const int nig = WGM * nN, gid = wgid / nig, fm = gid * WGM, gsz = (nM - fm) < WGM ? (nM - fm) : WGM;
    pm = fm + ((wgid % nig) % gsz); pn = (wgid % nig) / gsz; return true;
}
struct StaticOrder {
    int nM, nN, G, c;
    __device__ void init(int Mrows, int N, int G_, int c_) { nM = Mrows / BM; nN = N / BM; G = G_; c = c_; }
    __device__ __forceinline__ bool next(int i, Unit& u) const { u.e = 0; u.p0 = 0; u.cnt = 0; return grid_order(i, G, c, nM, nN, u.pm, u.pn); }
    __device__ __forceinline__ int arow(const Unit& u, int r) const { return u.pm * BM + r; }
};

template <class Epi, class Sched, bool ALIGN_EPI, bool GATHER = false, int ES = 2>
__device__ __forceinline__ void gemm_phase(LAS unsigned char* lds, const Gemm g, const Sched& S, const Epi& E, int wave0) {
    int tid = wave0 * 64 + lane_id(); asm volatile("" : "+v"(tid));
    const int wid = __builtin_amdgcn_readfirstlane(tid >> 6), lane = tid & 63, wr = wid >> 2, wc = wid & 3, fr = lane & 15, fq = lane >> 4;
    const int K = g.K, nt = K * ES / 128;
    unsigned voffA, voffB;
    { int R, C; stage_rc(tid * 16, R, C); const int Rb = Epi::PERM ? ((R & ~31) + perm32(R & 31)) : R; voffA = (unsigned)(R * K * ES + C * 2); voffB = (unsigned)(Rb * K * ES + C * 2); }
    const unsigned pstep = (unsigned)(64 * K * ES);
    const unsigned kstep = 128u;
    const unsigned hstep = (unsigned)(HALF * K * ES);
    const unsigned tstep = 2u * hstep;
    const unsigned ldsw = (unsigned)wid * 1024u;
    const unsigned lp = (unsigned)lds_byte(fr, fq * 8); const unsigned aS = (unsigned)wr * 8192u, bS = (unsigned)wc * 4096u;
#define PG8_ADDR(soff) ({ unsigned _t = lp; asm volatile("" : "+v"(_t)); _t + (soff); })
    const __amdgpu_buffer_rsrc_t rA = __builtin_amdgcn_make_buffer_rsrc(const_cast<void*>(g.A), 0, 0x7fffffff, 0x00020000);
    const __amdgpu_buffer_rsrc_t rB = __builtin_amdgcn_make_buffer_rsrc(const_cast<void*>(g.Bt), 0, 0x7fffffff, 0x00020000);
#define PG8_SA(b, h) (((b) * 2 + (h)) * HTB)
#define PG8_SB(b, h) ((4 + (b) * 2 + (h)) * HTB)
#define PG8_STAGE(bufoff, rsrc, soff, voff) do { _Pragma("unroll") for (int _i = 0; _i < 2; ++_i) \
        __builtin_amdgcn_raw_ptr_buffer_load_lds(rsrc, (LAS unsigned*)(lds + (bufoff) + ldsw + _i * 8192), 16, (voff), (int)((soff) + _i * pstep), 0, 0); } while (0)
#define PG8_STAGE_G(bufoff, rsrc, soff, V) do { _Pragma("unroll") for (int _i = 0; _i < 2; ++_i) \
        __builtin_amdgcn_raw_ptr_buffer_load_lds(rsrc, (LAS unsigned*)(lds + (bufoff) + ldsw + _i * 8192), 16, (V)[_i], (int)(soff), 0, 0); } while (0)
#define PG8_STAGE_A(bufoff, uo, kb, h, V) do { if constexpr (GATHER) { PG8_STAGE_G(bufoff, rA, (kb), (V)[h]); } else { PG8_STAGE(bufoff, rA, (uo) + (kb) + (h) * hstep, voffA); } } while (0)
#define PG8_AOFF(dst, u) do { const int _t = wid * 64 + lane_id(); _Pragma("unroll") for (int _i = 0; _i < 2; ++_i) { int _R, _C; stage_rc(_t * 16 + _i * 8192, _R, _C); _Pragma("unroll") for (int _h = 0; _h < 2; ++_h) \
        dst[_h][_i] = (unsigned)S.arow(u, _R + _h * HALF) * (unsigned)(K * ES) + (unsigned)_C * 2u; } } while (0)
#define PG8_FR(p) (*(const LAS bf16x8*)(p))
#define PG8_FR8(p) __builtin_shufflevector(__builtin_bit_cast(i32x4, PG8_FR(p)), __builtin_bit_cast(i32x4, PG8_FR((p) + 1024)), 0, 1, 2, 3, 4, 5, 6, 7)
#define PG8_LDA(dst, b, h) do { const unsigned aoff = PG8_ADDR(aS); _Pragma("unroll") for (int m = 0; m < 4; ++m) { if constexpr (ES == 2) { _Pragma("unroll") for (int k = 0; k < 2; ++k) dst[m][k] = PG8_FR(lds + PG8_SA(b, h) + aoff + m * 2048 + k * 1024); } \
        else dst##8[m] = PG8_FR8(lds + PG8_SA(b, h) + aoff + m * 2048); } } while (0)
#define PG8_LDB(dst, b, h) do { const unsigned boff = PG8_ADDR(bS); _Pragma("unroll") for (int n = 0; n < 2; ++n) { if constexpr (ES == 2) { _Pragma("unroll") for (int k = 0; k < 2; ++k) dst[n][k] = PG8_FR(lds + PG8_SB(b, h) + boff + n * 2048 + k * 1024); } \
        else dst##8[n] = PG8_FR8(lds + PG8_SB(b, h) + boff + n * 2048); } } while (0)
#define PG8_MMA(ai, bj, At, Bt) do { __builtin_amdgcn_s_setprio(1); _Pragma("unroll") for (int m = 0; m < 4; ++m) _Pragma("unroll") for (int n = 0; n < 2; ++n) { \
        if constexpr (ES == 2) { _Pragma("unroll") for (int k = 0; k < 2; ++k) acc[ai][bj][m][n] = __builtin_amdgcn_mfma_f32_16x16x32_bf16(Bt[n][k], At[m][k], acc[ai][bj][m][n], 0, 0, 0); } \
        else { asm volatile("v_mfma_f32_16x16x128_f8f6f4 %0, %1, %2, %0" : "+v"(acc[ai][bj][m][n]) : "v"(Bt##8[n]), "v"(At##8[m])); } } \
        __builtin_amdgcn_s_setprio(0); } while (0)
#define PG8_WAIT_V(n) asm volatile("s_waitcnt vmcnt(" #n ")" ::: "memory")
#define PG8_WAIT_L(n) asm volatile("s_waitcnt lgkmcnt(" #n ")" ::: "memory")
#define PG8_BAR __builtin_amdgcn_s_barrier()
#define PG8_SCHED __builtin_amdgcn_sched_barrier(0)
    Unit cur, nxt; int ui = 0;
    if (!S.next(0, cur)) return;
    f32x4 acc[2][2][4][2];
#pragma unroll
    for (int a = 0; a < 2; ++a)
#pragma unroll
        for (int b = 0; b < 2; ++b)
#pragma unroll
            for (int m = 0; m < 4; ++m)
#pragma unroll
                for (int n = 0; n < 2; ++n) acc[a][b][m][n] = (f32x4){0.f, 0.f, 0.f, 0.f};
    bf16x8 At[4][2], B0[2][2], B1[2][2];
    i32x8 At8[4], B08[2], B18[2];
    unsigned vc[2][2];
    LAS u32x4* vstash = (LAS u32x4*)(lds + VN_OFF - 0) + tid;
    if constexpr (GATHER) { PG8_AOFF(vc, cur); }
    unsigned cA = GATHER ? 0u : (unsigned)S.arow(cur, 0) * (unsigned)(K * ES);
    unsigned cB = (unsigned)cur.e * (unsigned)g.estride + (unsigned)cur.pn * tstep;
    PG8_STAGE(PG8_SB(0, 0), rB, cB, voffB); PG8_STAGE(PG8_SB(0, 1), rB, cB + hstep, voffB); PG8_STAGE_A(PG8_SA(0, 0), cA, 0u, 0, vc); PG8_STAGE_A(PG8_SA(0, 1), cA, 0u, 1, vc);
    if (wr == 1) PG8_BAR;
    PG8_WAIT_V(2); PG8_BAR;
    PG8_STAGE(PG8_SB(1, 0), rB, cB + kstep, voffB); PG8_STAGE_A(PG8_SA(1, 0), cA, kstep, 0, vc); PG8_STAGE(PG8_SB(1, 1), rB, cB + hstep + kstep, voffB);
    PG8_WAIT_V(6); PG8_BAR;
    for (;;) {
        const bool has_next = S.next(ui + 1, nxt);
        if constexpr (GATHER) { unsigned vn[2][2];
            if (has_next) { PG8_AOFF(vn, nxt); } else {
#pragma unroll
                for (int h = 0; h < 2; ++h)
#pragma unroll
                    for (int i = 0; i < 2; ++i) vn[h][i] = vc[h][i]; }
            *vstash = (u32x4){vn[0][0], vn[0][1], vn[1][0], vn[1][1]}; }
        const unsigned nA = GATHER ? 0u : (has_next ? (unsigned)S.arow(nxt, 0) * (unsigned)(K * ES) : cA);
        const unsigned nB = has_next ? (unsigned)nxt.e * (unsigned)g.estride + (unsigned)nxt.pn * tstep : cB;
        for (int t = 0; t < nt; t += 2) {
            const bool last = (t == nt - 2);
            const unsigned k1 = (unsigned)(t + 1) * kstep;
            const unsigned k2 = last ? 0u : (unsigned)(t + 2) * kstep, k3 = k2 + kstep;
            const unsigned a2 = last ? nA : cA;
            const unsigned b2 = last ? nB : cB + (unsigned)(t + 2) * kstep, b3 = b2 + kstep;
            PG8_LDB(B0, 0, 0); PG8_LDB(B1, 0, 1); PG8_SCHED; PG8_LDA(At, 0, 0); PG8_STAGE_A(PG8_SA(1, 1), cA, k1, 1, vc);
            if constexpr (GATHER) { if (last) { const u32x4 vv = *vstash; vc[0][0] = vv[0]; vc[0][1] = vv[1]; vc[1][0] = vv[2]; vc[1][1] = vv[3]; } }
            PG8_WAIT_V(8); PG8_WAIT_L(0); PG8_BAR; PG8_MMA(0, 0, At, B0); PG8_MMA(0, 1, At, B1); PG8_BAR; PG8_SCHED;
            PG8_LDA(At, 0, 1); PG8_STAGE(PG8_SB(0, 0), rB, b2, voffB); PG8_STAGE(PG8_SB(0, 1), rB, b2 + hstep, voffB); PG8_STAGE_A(PG8_SA(0, 0), a2, k2, 0, vc);
            PG8_WAIT_V(8); PG8_WAIT_L(0); PG8_BAR; PG8_MMA(1, 0, At, B0); PG8_MMA(1, 1, At, B1); PG8_BAR; PG8_SCHED;
            PG8_LDB(B0, 1, 0); PG8_LDB(B1, 1, 1); PG8_SCHED; PG8_LDA(At, 1, 0); PG8_STAGE_A(PG8_SA(0, 1), a2, k2, 1, vc);
            PG8_WAIT_V(8); PG8_WAIT_L(0); PG8_BAR; PG8_MMA(0, 0, At, B0); PG8_MMA(0, 1, At, B1); PG8_BAR; PG8_SCHED;
            PG8_LDA(At, 1, 1); PG8_STAGE(PG8_SB(1, 0), rB, b3, voffB); PG8_STAGE(PG8_SB(1, 1), rB, b3 + hstep, voffB); PG8_STAGE_A(PG8_SA(1, 0), a2, k3, 0, vc);
            PG8_WAIT_V(8); PG8_WAIT_L(0); PG8_BAR; PG8_MMA(1, 0, At, B0); PG8_MMA(1, 1, At, B1); PG8_BAR; PG8_SCHED;
        }
        if constexpr (ALIGN_EPI) { if (wr == 0) PG8_BAR; }
        if constexpr (ES == 1) asm volatile("s_nop 15\n\ts_nop 15" ::: "memory");
        { const int l2 = lane_id(); E(acc, cur, wr, wc, l2 & 15, l2 >> 4); }
        if (!has_next) break;
#pragma unroll
        for (int a = 0; a < 2; ++a)
#pragma unroll
            for (int b = 0; b < 2; ++b)
#pragma unroll
                for (int m = 0; m < 4; ++m)
#pragma unroll
                    for (int n = 0; n < 2; ++n) acc[a][b][m][n] = (f32x4){0.f, 0.f, 0.f, 0.f};
        cur = nxt; cA = nA; cB = nB; ++ui;
        if constexpr (ALIGN_EPI) { if (wr == 1) PG8_BAR; }
    }
    PG8_WAIT_V(0);
    if constexpr (!ALIGN_EPI) { if (wr == 0) PG8_BAR; }
    PG8_BAR;
#undef PG8_SA
#undef PG8_SB
#undef PG8_STAGE
#undef PG8_STAGE_G
#undef PG8_STAGE_A
#undef PG8_AOFF
#undef PG8_LDA
#undef PG8_LDB
#undef PG8_MMA
#undef PG8_FR
#undef PG8_ADDR
#undef PG8_FR8
#undef PG8_WAIT_V
#undef PG8_WAIT_L
#undef PG8_BAR
#undef PG8_SCHED
}

struct EpiProj {
    static constexpr bool PERM = true;
    bf16_t* PJ; const float* qn; const float* kn; const float* ropec; const float* ropes; unsigned* nrm;
    __device__ __forceinline__ void operator()(const f32x4 (&acc)[2][2][4][2], const Unit& u, int wr, int wc, int fr, int fq) const {
        const int row0 = u.pm * BM + wr * 64 + fr, pn = u.pn;
        const bool htype = (pn == 1) || (pn == 2);
        const bool roped = (pn == 1) || (pn == 2 && wc < 2);
        if (!htype) {
            const float sc = (pn == 3) ? 0.17677669529663687f * LOG2E : (pn == 6 ? 0.125f * LOG2E : 1.f);
            const int col0 = pn * BM + wc * 32 + 8 * fq;
            float nmax[2] = {0.f, 0.f};
#pragma unroll
            for (int ai = 0; ai < 2; ++ai)
#pragma unroll
                for (int m = 0; m < 4; ++m) { bf16_t* rowp = PJ + (size_t)(row0 + ai * HALF + m * 16) * D_IN + col0;
#pragma unroll
                    for (int bj = 0; bj < 2; ++bj) { const f32x4 v0 = acc[ai][bj][m][0] * sc, v1 = acc[ai][bj][m][1] * sc;
                        u32x4 w; w.x = pkbf(v0[0], v0[1]); w.y = pkbf(v0[2], v0[3]); w.z = pkbf(v1[0], v1[1]); w.w = pkbf(v1[2], v1[3]);
                        *(u32x4*)(rowp + bj * HALF) = w;
                        if (pn == 3 || pn == 4) { float ss = (v0[0] * v0[0] + v0[1] * v0[1]) + (v0[2] * v0[2] + v0[3] * v0[3]) + (v1[0] * v1[0] + v1[1] * v1[1]) + (v1[2] * v1[2] + v1[3] * v1[3]);
                            ss += xor_lane<16>(ss); ss = sum_xor32(ss); nmax[bj] = __builtin_fmaxf(nmax[bj], ss); } } }
            if (pn == 3 || pn == 4) {
#pragma unroll
                for (int bj = 0; bj < 2; ++bj) { float v = nmax[bj]; v = __builtin_fmaxf(v, xor_lane<1>(v)); v = __builtin_fmaxf(v, xor_lane<2>(v)); v = __builtin_fmaxf(v, xor_lane<4>(v)); v = __builtin_fmaxf(v, xor_lane<8>(v));
                    if (fr == 0 && fq == 0) { const int b = (u.pm * BM) / SEQ, h = 2 * bj + (wc >> 1), c = wc & 1;
                        __hip_atomic_fetch_max(nrm + ((pn - 3) * 16 + b) * 8 + h * 2 + c, __float_as_uint(v), __ATOMIC_RELAXED, __HIP_MEMORY_SCOPE_AGENT); } }
            }
        } else {
            const int colh = pn * BM + wc * 64 + 8 * fq;
            if (!roped) {
#pragma unroll
                for (int ai = 0; ai < 2; ++ai)
#pragma unroll
                    for (int m = 0; m < 4; ++m) { bf16_t* rowp = PJ + (size_t)(row0 + ai * HALF + m * 16) * D_IN + colh;
#pragma unroll
                        for (int bj = 0; bj < 2; ++bj) { const f32x4 v0 = acc[ai][bj][m][0], v1 = acc[ai][bj][m][1];
                            u32x4 w; w.x = pkbf(v0[0], v0[1]); w.y = pkbf(v0[2], v0[3]); w.z = pkbf(v1[0], v1[1]); w.w = pkbf(v1[2], v1[3]);
                            *(u32x4*)(rowp + bj * 32) = w; } }
            } else {
                const float* nw = (pn == 1) ? qn : kn; const float osc = (pn == 1) ? 0.125f * LOG2E : 1.f;
                f32x4 w1[2], w2[2];
#pragma unroll
                for (int bj = 0; bj < 2; ++bj) { w1[bj] = *(const f32x4*)(nw + 32 * bj + 4 * fq); w2[bj] = *(const f32x4*)(nw + 32 * bj + 16 + 4 * fq); }
#pragma unroll
                for (int ai = 0; ai < 2; ++ai)
#pragma unroll
                    for (int m = 0; m < 4; ++m) {
                        const int row = row0 + ai * HALF + m * 16, s = row & (SEQ - 1);
                        float ss = 0.f;
#pragma unroll
                        for (int bj = 0; bj < 2; ++bj)
#pragma unroll
                            for (int n = 0; n < 2; ++n) { const f32x4 x = acc[ai][bj][m][n]; ss += (x[0] * x[0] + x[1] * x[1]) + (x[2] * x[2] + x[3] * x[3]); }
                        ss += xor_lane<16>(ss); ss = sum_xor32(ss);
                        const float rinv = 1.0f / sqrtf(ss * (1.f / 64.f) + RMS_EPS);
                        bf16_t* rowp = PJ + (size_t)row * D_IN + colh;
#pragma unroll
                        for (int bj = 0; bj < 2; ++bj) {
                            const f32x4 c = *(const f32x4*)(ropec + s * 32 + bj * 16 + 4 * fq), sn = *(const f32x4*)(ropes + s * 32 + bj * 16 + 4 * fq);
                            const f32x4 x1 = acc[ai][bj][m][0] * rinv * w1[bj], x2 = acc[ai][bj][m][1] * rinv * w2[bj];
                            const f32x4 o1 = (x1 * c - x2 * sn) * osc, o2 = (x2 * c + x1 * sn) * osc;
                            u32x4 w; w.x = pkbf(o1[0], o1[1]); w.y = pkbf(o1[2], o1[3]); w.z = pkbf(o2[0], o2[1]); w.w = pkbf(o2[2], o2[3]);
                            *(u32x4*)(rowp + bj * 32) = w; }
                    }
            }
        }
    }
};
struct EpiResid {
    static constexpr bool PERM = false;
    float* X; float sc;
    __device__ __forceinline__ void operator()(const f32x4 (&acc)[2][2][4][2], const Unit& u, int wr, int wc, int fr, int fq) const {
        const int row0 = u.pm * BM + wr * 64 + fr, col0 = u.pn * BM + wc * 32 + 4 * fq;
#pragma unroll
        for (int ai = 0; ai < 2; ++ai)
#pragma unroll
            for (int m = 0; m < 4; ++m) { float* rowp = X + (size_t)(row0 + ai * HALF + m * 16) * DM + col0;
#pragma unroll
                for (int bj = 0; bj < 2; ++bj)
#pragma unroll
                    for (int n = 0; n < 2; ++n) { f32x4* p = (f32x4*)(rowp + bj * HALF + n * 16); *p = *p * ALPHA + acc[ai][bj][m][n] * sc; } }
    }
};
template <bool OUT8>
struct EpiSwiGLU {
    static constexpr bool PERM = true;
    void* H; int ldh; int rt0;
    __device__ __forceinline__ void operator()(const f32x4 (&acc)[2][2][4][2], const Unit& u, int wr, int wc, int fr, int fq) const {
        const int row0 = (u.pm - rt0) * BM + wr * 64 + fr, col0 = u.pn * HALF + wc * 32 + 8 * fq;
#pragma unroll
        for (int ai = 0; ai < 2; ++ai)
#pragma unroll
            for (int m = 0; m < 4; ++m) {
                float o[8];
#pragma unroll
                for (int n = 0; n < 2; ++n)
#pragma unroll
                    for (int j = 0; j < 4; j += 2) { constexpr float isc = OUT8 ? 1.0f / EGU_SCALE : 1.0f;
                        const f32x2 g2 = {acc[ai][0][m][n][j], acc[ai][0][m][n][j + 1]}, u2 = {acc[ai][1][m][n][j], acc[ai][1][m][n][j + 1]};
                        const f32x2 a2 = g2 * (-LOG2E * isc); f32x2 d2; d2.x = 1.0f + __builtin_amdgcn_exp2f(a2.x); d2.y = 1.0f + __builtin_amdgcn_exp2f(a2.y);
                        f32x2 r2; r2.x = __builtin_amdgcn_rcpf(d2.x); r2.y = __builtin_amdgcn_rcpf(d2.y);
                        const f32x2 o2 = (g2 * (isc * isc)) * u2 * r2; o[4 * n + j] = o2.x; o[4 * n + j + 1] = o2.y; }
                if constexpr (OUT8) { u32x2 w; w.x = pk4_fp8(o[0], o[1], o[2], o[3]); w.y = pk4_fp8(o[4], o[5], o[6], o[7]);
                    *(u32x2*)((unsigned char*)H + (size_t)(row0 + ai * HALF + m * 16) * ldh + col0) = w; }
                else { u32x4 w; w.x = pkbf(o[0], o[1]); w.y = pkbf(o[2], o[3]); w.z = pkbf(o[4], o[5]); w.w = pkbf(o[6], o[7]);
                    *(u32x4*)((bf16_t*)H + (size_t)(row0 + ai * HALF + m * 16) * ldh + col0) = w; } }
    }
};
struct EpiBf16 {
    static constexpr bool PERM = true;
    bf16_t* O; int ldc; float sc;
    __device__ __forceinline__ void operator()(const f32x4 (&acc)[2][2][4][2], const Unit& u, int wr, int wc, int fr, int fq) const {
        const int row0 = u.pm * BM + wr * 64 + fr, col0 = u.pn * BM + wc * 32 + 8 * fq;
#pragma unroll
        for (int ai = 0; ai < 2; ++ai)
#pragma unroll
            for (int m = 0; m < 4; ++m) { bf16_t* rowp = O + (size_t)(row0 + ai * HALF + m * 16) * ldc + col0;
#pragma unroll
                for (int bj = 0; bj < 2; ++bj) { const f32x4 v0 = acc[ai][bj][m][0] * sc, v1 = acc[ai][bj][m][1] * sc;
                    u32x4 w; w.x = pkbf(v0[0], v0[1]); w.y = pkbf(v0[2], v0[3]); w.z = pkbf(v1[0], v1[1]); w.w = pkbf(v1[2], v1[3]);
                    *(u32x4*)(rowp + bj * HALF) = w; } }
    }
};
}

struct MoeTable { volatile LAS int* T; };
__device__ __forceinline__ int moe_expert_of(const MoeTable& t, int rt) { int e = 0;
#pragma unroll
    for (int j = 1; j < 8; ++j) e += (rt >= t.T[j]) ? 1 : 0;
    return __builtin_amdgcn_readfirstlane(e); }
struct MoeOrder {
    MoeTable tab; int rt_lo, nM, nN, G, c; const int* ltok; bool gather;
    __device__ __forceinline__ bool next(int i, pg8::Unit& u) const {
        int pm, pn; if (!pg8::grid_order(i, G, c, nM, nN, pm, pn)) return false;
        u.pm = rt_lo + pm; u.pn = pn; u.e = moe_expert_of(tab, u.pm); u.p0 = __builtin_amdgcn_readfirstlane((u.pm - tab.T[u.e]) * 256); u.cnt = __builtin_amdgcn_readfirstlane(tab.T[16 + u.e]); return true; }
    __device__ __forceinline__ int arow(const pg8::Unit& u, int r) const {
        if (gather) { const int p = u.p0 + r; return p < u.cnt ? ltok[u.e * M + p] : 0; }
        return (u.pm - rt_lo) * 256 + r; }
};

namespace att {
constexpr int PJP = D_IN, MXP = DM, SLOTB = 8192;
constexpr int NSLOT = 3;
constexpr int L_K = 0, L_V = NSLOT * SLOTB, L_WS = 2 * NSLOT * SLOTB, L_OST = L_WS + 8 * 512, OST_W = 32 * 68 * 4, L_BYTES = L_OST + 8 * OST_W;
static_assert(L_BYTES <= RING_BYTES, "attention scratch");
constexpr float THR = 8.0f;
__device__ __forceinline__ int crow(int r, int hi) { return (r & 3) + 8 * (r >> 2) + 4 * hi; }
__device__ __forceinline__ void glds16(const void* gsrc, unsigned lds_dst) { unsigned keep;
    asm volatile("s_mov_b32 %0, m0\n\ts_mov_b32 m0, %2\n\ts_nop 0\n\tglobal_load_lds_dwordx4 %1, off\n\ts_mov_b32 m0, %0" : "=&s"(keep) : "v"(gsrc), "s"(lds_dst) : "memory"); }
#define ATT_MX3(a, b, c) __builtin_fmaxf(__builtin_fmaxf((a), (b)), (c))
__device__ __forceinline__ float rowmax(const f32x16& p0, const f32x16& p1) {
    float a = ATT_MX3(p0[0], p0[1], p1[0]), b = ATT_MX3(p0[2], p0[3], p1[1]); a = ATT_MX3(a, p1[2], p1[3]);
#pragma unroll
    for (int r = 4; r < 16; r += 4) { a = ATT_MX3(a, p0[r], p0[r + 1]); b = ATT_MX3(b, p0[r + 2], p0[r + 3]); a = ATT_MX3(a, p1[r], p1[r + 1]); b = ATT_MX3(b, p1[r + 2], p1[r + 3]); }
    float m = __builtin_fmaxf(a, b); auto rr = __builtin_amdgcn_permlane32_swap(__float_as_uint(m), __float_as_uint(m), false, false);
    return __builtin_fmaxf(__uint_as_float(rr[0]), __uint_as_float(rr[1])); }
template <int D0, int NS>
__device__ __forceinline__ void qkt(f32x16& p0, f32x16& p1, const LAS unsigned char* Kslot, const bf16x8* qr, const f32x16& ci0, const f32x16& ci1, int r32, int hi) {
    const LAS unsigned char* kb = Kslot + hi * 1024 + r32 * 16;
#pragma unroll
    for (int s = 0; s < NS; ++s) { const int d0 = D0 + s;
        const bf16x8 b0 = *(const LAS bf16x8*)(kb + d0 * 2048), b1 = *(const LAS bf16x8*)(kb + d0 * 2048 + 512);
        if (s == 0) { p0 = __builtin_amdgcn_mfma_f32_32x32x16_bf16(b0, qr[d0], ci0, 0, 0, 0); p1 = __builtin_amdgcn_mfma_f32_32x32x16_bf16(b1, qr[d0], ci1, 0, 0, 0); }
        else { p0 = __builtin_amdgcn_mfma_f32_32x32x16_bf16(b0, qr[d0], p0, 0, 0, 0); p1 = __builtin_amdgcn_mfma_f32_32x32x16_bf16(b1, qr[d0], p1, 0, 0, 0); } }
}
__device__ __forceinline__ void pv(f32x16* o, int vb, bf16x8 pa0, bf16x8 pa1, bf16x8 pa2, bf16x8 pa3) {
#pragma unroll
    for (int d0 = 0; d0 < 2; ++d0) { s16x4 lo[4], hi[4];
#pragma unroll
        for (int ks = 0; ks < 4; ++ks) {
            asm volatile("ds_read_b64_tr_b16 %0,%1 offset:%c2" : "=&v"(lo[ks]) : "v"(vb), "i"(d0 * 4096 + ks * 1024) : "memory");
            asm volatile("ds_read_b64_tr_b16 %0,%1 offset:%c2" : "=&v"(hi[ks]) : "v"(vb), "i"(d0 * 4096 + ks * 1024 + 512) : "memory"); }
        asm volatile("s_waitcnt lgkmcnt(0)" ::: "memory"); __builtin_amdgcn_sched_barrier(0);
#define ATT_PK(k) (bf16x8){lo[k][0], lo[k][1], lo[k][2], lo[k][3], hi[k][0], hi[k][1], hi[k][2], hi[k][3]}
        o[d0] = __builtin_amdgcn_mfma_f32_32x32x16_bf16(pa0, ATT_PK(0), o[d0], 0, 0, 0);
        o[d0] = __builtin_amdgcn_mfma_f32_32x32x16_bf16(pa1, ATT_PK(1), o[d0], 0, 0, 0);
        o[d0] = __builtin_amdgcn_mfma_f32_32x32x16_bf16(pa2, ATT_PK(2), o[d0], 0, 0, 0);
        o[d0] = __builtin_amdgcn_mfma_f32_32x32x16_bf16(pa3, ATT_PK(3), o[d0], 0, 0, 0);
#undef ATT_PK
    }
}
template <int NC>
__device__ __forceinline__ void pvn(f32x16 (&o)[NC][2], f32x16 (&ol)[NC], int vb, const u32x4 (&pw)[NC][4]) {
    { const bf16x8 ones = (bf16x8){0x3f80, 0x3f80, 0x3f80, 0x3f80, 0x3f80, 0x3f80, 0x3f80, 0x3f80};
#pragma unroll
      for (int ks = 0; ks < 4; ++ks)
#pragma unroll
        for (int c = 0; c < NC; ++c) ol[c] = __builtin_amdgcn_mfma_f32_32x32x16_bf16(__builtin_bit_cast(bf16x8, pw[c][ks]), ones, ol[c], 0, 0, 0); }
#pragma unroll
    for (int d0 = 0; d0 < 2; ++d0) { s16x4 lo[4], hi[4];
#pragma unroll
        for (int ks = 0; ks < 4; ++ks) {
            asm volatile("ds_read_b64_tr_b16 %0,%1 offset:%c2" : "=&v"(lo[ks]) : "v"(vb), "i"(d0 * 4096 + ks * 1024) : "memory");
            asm volatile("ds_read_b64_tr_b16 %0,%1 offset:%c2" : "=&v"(hi[ks]) : "v"(vb), "i"(d0 * 4096 + ks * 1024 + 512) : "memory"); }
        asm volatile("s_waitcnt lgkmcnt(0)" ::: "memory"); __builtin_amdgcn_sched_barrier(0);
#pragma unroll
        for (int ks = 0; ks < 4; ++ks) { const bf16x8 vf = (bf16x8){lo[ks][0], lo[ks][1], lo[ks][2], lo[ks][3], hi[ks][0], hi[ks][1], hi[ks][2], hi[ks][3]};
#pragma unroll
            for (int c = 0; c < NC; ++c) o[c][d0] = __builtin_amdgcn_mfma_f32_32x32x16_bf16(__builtin_bit_cast(bf16x8, pw[c][ks]), vf, o[c][d0], 0, 0, 0); }
    }
}
struct Par { float slope2; float sink2; float lam; float oscale; const float* subln; int dcut; };
template <int VAR>
__device__ __forceinline__ void unit(int b, int h, int qb, const bf16_t* PJ, bf16_t* MIX, LAS unsigned char* shm, const Par P, int wave0) {
    constexpr int NC = (VAR == 1) ? 2 : 1;
    constexpr int QC = VAR == 0 ? 256 : (VAR == 1 ? 768 : 1536), KC = VAR == 0 ? 512 : (VAR == 1 ? 1024 : 1792), VC = VAR == 0 ? 640 : (VAR == 1 ? 1280 : 1920), OC = VAR == 0 ? 256 : (VAR == 1 ? 512 : 768);
    int tid = wave0 * 64 + lane_id(); asm volatile("" : "+v"(tid));
    const int lane = tid & 63, r32 = lane & 31, hi = lane >> 5; const int wid = __builtin_amdgcn_readfirstlane(tid >> 6);
    const long rowbase = (long)b * SEQ; const int q0 = qb * 256;
    const int kvh = (VAR == 1) ? h : (h >> 1);
    const bf16_t* Qw = PJ + (rowbase + q0 + wid * 32) * PJP + QC + h * 64;
    const bf16_t* Kh = PJ + rowbase * PJP + KC + kvh * 64; const bf16_t* Vh = PJ + rowbase * PJP + VC + kvh * 64;
    const unsigned lds0 = (unsigned)(uintptr_t)shm;
    LAS float* wsf = (LAS float*)(shm + L_WS) + wid * 128;
    const bf16_t* ksrc = Kh + (long)lane * PJP + wid * 8;
    const bf16_t* vsrc = Vh + (long)(16 * (wid & 3) + (lane >> 2)) * PJP + (wid >> 2) * 32 + (lane & 3) * 8;
    const unsigned kdst = lds0 + L_K + wid * 1024, vdst = lds0 + L_V + wid * 1024;
#define ATT_DMA_K(t, so) glds16(ksrc + (long)(t) * 64 * PJP, (unsigned)__builtin_amdgcn_readfirstlane(kdst + (so)))
#define ATT_DMA_V(t, so) glds16(vsrc + (long)(t) * 64 * PJP, (unsigned)__builtin_amdgcn_readfirstlane(vdst + (so)))
    const int vb0 = (int)(lds0 + L_V) + ((lane >> 4) & 1) * 32 + (lane & 3) * 8 + (4 * hi + ((lane & 15) >> 2)) * 64;
    int t_lo = 0, t_hi = 31;
    if (VAR == 2) { t_lo = q0 / 64 - 2; if (t_lo < 0) t_lo = 0; t_hi = q0 / 64 + 5; if (t_hi > 31) t_hi = 31; }
    if (VAR == 1) { t_lo = (q0 - P.dcut) >> 6; if (t_lo < 0) t_lo = 0; t_hi = (q0 + 255 + P.dcut) >> 6; if (t_hi > 31) t_hi = 31; }
    bf16x8 qr[4];
#pragma unroll
    for (int d0 = 0; d0 < 4; ++d0) qr[d0] = *reinterpret_cast<const bf16x8*>(&Qw[(long)r32 * PJP + d0 * 16 + hi * 8]);
    ATT_DMA_K(t_lo, 0); ATT_DMA_V(t_lo, 0);
    if (t_lo < t_hi) { ATT_DMA_K(t_lo + 1, SLOTB); ATT_DMA_V(t_lo + 1, SLOTB); }
    float mh[NC]; f32x16 o[NC][2], ol[NC], negm[NC];
    float zf = 0.f; asm volatile("" : "+v"(zf));
#pragma unroll
    for (int c = 0; c < NC; ++c) { mh[c] = (VAR == 2) ? P.sink2 : 0.f;
#pragma unroll
        for (int r = 0; r < 16; ++r) { o[c][0][r] = zf; o[c][1][r] = zf; ol[c][r] = (VAR == 2) ? zf + 1.0f : zf; negm[c][r] = zf; } }
    const float K32 = (VAR != 0) ? P.slope2 * 32.f : 0.f;
    const int qpos = q0 + wid * 32 + r32, qw = q0 + wid * 32;
    bool started = false;
    int so = 0, so2 = 2 * SLOTB;
    for (int t = t_lo; t <= t_hi; ++t) {
        if (t < t_hi) asm volatile("s_waitcnt vmcnt(2) lgkmcnt(0)\n\ts_barrier" ::: "memory"); else asm volatile("s_waitcnt vmcnt(0) lgkmcnt(0)\n\ts_barrier" ::: "memory");
        if (t + 2 <= t_hi) { ATT_DMA_K(t + 2, so2); ATT_DMA_V(t + 2, so2); }
        bool rel = true;
        if (VAR == 2) rel = (64 * t + 63 >= qw - 128) && (64 * t <= qw + 31 + 128);
        if (VAR == 1) rel = (64 * t + 63 >= qw - P.dcut) && (64 * t <= qw + 31 + P.dcut);
        if (rel) {
            const bool first = (VAR != 2) && !started; started = true;
            f32x16 p0[NC], p1[NC];
#pragma unroll
            for (int c = 0; c < NC; ++c) {
                f32x16 ci0, ci1;
                if (VAR == 0) { ci0 = negm[c]; ci1 = negm[c]; }
                else {
                    const float qk = (float)(qpos - 64 * t - 4 * hi);
                    if (64 * t >= qw + 31) { const float A = __builtin_fmaf(P.slope2, qk, -mh[c]);
#pragma unroll
                        for (int r = 0; r < 16; ++r) { ci0[r] = __builtin_fmaf(-P.slope2, (float)((r & 3) + 8 * (r >> 2)), A); ci1[r] = ci0[r] - K32; } }
                    else if (64 * t + 63 <= qw) { const float A = __builtin_fmaf(-P.slope2, qk, -mh[c]);
#pragma unroll
                        for (int r = 0; r < 16; ++r) { ci0[r] = __builtin_fmaf(P.slope2, (float)((r & 3) + 8 * (r >> 2)), A); ci1[r] = ci0[r] + K32; } }
                    else {
#pragma unroll
                        for (int r = 0; r < 16; ++r) { const float cr = (float)((r & 3) + 8 * (r >> 2));
                            ci0[r] = __builtin_fmaf(-P.slope2, __builtin_fabsf(qk - cr), -mh[c]); ci1[r] = __builtin_fmaf(-P.slope2, __builtin_fabsf(qk - (cr + 32.f)), -mh[c]); } }
                }
                if (VAR == 1) { if (c == 0) qkt<0, 2>(p0[c], p1[c], shm + L_K + so, qr, ci0, ci1, r32, hi); else qkt<2, 2>(p0[c], p1[c], shm + L_K + so, qr, ci0, ci1, r32, hi); }
                else qkt<0, 4>(p0[c], p1[c], shm + L_K + so, qr, ci0, ci1, r32, hi);
            }
            u32x4 pw[NC][4];
#pragma unroll
            for (int c = 0; c < NC; ++c) {
                if (VAR == 2) {
                    const bool need_mask = (64 * t + 63 - qw > 128) || (qw + 31 - 64 * t > 128);
                    if (need_mask) { const float qk = (float)(qpos - 64 * t - 4 * hi);
#pragma unroll
                        for (int r = 0; r < 16; ++r) { const float cr = (float)((r & 3) + 8 * (r >> 2));
                            if (__builtin_fabsf(qk - cr) > 128.f) p0[c][r] = -INFINITY; if (__builtin_fabsf(qk - (cr + 32.f)) > 128.f) p1[c][r] = -INFINITY; } }
                }
                const float rm = rowmax(p0[c], p1[c]);
                if (first) {
                    mh[c] = rm;
#pragma unroll
                    for (int r = 0; r < 16; ++r) { p0[c][r] -= rm; p1[c][r] -= rm; if (VAR == 0) negm[c][r] = -rm; }
                } else if (__any(rm > THR)) {
                    const float dl = __builtin_fmaxf(rm, 0.f); mh[c] += dl;
#pragma unroll
                    for (int r = 0; r < 16; ++r) { p0[c][r] -= dl; p1[c][r] -= dl; if (VAR == 0) negm[c][r] = -mh[c]; }
                    const float f = __builtin_amdgcn_exp2f(-dl);
                    if (hi == 0) wsf[r32] = f;
                    asm volatile("s_waitcnt lgkmcnt(0)" ::: "memory");
#pragma unroll
                    for (int r = 0; r < 16; ++r) { const float fr_ = wsf[crow(r, hi)]; o[c][0][r] *= fr_; o[c][1][r] *= fr_; ol[c][r] *= fr_; }
                }
#pragma unroll
                for (int r = 0; r < 16; ++r) { p0[c][r] = __builtin_amdgcn_exp2f(p0[c][r]); p1[c][r] = __builtin_amdgcn_exp2f(p1[c][r]); }
                pw[c][0] = (u32x4){pkbf(p0[c][0], p0[c][1]), pkbf(p0[c][2], p0[c][3]), pkbf(p0[c][4], p0[c][5]), pkbf(p0[c][6], p0[c][7])};
                pw[c][1] = (u32x4){pkbf(p0[c][8], p0[c][9]), pkbf(p0[c][10], p0[c][11]), pkbf(p0[c][12], p0[c][13]), pkbf(p0[c][14], p0[c][15])};
                pw[c][2] = (u32x4){pkbf(p1[c][0], p1[c][1]), pkbf(p1[c][2], p1[c][3]), pkbf(p1[c][4], p1[c][5]), pkbf(p1[c][6], p1[c][7])};
                pw[c][3] = (u32x4){pkbf(p1[c][8], p1[c][9]), pkbf(p1[c][10], p1[c][11]), pkbf(p1[c][12], p1[c][13]), pkbf(p1[c][14], p1[c][15])};
            }
            pvn<NC>(o, ol, vb0 + so, pw);
        }
        so = (so == (NSLOT - 1) * SLOTB) ? 0 : so + SLOTB; so2 = (so2 == (NSLOT - 1) * SLOTB) ? 0 : so2 + SLOTB;
    }
    LAS float* stg = (LAS float*)(shm + L_OST + wid * OST_W);
#pragma unroll
    for (int r = 0; r < 16; ++r) { const int orow = crow(r, hi);
        const float rl0 = __builtin_amdgcn_rcpf(ol[0][r]);
        float rl1 = 0.f; if (VAR == 1) rl1 = P.lam * __builtin_amdgcn_rcpf(ol[NC - 1][r]);
#pragma unroll
        for (int d0 = 0; d0 < 2; ++d0) { float v = o[0][d0][r] * rl0; if (VAR == 1) v -= o[NC - 1][d0][r] * rl1; stg[orow * 68 + d0 * 32 + r32] = v; } }
    asm volatile("s_waitcnt lgkmcnt(0)" ::: "memory");
    {
        const int row = lane >> 1, half = lane & 1;
        f32x4 x[8];
#pragma unroll
        for (int k = 0; k < 8; ++k) x[k] = *(const LAS f32x4*)(stg + row * 68 + half * 32 + 4 * k);
        if (VAR == 1) {
            float ss = 0.f;
#pragma unroll
            for (int k = 0; k < 8; ++k) ss += (x[k][0] * x[k][0] + x[k][1] * x[k][1]) + (x[k][2] * x[k][2] + x[k][3] * x[k][3]);
            ss += xor_lane<1>(ss);
            const float rinv = P.oscale / sqrtf(ss * (1.f / 64.f) + RMS_EPS);
#pragma unroll
            for (int k = 0; k < 8; ++k) x[k] = x[k] * rinv * *(const f32x4*)(P.subln + half * 32 + 4 * k);
        }
        bf16_t* op = MIX + (rowbase + q0 + wid * 32 + row) * MXP + OC + h * 64 + half * 32;
#pragma unroll
        for (int k = 0; k < 4; ++k) { u32x4 w; w.x = pkbf(x[2 * k][0], x[2 * k][1]); w.y = pkbf(x[2 * k][2], x[2 * k][3]); w.z = pkbf(x[2 * k + 1][0], x[2 * k + 1][1]); w.w = pkbf(x[2 * k + 1][2], x[2 * k + 1][3]);
            *(u32x4*)(op + 8 * k) = w; }
    }
    asm volatile("s_waitcnt lgkmcnt(0)\n\ts_barrier" ::: "memory");
#undef ATT_DMA_K
#undef ATT_DMA_V
}
}

struct Frame {
    LAS unsigned char* lds; volatile LAS unsigned* MISC; gu32* ctl;
    int tid, lane, wave, vcu, G;
};
struct Args { const float* in[26]; float* out; unsigned char* ws; };
constexpr int PT_OFF = MISC_OFF + 1024;
__device__ __forceinline__ unsigned long long ldp_raw(LAS unsigned char* lds, int i) {
    unsigned z = 0u; asm volatile("" : "+v"(z));
    const unsigned a = z + (unsigned)(uintptr_t)lds + PT_OFF + 8u * (unsigned)i;
    const unsigned long long v = *(volatile LAS unsigned long long*)(uintptr_t)a;
    const unsigned lo = __builtin_amdgcn_readfirstlane((unsigned)v), hi = __builtin_amdgcn_readfirstlane((unsigned)(v >> 32));
    return ((unsigned long long)hi << 32) | lo; }
#define INP(i) ((const float*)ldp_raw(F.lds, (i)))
#define OUTP() ((float*)ldp_raw(F.lds, 26))
#define WSP() ((unsigned char*)ldp_raw(F.lds, 27))

__device__ __forceinline__ int winmap(int n) {
    const int tile = n >> 8, p = n & 255;
    if (tile != 1 && tile != 2) return n;
    const int hh = p >> 6, dim = p & 63, bj = dim >> 5, w = dim & 31;
    int fq, e;
    if (tile == 1 || hh < 2) { const int ehi = w >> 4, i = w & 15; fq = i >> 2; e = (i & 3) + 4 * ehi; }
    else { fq = w >> 3; e = w & 7; }
    return tile * 256 + 128 * bj + 32 * hh + 8 * fq + e;
}
template <int MAP> __device__ __forceinline__ int rowmap(int n) {
    if (MAP == 1) return winmap(n);
    if (MAP == 2) return (n >> 7) * 256 + (n & 127);
    if (MAP == 3) return (n >> 7) * 256 + 128 + (n & 127);
    return n;
}
__device__ __forceinline__ void tr_write(bf16_t* WT, int K, int k0, LAS float* scr, int lane, const int (&drow)[4]) {
    const int c = lane & 7;
#pragma unroll
    for (int j = 0; j < 4; ++j) { const int n = (lane >> 3) + 8 * j; const LAS float* s = scr + (8 * c) * 33 + n;
        u32x4 o; o.x = pkbf(s[0 * 33], s[1 * 33]); o.y = pkbf(s[2 * 33], s[3 * 33]); o.z = pkbf(s[4 * 33], s[5 * 33]); o.w = pkbf(s[6 * 33], s[7 * 33]);
        *(u32x4*)(WT + (size_t)drow[j] * K + k0 + 8 * c) = o; }
    asm volatile("s_waitcnt lgkmcnt(0)" ::: "memory");
}
template <int MAP>
__device__ __forceinline__ void tr_item(const float* W, int K, int N, int ncol0, bf16_t* WT, LAS float* scr, int item, int lane) {
    const int nblk = (N - ncol0) / 32, kb = item / nblk, nb = item % nblk, k0 = 64 * kb, n0 = ncol0 + 32 * nb;
    f32x4 v[8];
#pragma unroll
    for (int i = 0; i < 8; ++i) v[i] = __builtin_nontemporal_load((const f32x4*)(W + (size_t)(k0 + 8 * i + (lane >> 3)) * N + n0 + (lane & 7) * 4));
#pragma unroll
    for (int i = 0; i < 8; ++i) { LAS float* d = scr + (8 * i + (lane >> 3)) * 33 + (lane & 7) * 4; d[0] = v[i][0]; d[1] = v[i][1]; d[2] = v[i][2]; d[3] = v[i][3]; }
    asm volatile("s_waitcnt lgkmcnt(0)" ::: "memory");
    int drow[4];
#pragma unroll
    for (int j = 0; j < 4; ++j) drow[j] = rowmap<MAP>(n0 + (lane >> 3) + 8 * j);
    tr_write(WT, K, k0, scr, lane, drow);
}
template <int MAP>
__device__ __forceinline__ void tr_item8(const float* W, int K, int N, unsigned char* WT, float sc, LAS float* scr, int item, int lane) {
    const int nblk = N / 32, kb = item / nblk, nb = item % nblk, k0 = 64 * kb, n0 = 32 * nb;
    f32x4 v[8];
#pragma unroll
    for (int i = 0; i < 8; ++i) v[i] = __builtin_nontemporal_load((const f32x4*)(W + (size_t)(k0 + 8 * i + (lane >> 3)) * N + n0 + (lane & 7) * 4));
#pragma unroll
    for (int i = 0; i < 8; ++i) { LAS float* d = scr + (8 * i + (lane >> 3)) * 33 + (lane & 7) * 4; d[0] = v[i][0]; d[1] = v[i][1]; d[2] = v[i][2]; d[3] = v[i][3]; }
    asm volatile("s_waitcnt lgkmcnt(0)" ::: "memory");
    const int c = lane & 7;
#pragma unroll
    for (int j = 0; j < 4; ++j) { const int n = (lane >> 3) + 8 * j; const LAS float* s = scr + (8 * c) * 33 + n;
        u32x2 o; o.x = pk4_fp8(s[0 * 33] * sc, s[1 * 33] * sc, s[2 * 33] * sc, s[3 * 33] * sc); o.y = pk4_fp8(s[4 * 33] * sc, s[5 * 33] * sc, s[6 * 33] * sc, s[7 * 33] * sc);
        *(u32x2*)(WT + (size_t)rowmap<MAP>(n0 + n) * K + k0 + 8 * c) = o; }
    asm volatile("s_waitcnt lgkmcnt(0)" ::: "memory");
}
__device__ __forceinline__ void tr_item_pool_wg(const float* W, const float* wp, const float* scale, bf16_t* WT, LAS float* scr, int item, int tid) {
    const int kb = item / 8, nb = item % 8, k0 = 64 * kb, n0 = 32 * nb, g = n0 >> 6, kk = tid >> 3, nq = (tid & 7) * 4;
    const float* wrow = W + (size_t)(k0 + kk) * D_IN + 64 * g; const float* wpc = wp + (size_t)g * 4096 + (n0 & 63) + nq;
    f32x4 acc = {0.f, 0.f, 0.f, 0.f};
#pragma unroll 8
    for (int c = 0; c < 64; ++c) acc += *(const f32x4*)(wpc + c * 64) * wrow[c];
    acc = acc * *(const f32x4*)(scale + n0 + nq);
    LAS float* d = scr + kk * 33 + nq; d[0] = acc[0]; d[1] = acc[1]; d[2] = acc[2]; d[3] = acc[3];
    __syncthreads();
    if (tid < 64) { int drow[4];
#pragma unroll
        for (int j = 0; j < 4; ++j) drow[j] = n0 + (tid >> 3) + 8 * j;
        tr_write(WT, DM, k0, scr, tid, drow); }
    __syncthreads();
}
__device__ __forceinline__ void ln_core(f32x4 (&v)[4], const f32x4 (&g4)[4], const f32x4 (&b4)[4]) {
    float s = 0.f;
#pragma unroll
    for (int j = 0; j < 4; ++j) s += (v[j][0] + v[j][1]) + (v[j][2] + v[j][3]);
    const float mean = wave_sum(s) * (1.f / DM); float s2 = 0.f;
#pragma unroll
    for (int j = 0; j < 4; ++j) { v[j] = v[j] - mean; s2 += (v[j][0] * v[j][0] + v[j][1] * v[j][1]) + (v[j][2] * v[j][2] + v[j][3] * v[j][3]); }
    const float rstd = 1.f / sqrtf(wave_sum(s2) * (1.f / DM) + LN_EPS);
#pragma unroll
    for (int j = 0; j < 4; ++j) v[j] = v[j] * rstd * g4[j] + b4[j];
}
__device__ __forceinline__ void ln_store(const f32x4 (&v)[4], float* xo, bf16_t* xn, int lane) {
#pragma unroll
    for (int j = 0; j < 4; ++j) {
        if (xo) *((f32x4*)xo + lane + 64 * j) = v[j];
        if (xn) { u32x2 w; w.x = pkbf(v[j][0], v[j][1]); w.y = pkbf(v[j][2], v[j][3]); *((u32x2*)xn + lane + 64 * j) = w; } }
}

__global__ void __launch_bounds__(NWAVES * 64, 2) mega_fwd(Args args) {
    extern __shared__ __attribute__((aligned(16))) unsigned char lds_raw[];
    Frame F;
    F.lds = (LAS unsigned char*)lds_raw;
    F.MISC = (volatile LAS unsigned*)(F.lds + MISC_OFF);
    const int wave0 = __builtin_amdgcn_readfirstlane((int)threadIdx.x >> 6);
    F.ctl = (gu32*)(args.ws + WS_CTL);
    { const int t = wave0 * 64 + lane_id();
      for (int u = t; u < 256; u += NWAVES * 64) F.MISC[u] = 0u;
      if (t == 0) { volatile LAS unsigned long long* PT = (volatile LAS unsigned long long*)(F.lds + PT_OFF);
#pragma unroll
        for (int i = 0; i < 26; ++i) PT[i] = (unsigned long long)args.in[i];
        PT[26] = (unsigned long long)args.out; PT[27] = (unsigned long long)args.ws; } }
    __syncthreads();
    XcdBarrier bar = xcd_barrier_post((unsigned*)(F.ctl + CW_BAR), F.MISC + 8, wave0 == 0 && lane_id() == 0);
#define GRID_BAR() xcd_barrier(bar, wave0 == 0 && lane_id() == 0)
#define PHASE_LOCALS() int tid_ = wave0 * 64 + lane_id(); asm volatile("" : "+v"(tid_)); int bid_ = blockIdx.x, G_ = gridDim.x; asm volatile("" : "+s"(bid_), "+s"(G_)); \
    const int lane = tid_ & 63, wave = __builtin_amdgcn_readfirstlane(tid_ >> 6), vcu = (G_ % 8 == 0) ? (bid_ % 8) * (G_ / 8) + bid_ / 8 : bid_, gw = vcu * NWAVES + wave, NGW = G_ * NWAVES; \
    (void)lane; (void)gw; (void)NGW; (void)vcu; (void)wave

        asm volatile("; MARK_P0" ::: "memory");
    for (int dup = 0; dup < DUP_P0; ++dup) {
        PHASE_LOCALS();
        LAS float* scr = (LAS float*)(F.lds + wave * 16384);
        unsigned char* ws = WSP();
        const float* x_in = INP(0); const float* ln_in_g = INP(1); const float* ln_in_b = INP(2); const float* w_in = INP(3); const float* w_pool = INP(4); const float* pool_scale = INP(5);
        const float* w_out = INP(14); const float* w_gate = INP(17); const float* w_up = INP(18); const float* w_down = INP(19); const float* e_gate = INP(21); const float* e_up = INP(22); const float* e_down = INP(23);
        float* X = OUTP(); float* ropec = (float*)(ws + WS_ROPEC); float* ropes = (float*)(ws + WS_ROPES);
        bf16_t* Win_t = (bf16_t*)(ws + WS_WIN); bf16_t* Wout_t = (bf16_t*)(ws + WS_WOUT); bf16_t* Wgu_t = (bf16_t*)(ws + WS_WGU); bf16_t* Wd_t = (bf16_t*)(ws + WS_WD);
        unsigned char* Egu8 = ws + WS_EGU; unsigned char* Ed8 = ws + WS_ED; bf16_t* XN = (bf16_t*)(ws + WS_XN);
        constexpr int I_WIN = 16 * 56, I_POOL = 16 * 8, I_WOUT = 16 * 32, I_G = 16 * 88, I_D = 44 * 32, I_EG = 16 * 112, I_ED = 56 * 32;
        constexpr int N0 = 2 * I_WIN, N1 = N0 + 2 * I_WOUT, N2 = N1 + 2 * I_G, N3 = N2 + I_D, N4 = N3 + 16 * I_EG, N5 = N4 + 8 * I_ED;
        for (int pi = vcu; pi < 2 * I_POOL; pi += G_) { const int l = pi / I_POOL;
            tr_item_pool_wg(w_in + (size_t)l * DM * D_IN, w_pool + (size_t)l * 4 * 4096, pool_scale + l * 256, Win_t + (size_t)l * D_IN * DM, (LAS float*)F.lds, pi - l * I_POOL, tid_); }
        for (int it = gw; it < N5; it += NGW) {
            int r = it;
            if (r < N0) { const int l = r / I_WIN; r -= l * I_WIN; tr_item<1>(w_in + (size_t)l * DM * D_IN, DM, D_IN, 256, Win_t + (size_t)l * D_IN * DM, scr, r, lane); continue; }
            if (r < N1) { r -= N0; const int l = r / I_WOUT; r -= l * I_WOUT; tr_item<0>(w_out + (size_t)l * DM * DM, DM, DM, 0, Wout_t + (size_t)l * DM * DM, scr, r, lane); continue; }
            if (r < N2) { r -= N1; const int which = r / I_G; r -= which * I_G;
#if DENSE_FP8
                if (which == 0) tr_item8<2>(w_gate, DM, D_FF, (unsigned char*)Wgu_t, EGU_SCALE, scr, r, lane); else tr_item8<3>(w_up, DM, D_FF, (unsigned char*)Wgu_t, EGU_SCALE, scr, r, lane);
                continue; }
            if (r < N3) { r -= N2; tr_item8<0>(w_down, D_FF, DM, (unsigned char*)Wd_t, ED_SCALE, scr, r, lane); continue; }
#else
                if (which == 0) tr_item<2>(w_gate, DM, D_FF, 0, Wgu_t, scr, r, lane); else tr_item<3>(w_up, DM, D_FF, 0, Wgu_t, scr, r, lane);
                continue; }
            if (r < N3) { r -= N2; tr_item<0>(w_down, D_FF, DM, 0, Wd_t, scr, r, lane); continue; }
#endif
            if (r < N4) { r -= N3; const int idx = r / I_EG; r -= idx * I_EG; const int e = idx >> 1;
                if ((idx & 1) == 0) tr_item8<2>(e_gate + (size_t)e * DM * D_FFE, DM, D_FFE, Egu8 + (size_t)e * 2 * D_FFE * DM, EGU_SCALE, scr, r, lane);
                else tr_item8<3>(e_up + (size_t)e * DM * D_FFE, DM, D_FFE, Egu8 + (size_t)e * 2 * D_FFE * DM, EGU_SCALE, scr, r, lane);
                continue; }
            { r -= N4; const int e = r / I_ED; r -= e * I_ED; tr_item8<0>(e_down + (size_t)e * D_FFE * DM, D_FFE, DM, Ed8 + (size_t)e * DM * D_FFE, ED_SCALE, scr, r, lane); }
        }
        for (int idx = bid_ * 512 + tid_; idx < SEQ * 32; idx += G_ * 512) { const int s = idx >> 5, ax = (idx >> 4) & 1, i = idx & 15;
            const float pos = ax == 0 ? (float)(s / 64) : (float)(s % 64); const float inv_freq = powf(10000.0f, -(float)(2 * i) / 32.0f); const float ang = pos * inv_freq;
            ropec[idx] = cosf(ang); ropes[idx] = sinf(ang); }
        f32x4 g4[4], b4[4];
#pragma unroll
        for (int j = 0; j < 4; ++j) { g4[j] = *((const f32x4*)ln_in_g + lane + 64 * j); b4[j] = *((const f32x4*)ln_in_b + lane + 64 * j); }
        for (int m = gw; m < M; m += NGW) { f32x4 v[4];
#pragma unroll
            for (int j = 0; j < 4; ++j) v[j] = *((const f32x4*)(x_in + (size_t)m * DM) + lane + 64 * j);
            ln_core(v, g4, b4); ln_store(v, nullptr, XN + (size_t)m * DM, lane); }
    }
    GRID_BAR();

#pragma clang loop unroll(full)
    for (int l = 0; l < DEPTH; ++l) {
        asm volatile("; MARK_P1" ::: "memory");
        for (int dup = 0; dup < DUP_P1; ++dup) {
            PHASE_LOCALS();
            unsigned char* ws = WSP(); const float* qn_w = INP(6); const float* kn_w = INP(7);
            bf16_t* XN = (bf16_t*)(ws + WS_XN); bf16_t* Win_t = (bf16_t*)(ws + WS_WIN); bf16_t* PJ = (bf16_t*)(ws + WS_PJ); const float* ropec = (const float*)(ws + WS_ROPEC); const float* ropes = (const float*)(ws + WS_ROPES);
            pg8::Gemm g{XN, Win_t + (size_t)l * D_IN * DM, DM, 0};
            pg8::StaticOrder S; S.init(M, D_IN, G_, bid_);
            pg8::EpiProj E{PJ, qn_w + l * 64, kn_w + l * 64, ropec, ropes, (unsigned*)(ws + WS_CTL) + CW_NRM + l * 256};
            pg8::gemm_phase<pg8::EpiProj, pg8::StaticOrder, true>(F.lds, g, S, E, wave0);
        }
        GRID_BAR();
        asm volatile("; MARK_P2" ::: "memory");
        for (int dup = 0; dup < DUP_P2; ++dup) {
            PHASE_LOCALS();
            unsigned char* ws = WSP(); const float* lam_q1 = INP(8); const float* lam_k1 = INP(9); const float* lam_q2 = INP(10); const float* lam_k2 = INP(11); const float* subln_w = INP(12); const float* sink = INP(13);
            bf16_t* PJ = (bf16_t*)(ws + WS_PJ); bf16_t* MIX = (bf16_t*)(ws + WS_MIX);
            const float lam_init = 0.8f - 0.6f * expf(-0.3f * (float)l);
            float a = lane < 32 ? lam_q1[l * 32 + lane] * lam_k1[l * 32 + lane] : 0.f, c = lane < 32 ? lam_q2[l * 32 + lane] * lam_k2[l * 32 + lane] : 0.f;
            const float lam = __int_as_float(__builtin_amdgcn_readfirstlane(__float_as_int(expf(wave_sum(a)) - expf(wave_sum(c)) + lam_init)));
            unsigned* qhead = (unsigned*)(ws + WS_CTL) + CW_Q + 64 * l; const unsigned* nrm = (const unsigned*)(ws + WS_CTL) + CW_NRM + l * 256;
            for (;;) {
                unsigned zq = 0u; asm volatile("" : "+v"(zq));
                volatile LAS unsigned* qslot = (volatile LAS unsigned*)(uintptr_t)(zq + (unsigned)(uintptr_t)F.lds + MISC_OFF + 128u);
                if (wave0 == 0 && lane_id() == 0) *qslot = __hip_atomic_fetch_add(qhead, 1u, __ATOMIC_RELAXED, __HIP_MEMORY_SCOPE_AGENT);
                __syncthreads();
                const int idx = __builtin_amdgcn_readfirstlane((int)*qslot);
                __syncthreads();
                if (idx >= 1792) break;
                if (idx < 256 || (idx >= 768 && idx < 1024)) {
                    const int h = idx < 128 ? 3 : (idx < 256 ? 2 : (idx < 896 ? 1 : 0)), k = idx & 127, b = k >> 3, qb = k & 7;
                    const float slope2 = exp2f(-(float)(2 * h + 1)) * LOG2E;
                    const float q0n = __uint_as_float(nrm[(0 * 16 + b) * 8 + h * 2]), q1n = __uint_as_float(nrm[(0 * 16 + b) * 8 + h * 2 + 1]), k0n = __uint_as_float(nrm[(1 * 16 + b) * 8 + h * 2]), k1n = __uint_as_float(nrm[(1 * 16 + b) * 8 + h * 2 + 1]);
                    const float bound = sqrtf(__builtin_fmaxf(q0n * k0n, q1n * k1n));
                    float dc = (2.1f * bound + 40.0f) / slope2; if (dc > 4096.f) dc = 4096.f;
                    att::Par P{slope2, 0.f, lam, 1.0f - lam_init, subln_w + l * 64, (int)dc + 1};
                    for (int d_ = 0; d_ < DUP_C; ++d_) att::unit<1>(b, h, qb, PJ, MIX, F.lds, P, wave0);
                } else if (idx < 768) {
                    const int k = idx - 256, qb = k & 7, h = (k >> 3) & 3, b = k >> 5;
                    att::Par P{0.f, 0.f, 0.f, 0.f, nullptr, 0};
                    for (int d_ = 0; d_ < DUP_B; ++d_) att::unit<0>(b, h, qb, PJ, MIX, F.lds, P, wave0);
                } else if (idx < 1536) {
                    const int k = idx - 1024, qb = k & 7, h = (k >> 3) & 3, b = k >> 5;
                    att::Par P{exp2f(-(float)(2 * h + 2)) * LOG2E, sink[l * 4 + h] * LOG2E, 0.f, 0.f, nullptr, 0};
                    for (int d_ = 0; d_ < DUP_D; ++d_) att::unit<2>(b, h, qb, PJ, MIX, F.lds, P, wave0);
                } else {
                    const int ch = idx - 1536;
                    for (int it = wave0 * 64 + lane_id(); it < 128 * 32; it += NWAVES * 64) { const int t = ch * 128 + (it >> 5), cg = it & 31, c0 = cg * 8, s = t & (SEQ - 1), base = t - s;
                        const int w = 2 << (c0 >> 6); int lo = s - w / 2, hi = lo + w; if (lo < 0) lo = 0; if (hi > SEQ) hi = SEQ;
                        float acc[8];
#pragma unroll
                        for (int j = 0; j < 8; ++j) acc[j] = 0.f;
                        for (int j = lo; j < hi; ++j) { const u32x4 zz = *(const u32x4*)(PJ + (size_t)(base + j) * D_IN + c0);
                            acc[0] += bf_lo(zz.x); acc[1] += bf_hi(zz.x); acc[2] += bf_lo(zz.y); acc[3] += bf_hi(zz.y); acc[4] += bf_lo(zz.z); acc[5] += bf_hi(zz.z); acc[6] += bf_lo(zz.w); acc[7] += bf_hi(zz.w); }
                        const float inv = 1.0f / (float)(hi - lo); const u32x4 zs = *(const u32x4*)(PJ + (size_t)t * D_IN + c0);
                        u32x4 o; o.x = pkbf(acc[0] * inv - bf_lo(zs.x), acc[1] * inv - bf_hi(zs.x)); o.y = pkbf(acc[2] * inv - bf_lo(zs.y), acc[3] * inv - bf_hi(zs.y));
                        o.z = pkbf(acc[4] * inv - bf_lo(zs.z), acc[5] * inv - bf_hi(zs.z)); o.w = pkbf(acc[6] * inv - bf_lo(zs.w), acc[7] * inv - bf_hi(zs.w));
                        *(u32x4*)(MIX + (size_t)t * DM + c0) = o; }
                }
            }
        }
        GRID_BAR();
        asm volatile("; MARK_P3" ::: "memory");
        {
            PHASE_LOCALS();
            unsigned char* ws = WSP(); bf16_t* MIX = (bf16_t*)(ws + WS_MIX); bf16_t* Wout_t = (bf16_t*)(ws + WS_WOUT); bf16_t* MO = (bf16_t*)(ws + WS_PJ);
            pg8::Gemm g{MIX, Wout_t + (size_t)l * DM * DM, DM, 0};
            pg8::StaticOrder S; S.init(M, DM, G_, bid_);
            pg8::EpiBf16 E{MO, DM, 1.0f};
            pg8::gemm_phase<pg8::EpiBf16, pg8::StaticOrder, true>(F.lds, g, S, E, wave0);
        }
        GRID_BAR();
        asm volatile("; MARK_LN1" ::: "memory");
        {
            PHASE_LOCALS();
            unsigned char* ws = WSP(); float* X = OUTP(); const float* ln1_g = INP(15); const float* ln1_b = INP(16); const float* w_router = INP(20);
            bf16_t* XN = (bf16_t*)(ws + WS_XN); int* ltok = (int*)(ws + WS_LTOK); int* tpos = (int*)(ws + WS_TPOS); float* tgate = (float*)(ws + WS_TGATE); const bf16_t* MO = (const bf16_t*)(ws + WS_PJ);
            f32x4 g4[4], b4[4];
#pragma unroll
            for (int j = 0; j < 4; ++j) { g4[j] = *((const f32x4*)(ln1_g + l * DM) + lane + 64 * j); b4[j] = *((const f32x4*)(ln1_b + l * DM) + lane + 64 * j); }
            int me1 = -1, me2 = -1; float mg1 = 0.f, mg2 = 0.f;
            const int rows_per_wave = M / NGW;
            for (int ri = 0; ri < rows_per_wave; ++ri) { const int m = gw * rows_per_wave + ri; f32x4 v[4];
#pragma unroll
                for (int j = 0; j < 4; ++j) { const u32x2 xv = *((const u32x2*)(XN + (size_t)m * DM) + lane + 64 * j); const u32x2 mo = *((const u32x2*)(MO + (size_t)m * DM) + lane + 64 * j);
                    v[j][0] = ALPHA * bf_lo(xv.x) + bf_lo(mo.x); v[j][1] = ALPHA * bf_hi(xv.x) + bf_hi(mo.x); v[j][2] = ALPHA * bf_lo(xv.y) + bf_lo(mo.y); v[j][3] = ALPHA * bf_hi(xv.y) + bf_hi(mo.y); }
                ln_core(v, g4, b4);
                if (l == 0 && !DENSE_FP8) ln_store(v, nullptr, XN + (size_t)m * DM, lane);
                else { ln_store(v, nullptr, (bf16_t*)(X + (size_t)m * DM) + DM, lane);
#pragma unroll
                    for (int j = 0; j < 4; ++j) *((unsigned*)(ws + (DENSE_FP8 && l == 0 ? WS_XN : WS_XN8) + (size_t)m * DM) + lane + 64 * j) = pk4_fp8(v[j][0], v[j][1], v[j][2], v[j][3]); }
                if (l == 1) {
                    float lg[8];
#pragma unroll
                    for (int e = 0; e < 8; ++e) lg[e] = 0.f;
#pragma unroll
                    for (int j = 0; j < 4; ++j)
#pragma unroll
                        for (int q = 0; q < 4; ++q) { const int c = 4 * lane + 256 * j + q; const f32x4 wa = *(const f32x4*)(w_router + c * 8), wb = *(const f32x4*)(w_router + c * 8 + 4); const float xv = v[j][q];
                            lg[0] += xv * wa[0]; lg[1] += xv * wa[1]; lg[2] += xv * wa[2]; lg[3] += xv * wa[3]; lg[4] += xv * wb[0]; lg[5] += xv * wb[1]; lg[6] += xv * wb[2]; lg[7] += xv * wb[3]; }
#pragma unroll
                    for (int e = 0; e < 8; ++e) lg[e] = wave_sum(lg[e]);
                    int i1 = 0; float v1 = lg[0];
#pragma unroll
                    for (int e = 1; e < 8; ++e) if (lg[e] > v1) { v1 = lg[e]; i1 = e; }
                    int i2 = 0; float v2 = -INFINITY;
#pragma unroll
                    for (int e = 0; e < 8; ++e) if (e != i1 && lg[e] > v2) { v2 = lg[e]; i2 = e; }
                    const float ex = expf(v2 - v1), ga = 1.f / (1.f + ex), gb = ex / (1.f + ex);
                    if (lane == ri) { me1 = i1; me2 = i2; mg1 = ga; mg2 = gb; }
                }
            }
            if (l == 1) {
                const int myrow = gw * rows_per_wave + lane;
#pragma unroll
                for (int e = 0; e < 8; ++e) {
                    const bool has = (lane < rows_per_wave) && (me1 == e || me2 == e);
                    const unsigned long long mask = __ballot(has);
                    const int n = __popcll(mask);
                    if (n) {
                        int base = 0;
                        if (lane == 0) base = (int)__hip_atomic_fetch_add((unsigned*)(ws + WS_CTL) + CW_CNT + 64 * e, (unsigned)n, __ATOMIC_RELAXED, __HIP_MEMORY_SCOPE_AGENT);
                        base = __builtin_amdgcn_readfirstlane(base);
                        if (has) { const int p = base + (int)__builtin_amdgcn_mbcnt_hi((unsigned)(mask >> 32), __builtin_amdgcn_mbcnt_lo((unsigned)mask, 0u)); const int k = (me1 == e) ? 0 : 1;
                            ltok[e * M + p] = myrow; tpos[myrow * 2 + k] = (e << 20) | p; tgate[myrow * 2 + k] = k == 0 ? mg1 : mg2; }
                    }
                }
            }
        }
        GRID_BAR();
        if (l == 0) {
        asm volatile("; MARK_DENSE" ::: "memory");
            for (int dup = 0; dup < DUP_GU; ++dup) {
                PHASE_LOCALS();
                unsigned char* ws = WSP(); bf16_t* XN = (bf16_t*)(ws + WS_XN); bf16_t* Wgu_t = (bf16_t*)(ws + WS_WGU); bf16_t* Hd = (bf16_t*)(ws + WS_H);
                pg8::Gemm g{XN, Wgu_t, DM, 0};
                pg8::StaticOrder S; S.init(M, 2 * D_FF, G_, bid_);
#if DENSE_FP8
                pg8::EpiSwiGLU<true> E{Hd, D_FF, 0};
                pg8::gemm_phase<pg8::EpiSwiGLU<true>, pg8::StaticOrder, true, false, 1>(F.lds, g, S, E, wave0);
#else
                pg8::EpiSwiGLU<false> E{Hd, D_FF, 0};
                pg8::gemm_phase<pg8::EpiSwiGLU<false>, pg8::StaticOrder, true>(F.lds, g, S, E, wave0);
#endif
            }
            GRID_BAR();
            {
                PHASE_LOCALS();
                unsigned char* ws = WSP(); bf16_t* Wd_t = (bf16_t*)(ws + WS_WD); bf16_t* Hd = (bf16_t*)(ws + WS_H); bf16_t* MO = (bf16_t*)(ws + WS_FO);
                pg8::Gemm g{Hd, Wd_t, D_FF, 0};
                pg8::StaticOrder S; S.init(M, DM, G_, bid_);
#if DENSE_FP8
                pg8::EpiBf16 E{MO, DM, 1.0f / ED_SCALE};
                pg8::gemm_phase<pg8::EpiBf16, pg8::StaticOrder, true, false, 1>(F.lds, g, S, E, wave0);
#else
                pg8::EpiBf16 E{MO, DM, 1.0f};
                pg8::gemm_phase<pg8::EpiBf16, pg8::StaticOrder, true>(F.lds, g, S, E, wave0);
#endif
            }
            GRID_BAR();
        asm volatile("; MARK_LN2" ::: "memory");
            {
                PHASE_LOCALS();
                unsigned char* ws = WSP(); const float* ln2_g = INP(24); const float* ln2_b = INP(25); bf16_t* XN = (bf16_t*)(ws + WS_XN); const bf16_t* MO = (const bf16_t*)(ws + WS_FO);
                f32x4 g4[4], b4[4];
#pragma unroll
                for (int j = 0; j < 4; ++j) { g4[j] = *((const f32x4*)(ln2_g + l * DM) + lane + 64 * j); b4[j] = *((const f32x4*)(ln2_b + l * DM) + lane + 64 * j); }
                for (int m = gw; m < M; m += NGW) { f32x4 v[4];
#pragma unroll
                    for (int j = 0; j < 4; ++j) { const u32x2 xv = *((const u32x2*)(XN + (size_t)m * DM) + lane + 64 * j); const u32x2 mo = *((const u32x2*)(MO + (size_t)m * DM) + lane + 64 * j);
                        v[j][0] = ALPHA * bf_lo(xv.x) + bf_lo(mo.x); v[j][1] = ALPHA * bf_hi(xv.x) + bf_hi(mo.x); v[j][2] = ALPHA * bf_lo(xv.y) + bf_lo(mo.y); v[j][3] = ALPHA * bf_hi(xv.y) + bf_hi(mo.y); }
                    ln_core(v, g4, b4); ln_store(v, nullptr, XN + (size_t)m * DM, lane); }
            }
            GRID_BAR();
        } else {
        asm volatile("; MARK_MOE" ::: "memory");
            volatile LAS int* T = (volatile LAS int*)(F.MISC + 64);
            if (wave0 == 0 && lane_id() == 0) { int acc = 0; unsigned* ctlw = (unsigned*)(WSP() + WS_CTL);
                for (int e = 0; e < 8; ++e) { const int c = (int)__hip_atomic_load(ctlw + CW_CNT + 64 * e, __ATOMIC_RELAXED, __HIP_MEMORY_SCOPE_AGENT); T[e] = acc; T[16 + e] = c; acc += (c + 255) >> 8; }
                T[8] = acc; }
            __syncthreads();
            MoeTable tab{T};
            const int total_tiles = __builtin_amdgcn_readfirstlane(T[8]);
            for (int dup = 0; dup < DUP_MOE; ++dup)
            for (int rt_lo = 0; rt_lo < total_tiles; rt_lo += CHUNK_TILES) {
                const int nrt = (total_tiles - rt_lo) < CHUNK_TILES ? (total_tiles - rt_lo) : CHUNK_TILES;
                {
                    PHASE_LOCALS();
                    unsigned char* ws = WSP(); unsigned char* XN8 = ws + WS_XN8; unsigned char* Egu8 = ws + WS_EGU; unsigned char* HC = ws + WS_HC; const int* ltok = (const int*)(ws + WS_LTOK);
                    pg8::Gemm g{XN8, Egu8, DM, (size_t)2 * D_FFE * DM};
                    MoeOrder S{tab, rt_lo, nrt, 2 * D_FFE / 256, G_, bid_, ltok, true};
                    pg8::EpiSwiGLU<true> E{HC, D_FFE, rt_lo};
                    pg8::gemm_phase<pg8::EpiSwiGLU<true>, MoeOrder, true, true, 1>(F.lds, g, S, E, wave0);
                }
                GRID_BAR();
                {
                    PHASE_LOCALS();
                    unsigned char* ws = WSP(); unsigned char* Ed8 = ws + WS_ED; unsigned char* HC = ws + WS_HC; bf16_t* Y = (bf16_t*)(ws + WS_Y); const int* ltok = (const int*)(ws + WS_LTOK);
                    pg8::Gemm g{HC, Ed8, D_FFE, (size_t)DM * D_FFE};
                    MoeOrder S{tab, rt_lo, nrt, DM / 256, G_, bid_, ltok, false};
                    pg8::EpiBf16 E{Y, DM, 1.0f / ED_SCALE};
                    pg8::gemm_phase<pg8::EpiBf16, MoeOrder, true, false, 1>(F.lds, g, S, E, wave0);
                }
                GRID_BAR();
            }
        asm volatile("; MARK_COMB" ::: "memory");
            {
                PHASE_LOCALS();
                unsigned char* ws = WSP(); float* X = OUTP(); const float* ln2_g = INP(24); const float* ln2_b = INP(25);
                const bf16_t* Y = (const bf16_t*)(ws + WS_Y); const int* tpos = (const int*)(ws + WS_TPOS); const float* tgate = (const float*)(ws + WS_TGATE);
                f32x4 g4[4], b4[4];
#pragma unroll
                for (int j = 0; j < 4; ++j) { g4[j] = *((const f32x4*)(ln2_g + l * DM) + lane + 64 * j); b4[j] = *((const f32x4*)(ln2_b + l * DM) + lane + 64 * j); }
                for (int m = gw; m < M; m += NGW) {
                    const int pa = tpos[m * 2], pb = tpos[m * 2 + 1]; const float ga = tgate[m * 2], gb = tgate[m * 2 + 1];
                    const size_t ra = (size_t)T[pa >> 20] * 256 + (pa & 0xfffff), rb = (size_t)T[pb >> 20] * 256 + (pb & 0xfffff);
                    f32x4 v[4];
#pragma unroll
                    for (int j = 0; j < 4; ++j) { const u32x2 ya = *((const u32x2*)(Y + ra * DM) + lane + 64 * j), yb = *((const u32x2*)(Y + rb * DM) + lane + 64 * j);
                        const u32x2 xv = *((const u32x2*)((const bf16_t*)(X + (size_t)m * DM) + DM) + lane + 64 * j);
                        v[j][0] = ALPHA * bf_lo(xv.x) + ga * bf_lo(ya.x) + gb * bf_lo(yb.x); v[j][1] = ALPHA * bf_hi(xv.x) + ga * bf_hi(ya.x) + gb * bf_hi(yb.x);
                        v[j][2] = ALPHA * bf_lo(xv.y) + ga * bf_lo(ya.y) + gb * bf_lo(yb.y); v[j][3] = ALPHA * bf_hi(xv.y) + ga * bf_hi(ya.y) + gb * bf_hi(yb.y); }
                    ln_core(v, g4, b4); ln_store(v, X + (size_t)m * DM, nullptr, lane); }
            }
        }
    }
}

extern "C" void kernel_launch(void* const* d_in, const int* in_sizes, int n_in, void* d_out, int out_size, void* d_ws, size_t ws_size, hipStream_t stream) {
    static int grid = 0;
    if (grid == 0) {
        if (n_in != 26 || in_sizes[0] != M * DM || out_size != M * DM || ws_size < WS_END) { fprintf(stderr, "kernel_launch: unexpected shapes (n_in %d, ws %zu < %zu)\n", n_in, ws_size, (size_t)WS_END); grid = -1; return; }
        int dev = 0, cus = 0, per_cu = 0;
        if (hipGetDevice(&dev) != hipSuccess || hipDeviceGetAttribute(&cus, hipDeviceAttributeMultiprocessorCount, dev) != hipSuccess) { grid = -1; return; }
        if (hipFuncSetAttribute((const void*)mega_fwd, hipFuncAttributeMaxDynamicSharedMemorySize, LDS_BYTES) != hipSuccess) { fprintf(stderr, "kernel_launch: hipFuncSetAttribute failed\n"); grid = -1; return; }
        if (hipOccupancyMaxActiveBlocksPerMultiprocessor(&per_cu, (const void*)mega_fwd, NWAVES * 64, LDS_BYTES) != hipSuccess || per_cu < 1) { fprintf(stderr, "kernel_launch: occupancy query says %d\n", per_cu); }
        (void)hipGetLastError();
        grid = cus;
    }
    if (grid < 0) return;
    if (hipMemsetAsync((char*)d_ws + WS_CTL, 0, CTL_ZERO_BYTES, stream) != hipSuccess) return;
    Args a{};
    for (int i = 0; i < 26; ++i) a.in[i] = (const float*)d_in[i];
    a.out = (float*)d_out; a.ws = (unsigned char*)d_ws;
    hipLaunchKernelGGL(mega_fwd, dim3(grid), dim3(NWAVES * 64), LDS_BYTES, stream, a);
}
```

```cpp
#include <hip/hip_runtime.h>
#include <cstdio>
#include <cstdint>
#include <cmath>

constexpr int BATCH = 16, SEQ = 2048, DM = 1024, M = BATCH * SEQ, DEPTH = 2;
constexpr int D_IN = 2048, D_FF = 2816, N_EXP = 8, D_FFE = 3584;
constexpr float LN_EPS = 1e-5f, RMS_EPS = 1e-6f;
constexpr float ALPHA = 1.41421356237309515f;
constexpr float LOG2E = 1.4426950408889634f;
constexpr float EGU_SCALE = 64.f, ED_SCALE = 128.f;
constexpr int NWAVES = 8;
#ifndef DENSE_FP8
#define DENSE_FP8 0
#endif
#ifndef DUP_P0
#define DUP_P0 1
#endif
#ifndef DUP_P1
#define DUP_P1 1
#endif
#ifndef DUP_P2
#define DUP_P2 1
#endif
#ifndef DUP_B
#define DUP_B 1
#endif
#ifndef DUP_C
#define DUP_C 1
#endif
#ifndef DUP_D
#define DUP_D 1
#endif
#ifndef DUP_GU
#define DUP_GU 1
#endif
#ifndef DUP_MOE
#define DUP_MOE 1
#endif

#define GAS __attribute__((address_space(1)))
#define LAS __attribute__((address_space(3)))
typedef unsigned short bf16_t;
typedef short bf16x8 __attribute__((ext_vector_type(8)));
typedef float f32x4 __attribute__((ext_vector_type(4)));
typedef float f32x2 __attribute__((ext_vector_type(2)));
typedef float f32x16 __attribute__((ext_vector_type(16)));
typedef unsigned u32x4 __attribute__((ext_vector_type(4)));
typedef unsigned u32x2 __attribute__((ext_vector_type(2)));
typedef short s16x4 __attribute__((ext_vector_type(4)));
typedef __bf16 bf16x2_t __attribute__((ext_vector_type(2)));
typedef GAS unsigned gu32;

__device__ __forceinline__ unsigned pkbf(float lo, float hi) { f32x2 v = {lo, hi}; bf16x2_t b = __builtin_convertvector(v, bf16x2_t); return __builtin_bit_cast(unsigned, b); }
typedef int i32x4 __attribute__((ext_vector_type(4)));
typedef int i32x8 __attribute__((ext_vector_type(8)));
__device__ __forceinline__ float clamp8(float v) { return __builtin_fminf(__builtin_fmaxf(v, -448.f), 448.f); }
__device__ __forceinline__ unsigned pk4_fp8(float a, float b, float c, float d) { int w = __builtin_amdgcn_cvt_pk_fp8_f32(clamp8(a), clamp8(b), 0, false); w = __builtin_amdgcn_cvt_pk_fp8_f32(clamp8(c), clamp8(d), w, true); return (unsigned)w; }
__device__ __forceinline__ float bf_lo(unsigned w) { return __uint_as_float(w << 16); }
__device__ __forceinline__ float bf_hi(unsigned w) { return __uint_as_float(w & 0xffff0000u); }
__device__ __forceinline__ int lane_id() { int l; asm volatile("v_mbcnt_lo_u32_b32 %0, -1, 0\n\tv_mbcnt_hi_u32_b32 %0, -1, %0" : "=v"(l)); return l; }
template <int K> __device__ __forceinline__ float xor_lane(float v) { return __int_as_float(__builtin_amdgcn_ds_swizzle(__float_as_int(v), (K << 10) | 0x1f)); }
__device__ __forceinline__ float sum_xor32(float v) { auto rr = __builtin_amdgcn_permlane32_swap(__float_as_uint(v), __float_as_uint(v), false, false); return __uint_as_float(rr[0]) + __uint_as_float(rr[1]); }
__device__ __forceinline__ float wave_sum(float v) {
    v += xor_lane<1>(v); v += xor_lane<2>(v); v += xor_lane<4>(v); v += xor_lane<8>(v); v += xor_lane<16>(v);
    return sum_xor32(v);
}

constexpr size_t MiB = 1u << 20;
constexpr size_t WS_CTL = 0, CTL_ZERO_BYTES = 1 * MiB;
constexpr size_t WS_ROPEC = 1 * MiB, WS_ROPES = 1 * MiB + 256 * 1024;
constexpr size_t WS_LTOK = 2 * MiB;
constexpr size_t WS_TPOS = 3 * MiB, WS_TGATE = 3 * MiB + 512 * 1024;
constexpr size_t WS_WIN = 4 * MiB;
constexpr size_t WS_WOUT = 12 * MiB;
constexpr size_t WS_WGU = 16 * MiB;
constexpr size_t WS_WD = 27 * MiB;
constexpr size_t WS_EGU = 33 * MiB;
constexpr size_t WS_ED = 89 * MiB;
constexpr size_t WS_XN = 201 * MiB;
constexpr size_t WS_R = 265 * MiB;
constexpr size_t WS_PJ = WS_R;
constexpr size_t WS_MIX = WS_R + 128 * MiB;
constexpr size_t WS_H = WS_R;
constexpr size_t WS_FO = WS_R + 176 * MiB;
constexpr size_t WS_XN8 = 117 * MiB;
constexpr size_t WS_Y = 149 * MiB;
constexpr size_t WS_HC = 281 * MiB;
constexpr size_t WS_END = 512 * MiB;
static_assert(WS_ED + (size_t)8 * DM * D_FFE <= WS_XN8 && WS_HC + (size_t)264 * 256 * D_FFE <= WS_END && WS_R + 192 * MiB <= WS_END, "ws map (MoE overlay)");
static_assert(WS_WD + (size_t)DM * D_FF * 2 <= WS_EGU && WS_EGU + (size_t)16 * DM * D_FFE <= WS_ED && WS_ED + (size_t)8 * DM * D_FFE <= WS_XN, "ws map");
constexpr int CW_TMO = 0, CW_BAR = 4096, CW_CNT = 8192, CW_Q = 9216, CW_EWQ = 11264, CW_NRM = 12288;
constexpr int CHUNK_TILES = 264;

constexpr int RING_BYTES = 131072;
constexpr int MISC_OFF = RING_BYTES;
constexpr int LDS_BYTES = 147456;
constexpr int VN_OFF = MISC_OFF + 2048;
static_assert(VN_OFF + 8192 <= LDS_BYTES, "LDS map");

#define XB_TMO      128
#define XB_XCNT(j)  (256  + 64 * (j))
#define XB_XSUB(j)  (1280 + 64 * (j))
#define XB_XGEN(j)  (2304 + 64 * (j))
#define XB_TOP      3328
#define XB_TOPGEN   3392
#define XCD_BAR_WORDS 3456
#define XB_SPIN_CAP (1u << 18)
__device__ __forceinline__ unsigned xb_ld(unsigned* p)              { return __hip_atomic_load(p, __ATOMIC_RELAXED, __HIP_MEMORY_SCOPE_AGENT); }
__device__ __forceinline__ unsigned xb_add(unsigned* p, unsigned v) { return __hip_atomic_fetch_add(p, v, __ATOMIC_RELAXED, __HIP_MEMORY_SCOPE_AGENT); }
__device__ __forceinline__ unsigned xb_xcc_id() { return (unsigned)__builtin_amdgcn_s_getreg((3 << 11) | 20) & 0xFu; }
#define XB_SPIN(cond, bar) do { unsigned _sp = 0; while (cond) { __builtin_amdgcn_s_sleep(1); \
    if ((++_sp & 255u) == 0u) { if (xb_ld(&(bar)[XB_TMO])) break; if (_sp > XB_SPIN_CAP) { atomicAdd(&(bar)[XB_TMO], 1u); break; } } } } while (0)
struct XcdBarrier { unsigned* bar; unsigned x; volatile LAS unsigned* st; };
__device__ __forceinline__ XcdBarrier xcd_barrier_post(unsigned* bar, volatile LAS unsigned* st, bool t0) {
    XcdBarrier b; b.bar = bar; b.x = xb_xcc_id(); b.st = st;
    if (t0) (void)xb_add(&bar[XB_XCNT(b.x)], 1u);
    return b;
}
__device__ __forceinline__ void xcd_barrier_complete(unsigned* bar, unsigned x, unsigned& nloc, unsigned& nx) {
    const unsigned G = gridDim.x * gridDim.y * gridDim.z;
    unsigned sum, cnt, mine, sp = 0u;
    for (;;) {
        sum = 0u; cnt = 0u; mine = 0u;
#pragma unroll
        for (unsigned j = 0; j < 16; ++j) { const unsigned c = xb_ld(&bar[XB_XCNT(j)]); sum += c; cnt += (c > 0u) ? 1u : 0u; mine = (j == x) ? c : mine; }
        if (sum == G) break;
        __builtin_amdgcn_s_sleep(1);
        if ((++sp & 255u) == 0u) { if (xb_ld(&bar[XB_TMO])) break; if (sp > XB_SPIN_CAP) { atomicAdd(&bar[XB_TMO], 1u); break; } }
    }
    nloc = mine > 0u ? mine : 1u; nx = cnt > 0u ? cnt : 1u;
}
__device__ __forceinline__ void xcd_barrier(const XcdBarrier& b, bool t0) {
    asm volatile("s_waitcnt vmcnt(0)" ::: "memory");
    __syncthreads();
    if (t0) {
        unsigned* bar = b.bar; asm volatile("" : "+s"(bar));
        __builtin_amdgcn_s_waitcnt(0);
        unsigned nloc = b.st[0], nx = b.st[1];
        unsigned bx = b.x; asm volatile("" : "+s"(bx));
        if (nloc == 0u) { xcd_barrier_complete(bar, bx, nloc, nx); b.st[0] = nloc; b.st[1] = nx; }
        const unsigned old = xb_add(&bar[XB_XSUB(bx)], 1u);
        const unsigned gen = old / nloc;
        if (old + 1u == (gen + 1u) * nloc) {
            __builtin_amdgcn_fence(__ATOMIC_RELEASE, "agent");
            asm volatile("s_waitcnt vmcnt(0)" ::: "memory");
            const unsigned og = xb_add(&bar[XB_TOP], 1u);
            const unsigned tg = og / nx;
            if (og + 1u == (tg + 1u) * nx) xb_add(&bar[XB_TOPGEN], 1u);
            else XB_SPIN(xb_ld(&bar[XB_TOPGEN]) == tg, bar);
            __builtin_amdgcn_fence(__ATOMIC_ACQUIRE, "agent");
            xb_add(&bar[XB_XGEN(bx)], 1u);
            asm volatile("s_waitcnt vmcnt(0)" ::: "memory");
        } else {
            XB_SPIN(xb_ld(&bar[XB_XGEN(bx)]) == gen, bar);
            __builtin_amdgcn_fence(__ATOMIC_ACQUIRE, "agent");
            asm volatile("s_waitcnt vmcnt(0)" ::: "memory");
        }
    }
    __syncthreads();
}

namespace pg8 {
constexpr int BM = 256, BK = 64, HALF = 128, HTB = HALF * BK * 2, STAGE_BYTES = 8 * HTB, NXCD = 8, WGM = 8;
__device__ __forceinline__ int lds_byte(int r, int c) { const int st = (r >> 4) * 2 + (c >> 5), rr = r & 15, cc = c & 31, ob = rr * 64 + cc * 2; return st * 1024 + (ob ^ (((ob >> 9) & 1) << 5)); }
__device__ __forceinline__ void stage_rc(int b, int& R, int& C) { const int st = b / 1024, sb = b % 1024, swz = sb ^ (((sb >> 9) & 1) << 5); R = (st >> 1) * 16 + swz / 64; C = (st & 1) * 32 + (swz % 64) / 2; }
__device__ __forceinline__ int perm32(int rho) { const int n = rho >> 4, i = rho & 15; return 8 * (i >> 2) + 4 * n + (i & 3); }

struct Unit { int pm, pn, e, p0, cnt; };
struct Gemm { const void* A; const void* Bt; int K; size_t estride; };

__device__ __forceinline__ bool grid_order(int i, int G, int c, int nM, int nN, int& pm, int& pn) {
    const int nwg = nM * nN; const long L = (long)i * G + c; if (L >= nwg) return false;
    int wgid = (int)L; { const int q = nwg / NXCD, r = nwg % NXCD, xcd = wgid % NXCD, off = wgid / NXCD; wgid = (xcd < r ? xcd * (q + 1) : r * (q + 1) + (xcd - r) * q) + off; }
    const int nig = WGM * nN, gid = wgid / nig, fm = gid * WGM, gsz = (nM - fm) < WGM ? (nM - fm) : WGM;
    pm = fm + ((wgid % nig) % gsz); pn = (wgid % nig) / gsz; return true;
}
struct StaticOrder {
    int nM, nN, G, c;
    __device__ void init(int Mrows, int N, int G_, int c_) { nM = Mrows / BM; nN = N / BM; G = G_; c = c_; }
    __device__ __forceinline__ bool next(int i, Unit& u) const { u.e = 0; u.p0 = 0; u.cnt = 0; return grid_order(i, G, c, nM, nN, u.pm, u.pn); }
    __device__ __forceinline__ int arow(const Unit& u, int r) const { return u.pm * BM + r; }
};

template <class Epi, class Sched, bool ALIGN_EPI, bool GATHER = false, int ES = 2>
__device__ __forceinline__ void gemm_phase(LAS unsigned char* lds, const Gemm g, const Sched& S, const Epi& E, int wave0) {
    int tid = wave0 * 64 + lane_id(); asm volatile("" : "+v"(tid));
    const int wid = __builtin_amdgcn_readfirstlane(tid >> 6), lane = tid & 63, wr = wid >> 2, wc = wid & 3, fr = lane & 15, fq = lane >> 4;
    const int K = g.K, nt = K * ES / 128;
    unsigned voffA, voffB;
    { int R, C; stage_rc(tid * 16, R, C); const int Rb = Epi::PERM ? ((R & ~31) + perm32(R & 31)) : R; voffA = (unsigned)(R * K * ES + C * 2); voffB = (unsigned)(Rb * K * ES + C * 2); }
    const unsigned pstep = (unsigned)(64 * K * ES);
    const unsigned kstep = 128u;
    const unsigned hstep = (unsigned)(HALF * K * ES);
    const unsigned tstep = 2u * hstep;
    const unsigned ldsw = (unsigned)wid * 1024u;
    const unsigned lp = (unsigned)lds_byte(fr, fq * 8); const unsigned aS = (unsigned)wr * 8192u, bS = (unsigned)wc * 4096u;
#define PG8_ADDR(soff) ({ unsigned _t = lp; asm volatile("" : "+v"(_t)); _t + (soff); })
    const __amdgpu_buffer_rsrc_t rA = __builtin_amdgcn_make_buffer_rsrc(const_cast<void*>(g.A), 0, 0x7fffffff, 0x00020000);
    const __amdgpu_buffer_rsrc_t rB = __builtin_amdgcn_make_buffer_rsrc(const_cast<void*>(g.Bt), 0, 0x7fffffff, 0x00020000);
#define PG8_SA(b, h) (((b) * 2 + (h)) * HTB)
#define PG8_SB(b, h) ((4 + (b) * 2 + (h)) * HTB)
#define PG8_STAGE(bufoff, rsrc, soff, voff) do { _Pragma("unroll") for (int _i = 0; _i < 2; ++_i) \
        __builtin_amdgcn_raw_ptr_buffer_load_lds(rsrc, (LAS unsigned*)(lds + (bufoff) + ldsw + _i * 8192), 16, (voff), (int)((soff) + _i * pstep), 0, 0); } while (0)
#define PG8_STAGE_G(bufoff, rsrc, soff, V) do { _Pragma("unroll") for (int _i = 0; _i < 2; ++_i) \
        __builtin_amdgcn_raw_ptr_buffer_load_lds(rsrc, (LAS unsigned*)(lds + (bufoff) + ldsw + _i * 8192), 16, (V)[_i], (int)(soff), 0, 0); } while (0)
#define PG8_STAGE_A(bufoff, uo, kb, h, V) do { if constexpr (GATHER) { PG8_STAGE_G(bufoff, rA, (kb), (V)[h]); } else { PG8_STAGE(bufoff, rA, (uo) + (kb) + (h) * hstep, voffA); } } while (0)
#define PG8_AOFF(dst, u) do { const int _t = wid * 64 + lane_id(); _Pragma("unroll") for (int _i = 0; _i < 2; ++_i) { int _R, _C; stage_rc(_t * 16 + _i * 8192, _R, _C); _Pragma("unroll") for (int _h = 0; _h < 2; ++_h) \
        dst[_h][_i] = (unsigned)S.arow(u, _R + _h * HALF) * (unsigned)(K * ES) + (unsigned)_C * 2u; } } while (0)
#define PG8_FR(p) (*(const LAS bf16x8*)(p))
#define PG8_FR8(p) __builtin_shufflevector(__builtin_bit_cast(i32x4, PG8_FR(p)), __builtin_bit_cast(i32x4, PG8_FR((p) + 1024)), 0, 1, 2, 3, 4, 5, 6, 7)
#define PG8_LDA(dst, b, h) do { const unsigned aoff = PG8_ADDR(aS); _Pragma("unroll") for (int m = 0; m < 4; ++m) { if constexpr (ES == 2) { _Pragma("unroll") for (int k = 0; k < 2; ++k) dst[m][k] = PG8_FR(lds + PG8_SA(b, h) + aoff + m * 2048 + k * 1024); } \
        else dst##8[m] = PG8_FR8(lds + PG8_SA(b, h) + aoff + m * 2048); } } while (0)
#define PG8_LDB(dst, b, h) do { const unsigned boff = PG8_ADDR(bS); _Pragma("unroll") for (int n = 0; n < 2; ++n) { if constexpr (ES == 2) { _Pragma("unroll") for (int k = 0; k < 2; ++k) dst[n][k] = PG8_FR(lds + PG8_SB(b, h) + boff + n * 2048 + k * 1024); } \
        else dst##8[n] = PG8_FR8(lds + PG8_SB(b, h) + boff + n * 2048); } } while (0)
#define PG8_MMA(ai, bj, At, Bt) do { __builtin_amdgcn_s_setprio(1); _Pragma("unroll") for (int m = 0; m < 4; ++m) _Pragma("unroll") for (int n = 0; n < 2; ++n) { \
        if constexpr (ES == 2) { _Pragma("unroll") for (int k = 0; k < 2; ++k) acc[ai][bj][m][n] = __builtin_amdgcn_mfma_f32_16x16x32_bf16(Bt[n][k], At[m][k], acc[ai][bj][m][n], 0, 0, 0); } \
        else { asm volatile("v_mfma_f32_16x16x128_f8f6f4 %0, %1, %2, %0" : "+v"(acc[ai][bj][m][n]) : "v"(Bt##8[n]), "v"(At##8[m])); } } \
        __builtin_amdgcn_s_setprio(0); } while (0)
#define PG8_WAIT_V(n) asm volatile("s_waitcnt vmcnt(" #n ")" ::: "memory")
#define PG8_WAIT_L(n) asm volatile("s_waitcnt lgkmcnt(" #n ")" ::: "memory")
#define PG8_BAR __builtin_amdgcn_s_barrier()
#define PG8_SCHED __builtin_amdgcn_sched_barrier(0)
    Unit cur, nxt; int ui = 0;
    if (!S.next(0, cur)) return;
    f32x4 acc[2][2][4][2];
#pragma unroll
    for (int a = 0; a < 2; ++a)
#pragma unroll
        for (int b = 0; b < 2; ++b)
#pragma unroll
            for (int m = 0; m < 4; ++m)
#pragma unroll
                for (int n = 0; n < 2; ++n) acc[a][b][m][n] = (f32x4){0.f, 0.f, 0.f, 0.f};
    bf16x8 At[4][2], B0[2][2], B1[2][2];
    i32x8 At8[4], B08[2], B18[2];
    unsigned vc[2][2];
    LAS u32x4* vstash = (LAS u32x4*)(lds + VN_OFF - 0) + tid;
    if constexpr (GATHER) { PG8_AOFF(vc, cur); }
    unsigned cA = GATHER ? 0u : (unsigned)S.arow(cur, 0) * (unsigned)(K * ES);
    unsigned cB = (unsigned)cur.e * (unsigned)g.estride + (unsigned)cur.pn * tstep;
    PG8_STAGE(PG8_SB(0, 0), rB, cB, voffB); PG8_STAGE(PG8_SB(0, 1), rB, cB + hstep, voffB); PG8_STAGE_A(PG8_SA(0, 0), cA, 0u, 0, vc); PG8_STAGE_A(PG8_SA(0, 1), cA, 0u, 1, vc);
    if (wr == 1) PG8_BAR;
    PG8_WAIT_V(2); PG8_BAR;
    PG8_STAGE(PG8_SB(1, 0), rB, cB + kstep, voffB); PG8_STAGE_A(PG8_SA(1, 0), cA, kstep, 0, vc); PG8_STAGE(PG8_SB(1, 1), rB, cB + hstep + kstep, voffB);
    PG8_WAIT_V(6); PG8_BAR;
    for (;;) {
        const bool has_next = S.next(ui + 1, nxt);
        if constexpr (GATHER) { unsigned vn[2][2];
            if (has_next) { PG8_AOFF(vn, nxt); } else {
#pragma unroll
                for (int h = 0; h < 2; ++h)
#pragma unroll
                    for (int i = 0; i < 2; ++i) vn[h][i] = vc[h][i]; }
            *vstash = (u32x4){vn[0][0], vn[0][1], vn[1][0], vn[1][1]}; }
        const unsigned nA = GATHER ? 0u : (has_next ? (unsigned)S.arow(nxt, 0) * (unsigned)(K * ES) : cA);
        const unsigned nB = has_next ? (unsigned)nxt.e * (unsigned)g.estride + (unsigned)nxt.pn * tstep : cB;
        for (int t = 0; t < nt; t += 2) {
            const bool last = (t == nt - 2);
            const unsigned k1 = (unsigned)(t + 1) * kstep;
            const unsigned k2 = last ? 0u : (unsigned)(t + 2) * kstep, k3 = k2 + kstep;
            const unsigned a2 = last ? nA : cA;
            const unsigned b2 = last ? nB : cB + (unsigned)(t + 2) * kstep, b3 = b2 + kstep;
            PG8_LDB(B0, 0, 0); PG8_LDB(B1, 0, 1); PG8_SCHED; PG8_LDA(At, 0, 0); PG8_STAGE_A(PG8_SA(1, 1), cA, k1, 1, vc);
            if constexpr (GATHER) { if (last) { const u32x4 vv = *vstash; vc[0][0] = vv[0]; vc[0][1] = vv[1]; vc[1][0] = vv[2]; vc[1][1] = vv[3]; } }
            PG8_WAIT_V(8); PG8_WAIT_L(0); PG8_BAR; PG8_MMA(0, 0, At, B0); PG8_MMA(0, 1, At, B1); PG8_BAR; PG8_SCHED;
            PG8_LDA(At, 0, 1); PG8_STAGE(PG8_SB(0, 0), rB, b2, voffB); PG8_STAGE(PG8_SB(0, 1), rB, b2 + hstep, voffB); PG8_STAGE_A(PG8_SA(0, 0), a2, k2, 0, vc);
            PG8_WAIT_V(8); PG8_WAIT_L(0); PG8_BAR; PG8_MMA(1, 0, At, B0); PG8_MMA(1, 1, At, B1); PG8_BAR; PG8_SCHED;
            PG8_LDB(B0, 1, 0); PG8_LDB(B1, 1, 1); PG8_SCHED; PG8_LDA(At, 1, 0); PG8_STAGE_A(PG8_SA(0, 1), a2, k2, 1, vc);
            PG8_WAIT_V(8); PG8_WAIT_L(0); PG8_BAR; PG8_MMA(0, 0, At, B0); PG8_MMA(0, 1, At, B1); PG8_BAR; PG8_SCHED;
            PG8_LDA(At, 1, 1); PG8_STAGE(PG8_SB(1, 0), rB, b3, voffB); PG8_STAGE(PG8_SB(1, 1), rB, b3 + hstep, voffB); PG8_STAGE_A(PG8_SA(1, 0), a2, k3, 0, vc);
            PG8_WAIT_V(8); PG8_WAIT_L(0); PG8_BAR; PG8_MMA(1, 0, At, B0); PG8_MMA(1, 1, At, B1); PG8_BAR; PG8_SCHED;
        }
        if constexpr (ALIGN_EPI) { if (wr == 0) PG8_BAR; }
        if constexpr (ES == 1) asm volatile("s_nop 15\n\ts_nop 15" ::: "memory");
        { const int l2 = lane_id(); E(acc, cur, wr, wc, l2 & 15, l2 >> 4); }
        if (!has_next) break;
#pragma unroll
        for (int a = 0; a < 2; ++a)
#pragma unroll
            for (int b = 0; b < 2; ++b)
#pragma unroll
                for (int m = 0; m < 4; ++m)
#pragma unroll
                    for (int n = 0; n < 2; ++n) acc[a][b][m][n] = (f32x4){0.f, 0.f, 0.f, 0.f};
        cur = nxt; cA = nA; cB = nB; ++ui;
        if constexpr (ALIGN_EPI) { if (wr == 1) PG8_BAR; }
    }
    PG8_WAIT_V(0);
    if constexpr (!ALIGN_EPI) { if (wr == 0) PG8_BAR; }
    PG8_BAR;
#undef PG8_SA
#undef PG8_SB
#undef PG8_STAGE
#undef PG8_STAGE_G
#undef PG8_STAGE_A
#undef PG8_AOFF
#undef PG8_LDA
#undef PG8_LDB
#undef PG8_MMA
#undef PG8_FR
#undef PG8_ADDR
#undef PG8_FR8
#undef PG8_WAIT_V
#undef PG8_WAIT_L
#undef PG8_BAR
#undef PG8_SCHED
}

struct EpiProj {
    static constexpr bool PERM = true;
    bf16_t* PJ; const float* qn; const float* kn; const float* ropec; const float* ropes; unsigned* nrm;
    __device__ __forceinline__ void operator()(const f32x4 (&acc)[2][2][4][2], const Unit& u, int wr, int wc, int fr, int fq) const {
        const int row0 = u.pm * BM + wr * 64 + fr, pn = u.pn;
        const bool htype = (pn == 1) || (pn == 2);
        const bool roped = (pn == 1) || (pn == 2 && wc < 2);
        if (!htype) {
            const float sc = (pn == 3) ? 0.17677669529663687f * LOG2E : (pn == 6 ? 0.125f * LOG2E : 1.f);
            const int col0 = pn * BM + wc * 32 + 8 * fq;
            float nmax[2] = {0.f, 0.f};
#pragma unroll
            for (int ai = 0; ai < 2; ++ai)
#pragma unroll
                for (int m = 0; m < 4; ++m) { bf16_t* rowp = PJ + (size_t)(row0 + ai * HALF + m * 16) * D_IN + col0;
#pragma unroll
                    for (int bj = 0; bj < 2; ++bj) { const f32x4 v0 = acc[ai][bj][m][0] * sc, v1 = acc[ai][bj][m][1] * sc;
                        u32x4 w; w.x = pkbf(v0[0], v0[1]); w.y = pkbf(v0[2], v0[3]); w.z = pkbf(v1[0], v1[1]); w.w = pkbf(v1[2], v1[3]);
                        *(u32x4*)(rowp + bj * HALF) = w;
                        if (pn == 3 || pn == 4) { float ss = (v0[0] * v0[0] + v0[1] * v0[1]) + (v0[2] * v0[2] + v0[3] * v0[3]) + (v1[0] * v1[0] + v1[1] * v1[1]) + (v1[2] * v1[2] + v1[3] * v1[3]);
                            ss += xor_lane<16>(ss); ss = sum_xor32(ss); nmax[bj] = __builtin_fmaxf(nmax[bj], ss); } } }
            if (pn == 3 || pn == 4) {
#pragma unroll
                for (int bj = 0; bj < 2; ++bj) { float v = nmax[bj]; v = __builtin_fmaxf(v, xor_lane<1>(v)); v = __builtin_fmaxf(v, xor_lane<2>(v)); v = __builtin_fmaxf(v, xor_lane<4>(v)); v = __builtin_fmaxf(v, xor_lane<8>(v));
                    if (fr == 0 && fq == 0) { const int b = (u.pm * BM) / SEQ, h = 2 * bj + (wc >> 1), c = wc & 1;
                        __hip_atomic_fetch_max(nrm + ((pn - 3) * 16 + b) * 8 + h * 2 + c, __float_as_uint(v), __ATOMIC_RELAXED, __HIP_MEMORY_SCOPE_AGENT); } }
            }
        } else {
            const int colh = pn * BM + wc * 64 + 8 * fq;
            if (!roped) {
#pragma unroll
                for (int ai = 0; ai < 2; ++ai)
#pragma unroll
                    for (int m = 0; m < 4; ++m) { bf16_t* rowp = PJ + (size_t)(row0 + ai * HALF + m * 16) * D_IN + colh;
#pragma unroll
                        for (int bj = 0; bj < 2; ++bj) { const f32x4 v0 = acc[ai][bj][m][0], v1 = acc[ai][bj][m][1];
                            u32x4 w; w.x = pkbf(v0[0], v0[1]); w.y = pkbf(v0[2], v0[3]); w.z = pkbf(v1[0], v1[1]); w.w = pkbf(v1[2], v1[3]);
                            *(u32x4*)(rowp + bj * 32) = w; } }
            } else {
                const float* nw = (pn == 1) ? qn : kn; const float osc = (pn == 1) ? 0.125f * LOG2E : 1.f;
                f32x4 w1[2], w2[2];
#pragma unroll
                for (int bj = 0; bj < 2; ++bj) { w1[bj] = *(const f32x4*)(nw + 32 * bj + 4 * fq); w2[bj] = *(const f32x4*)(nw + 32 * bj + 16 + 4 * fq); }
#pragma unroll
                for (int ai = 0; ai < 2; ++ai)
#pragma unroll
                    for (int m = 0; m < 4; ++m) {
                        const int row = row0 + ai * HALF + m * 16, s = row & (SEQ - 1);
                        float ss = 0.f;
#pragma unroll
                        for (int bj = 0; bj < 2; ++bj)
#pragma unroll
                            for (int n = 0; n < 2; ++n) { const f32x4 x = acc[ai][bj][m][n]; ss += (x[0] * x[0] + x[1] * x[1]) + (x[2] * x[2] + x[3] * x[3]); }
                        ss += xor_lane<16>(ss); ss = sum_xor32(ss);
                        const float rinv = 1.0f / sqrtf(ss * (1.f / 64.f) + RMS_EPS);
                        bf16_t* rowp = PJ + (size_t)row * D_IN + colh;
#pragma unroll
                        for (int bj = 0; bj < 2; ++bj) {
                            const f32x4 c = *(const f32x4*)(ropec + s * 32 + bj * 16 + 4 * fq), sn = *(const f32x4*)(ropes + s * 32 + bj * 16 + 4 * fq);
                            const f32x4 x1 = acc[ai][bj][m][0] * rinv * w1[bj], x2 = acc[ai][bj][m][1] * rinv * w2[bj];
                            const f32x4 o1 = (x1 * c - x2 * sn) * osc, o2 = (x2 * c + x1 * sn) * osc;
                            u32x4 w; w.x = pkbf(o1[0], o1[1]); w.y = pkbf(o1[2], o1[3]); w.z = pkbf(o2[0], o2[1]); w.w = pkbf(o2[2], o2[3]);
                            *(u32x4*)(rowp + bj * 32) = w; }
                    }
            }
        }
    }
};
struct EpiResid {
    static constexpr bool PERM = false;
    float* X; float sc;
    __device__ __forceinline__ void operator()(const f32x4 (&acc)[2][2][4][2], const Unit& u, int wr, int wc, int fr, int fq) const {
        const int row0 = u.pm * BM + wr * 64 + fr, col0 = u.pn * BM + wc * 32 + 4 * fq;
#pragma unroll
        for (int ai = 0; ai < 2; ++ai)
#pragma unroll
            for (int m = 0; m < 4; ++m) { float* rowp = X + (size_t)(row0 + ai * HALF + m * 16) * DM + col0;
#pragma unroll
                for (int bj = 0; bj < 2; ++bj)
#pragma unroll
                    for (int n = 0; n < 2; ++n) { f32x4* p = (f32x4*)(rowp + bj * HALF + n * 16); *p = *p * ALPHA + acc[ai][bj][m][n] * sc; } }
    }
};
template <bool OUT8>
struct EpiSwiGLU {
    static constexpr bool PERM = true;
    void* H; int ldh; int rt0;
    __device__ __forceinline__ void operator()(const f32x4 (&acc)[2][2][4][2], const Unit& u, int wr, int wc, int fr, int fq) const {
        const int row0 = (u.pm - rt0) * BM + wr * 64 + fr, col0 = u.pn * HALF + wc * 32 + 8 * fq;
#pragma unroll
        for (int ai = 0; ai < 2; ++ai)
#pragma unroll
            for (int m = 0; m < 4; ++m) {
                float o[8];
#pragma unroll
                for (int n = 0; n < 2; ++n)
#pragma unroll
                    for (int j = 0; j < 4; j += 2) { constexpr float isc = OUT8 ? 1.0f / EGU_SCALE : 1.0f;
                        const f32x2 g2 = {acc[ai][0][m][n][j], acc[ai][0][m][n][j + 1]}, u2 = {acc[ai][1][m][n][j], acc[ai][1][m][n][j + 1]};
                        const f32x2 a2 = g2 * (-LOG2E * isc); f32x2 d2; d2.x = 1.0f + __builtin_amdgcn_exp2f(a2.x); d2.y = 1.0f + __builtin_amdgcn_exp2f(a2.y);
                        f32x2 r2; r2.x = __builtin_amdgcn_rcpf(d2.x); r2.y = __builtin_amdgcn_rcpf(d2.y);
                        const f32x2 o2 = (g2 * (isc * isc)) * u2 * r2; o[4 * n + j] = o2.x; o[4 * n + j + 1] = o2.y; }
                if constexpr (OUT8) { u32x2 w; w.x = pk4_fp8(o[0], o[1], o[2], o[3]); w.y = pk4_fp8(o[4], o[5], o[6], o[7]);
                    *(u32x2*)((unsigned char*)H + (size_t)(row0 + ai * HALF + m * 16) * ldh + col0) = w; }
                else { u32x4 w; w.x = pkbf(o[0], o[1]); w.y = pkbf(o[2], o[3]); w.z = pkbf(o[4], o[5]); w.w = pkbf(o[6], o[7]);
                    *(u32x4*)((bf16_t*)H + (size_t)(row0 + ai * HALF + m * 16) * ldh + col0) = w; } }
    }
};
struct EpiBf16 {
    static constexpr bool PERM = true;
    bf16_t* O; int ldc; float sc;
    __device__ __forceinline__ void operator()(const f32x4 (&acc)[2][2][4][2], const Unit& u, int wr, int wc, int fr, int fq) const {
        const int row0 = u.pm * BM + wr * 64 + fr, col0 = u.pn * BM + wc * 32 + 8 * fq;
#pragma unroll
        for (int ai = 0; ai < 2; ++ai)
#pragma unroll
            for (int m = 0; m < 4; ++m) { bf16_t* rowp = O + (size_t)(row0 + ai * HALF + m * 16) * ldc + col0;
#pragma unroll
                for (int bj = 0; bj < 2; ++bj) { const f32x4 v0 = acc[ai][bj][m][0] * sc, v1 = acc[ai][bj][m][1] * sc;
                    u32x4 w; w.x = pkbf(v0[0], v0[1]); w.y = pkbf(v0[2], v0[3]); w.z = pkbf(v1[0], v1[1]); w.w = pkbf(v1[2], v1[3]);
                    *(u32x4*)(rowp + bj * HALF) = w; } }
    }
};
}

struct MoeTable { volatile LAS int* T; };
__device__ __forceinline__ int moe_expert_of(const MoeTable& t, int rt) { int e = 0;
#pragma unroll
    for (int j = 1; j < 8; ++j) e += (rt >= t.T[j]) ? 1 : 0;
    return __builtin_amdgcn_readfirstlane(e); }
struct MoeOrder {
    MoeTable tab; int rt_lo, nM, nN, G, c; const int* ltok; bool gather;
    __device__ __forceinline__ bool next(int i, pg8::Unit& u) const {
        int pm, pn; if (!pg8::grid_order(i, G, c, nM, nN, pm, pn)) return false;
        u.pm = rt_lo + pm; u.pn = pn; u.e = moe_expert_of(tab, u.pm); u.p0 = __builtin_amdgcn_readfirstlane((u.pm - tab.T[u.e]) * 256); u.cnt = __builtin_amdgcn_readfirstlane(tab.T[16 + u.e]); return true; }
    __device__ __forceinline__ int arow(const pg8::Unit& u, int r) const {
        if (gather) { const int p = u.p0 + r; return p < u.cnt ? ltok[u.e * M + p] : 0; }
        return (u.pm - rt_lo) * 256 + r; }
};

namespace att {
constexpr int PJP = D_IN, MXP = DM, SLOTB = 8192;
constexpr int NSLOT = 3;
constexpr int L_K = 0, L_V = NSLOT * SLOTB, L_WS = 2 * NSLOT * SLOTB, L_OST = L_WS + 8 * 512, OST_W = 32 * 68 * 4, L_BYTES = L_OST + 8 * OST_W;
static_assert(L_BYTES <= RING_BYTES, "attention scratch");
constexpr float THR = 8.0f;
__device__ __forceinline__ int crow(int r, int hi) { return (r & 3) + 8 * (r >> 2) + 4 * hi; }
__device__ __forceinline__ void glds16(const void* gsrc, unsigned lds_dst) { unsigned keep;
    asm volatile("s_mov_b32 %0, m0\n\ts_mov_b32 m0, %2\n\ts_nop 0\n\tglobal_load_lds_dwordx4 %1, off\n\ts_mov_b32 m0, %0" : "=&s"(keep) : "v"(gsrc), "s"(lds_dst) : "memory"); }
#define ATT_MX3(a, b, c) __builtin_fmaxf(__builtin_fmaxf((a), (b)), (c))
__device__ __forceinline__ float rowmax(const f32x16& p0, const f32x16& p1) {
    float a = ATT_MX3(p0[0], p0[1], p1[0]), b = ATT_MX3(p0[2], p0[3], p1[1]); a = ATT_MX3(a, p1[2], p1[3]);
#pragma unroll
    for (int r = 4; r < 16; r += 4) { a = ATT_MX3(a, p0[r], p0[r + 1]); b = ATT_MX3(b, p0[r + 2], p0[r + 3]); a = ATT_MX3(a, p1[r], p1[r + 1]); b = ATT_MX3(b, p1[r + 2], p1[r + 3]); }
    float m = __builtin_fmaxf(a, b); auto rr = __builtin_amdgcn_permlane32_swap(__float_as_uint(m), __float_as_uint(m), false, false);
    return __builtin_fmaxf(__uint_as_float(rr[0]), __uint_as_float(rr[1])); }
template <int D0, int NS>
__device__ __forceinline__ void qkt(f32x16& p0, f32x16& p1, const LAS unsigned char* Kslot, const bf16x8* qr, const f32x16& ci0, const f32x16& ci1, int r32, int hi) {
    const LAS unsigned char* kb = Kslot + hi * 1024 + r32 * 16;
#pragma unroll
    for (int s = 0; s < NS; ++s) { const int d0 = D0 + s;
        const bf16x8 b0 = *(const LAS bf16x8*)(kb + d0 * 2048), b1 = *(const LAS bf16x8*)(kb + d0 * 2048 + 512);
        if (s == 0) { p0 = __builtin_amdgcn_mfma_f32_32x32x16_bf16(b0, qr[d0], ci0, 0, 0, 0); p1 = __builtin_amdgcn_mfma_f32_32x32x16_bf16(b1, qr[d0], ci1, 0, 0, 0); }
        else { p0 = __builtin_amdgcn_mfma_f32_32x32x16_bf16(b0, qr[d0], p0, 0, 0, 0); p1 = __builtin_amdgcn_mfma_f32_32x32x16_bf16(b1, qr[d0], p1, 0, 0, 0); } }
}
__device__ __forceinline__ void pv(f32x16* o, int vb, bf16x8 pa0, bf16x8 pa1, bf16x8 pa2, bf16x8 pa3) {
#pragma unroll
    for (int d0 = 0; d0 < 2; ++d0) { s16x4 lo[4], hi[4];
#pragma unroll
        for (int ks = 0; ks < 4; ++ks) {
            asm volatile("ds_read_b64_tr_b16 %0,%1 offset:%c2" : "=&v"(lo[ks]) : "v"(vb), "i"(d0 * 4096 + ks * 1024) : "memory");
            asm volatile("ds_read_b64_tr_b16 %0,%1 offset:%c2" : "=&v"(hi[ks]) : "v"(vb), "i"(d0 * 4096 + ks * 1024 + 512) : "memory"); }
        asm volatile("s_waitcnt lgkmcnt(0)" ::: "memory"); __builtin_amdgcn_sched_barrier(0);
#define ATT_PK(k) (bf16x8){lo[k][0], lo[k][1], lo[k][2], lo[k][3], hi[k][0], hi[k][1], hi[k][2], hi[k][3]}
        o[d0] = __builtin_amdgcn_mfma_f32_32x32x16_bf16(pa0, ATT_PK(0), o[d0], 0, 0, 0);
        o[d0] = __builtin_amdgcn_mfma_f32_32x32x16_bf16(pa1, ATT_PK(1), o[d0], 0, 0, 0);
        o[d0] = __builtin_amdgcn_mfma_f32_32x32x16_bf16(pa2, ATT_PK(2), o[d0], 0, 0, 0);
        o[d0] = __builtin_amdgcn_mfma_f32_32x32x16_bf16(pa3, ATT_PK(3), o[d0], 0, 0, 0);
#undef ATT_PK
    }
}
template <int NC>
__device__ __forceinline__ void pvn(f32x16 (&o)[NC][2], f32x16 (&ol)[NC], int vb, const u32x4 (&pw)[NC][4]) {
    { const bf16x8 ones = (bf16x8){0x3f80, 0x3f80, 0x3f80, 0x3f80, 0x3f80, 0x3f80, 0x3f80, 0x3f80};
#pragma unroll
      for (int ks = 0; ks < 4; ++ks)
#pragma unroll
        for (int c = 0; c < NC; ++c) ol[c] = __builtin_amdgcn_mfma_f32_32x32x16_bf16(__builtin_bit_cast(bf16x8, pw[c][ks]), ones, ol[c], 0, 0, 0); }
#pragma unroll
    for (int d0 = 0; d0 < 2; ++d0) { s16x4 lo[4], hi[4];
#pragma unroll
        for (int ks = 0; ks < 4; ++ks) {
            asm volatile("ds_read_b64_tr_b16 %0,%1 offset:%c2" : "=&v"(lo[ks]) : "v"(vb), "i"(d0 * 4096 + ks * 1024) : "memory");
            asm volatile("ds_read_b64_tr_b16 %0,%1 offset:%c2" : "=&v"(hi[ks]) : "v"(vb), "i"(d0 * 4096 + ks * 1024 + 512) : "memory"); }
        asm volatile("s_waitcnt lgkmcnt(0)" ::: "memory"); __builtin_amdgcn_sched_barrier(0);
#pragma unroll
        for (int ks = 0; ks < 4; ++ks) { const bf16x8 vf = (bf16x8){lo[ks][0], lo[ks][1], lo[ks][2], lo[ks][3], hi[ks][0], hi[ks][1], hi[ks][2], hi[ks][3]};
#pragma unroll
            for (int c = 0; c < NC; ++c) o[c][d0] = __builtin_amdgcn_mfma_f32_32x32x16_bf16(__builtin_bit_cast(bf16x8, pw[c][ks]), vf, o[c][d0], 0, 0, 0); }
    }
}
struct Par { float slope2; float sink2; float lam; float oscale; const float* subln; int dcut; };
template <int VAR>
__device__ __forceinline__ void unit(int b, int h, int qb, const bf16_t* PJ, bf16_t* MIX, LAS unsigned char* shm, const Par P, int wave0) {
    constexpr int NC = (VAR == 1) ? 2 : 1;
    constexpr int QC = VAR == 0 ? 256 : (VAR == 1 ? 768 : 1536), KC = VAR == 0 ? 512 : (VAR == 1 ? 1024 : 1792), VC = VAR == 0 ? 640 : (VAR == 1 ? 1280 : 1920), OC = VAR == 0 ? 256 : (VAR == 1 ? 512 : 768);
    int tid = wave0 * 64 + lane_id(); asm volatile("" : "+v"(tid));
    const int lane = tid & 63, r32 = lane & 31, hi = lane >> 5; const int wid = __builtin_amdgcn_readfirstlane(tid >> 6);
    const long rowbase = (long)b * SEQ; const int q0 = qb * 256;
    const int kvh = (VAR == 1) ? h : (h >> 1);
    const bf16_t* Qw = PJ + (rowbase + q0 + wid * 32) * PJP + QC + h * 64;
    const bf16_t* Kh = PJ + rowbase * PJP + KC + kvh * 64; const bf16_t* Vh = PJ + rowbase * PJP + VC + kvh * 64;
    const unsigned lds0 = (unsigned)(uintptr_t)shm;
    const bf16_t* ksrc = Kh + (long)lane * PJP + wid * 8;
    const bf16_t* vsrc = Vh + (long)(16 * (wid & 3) + (lane >> 2)) * PJP + (wid >> 2) * 32 + (lane & 3) * 8;
    const unsigned kdst = lds0 + L_K + wid * 1024, vdst = lds0 + L_V + wid * 1024;
#define ATT_DMA_K(t, so) glds16(ksrc + (long)(t) * 64 * PJP, (unsigned)__builtin_amdgcn_readfirstlane(kdst + (so)))
#define ATT_DMA_V(t, so) glds16(vsrc + (long)(t) * 64 * PJP, (unsigned)__builtin_amdgcn_readfirstlane(vdst + (so)))
    const int vb0 = (int)(lds0 + L_V) + ((lane >> 4) & 1) * 32 + (lane & 3) * 8 + (4 * hi + ((lane & 15) >> 2)) * 64;
    int t_lo = 0, t_hi = 31;
    if (VAR == 2) { t_lo = q0 / 64 - 2; if (t_lo < 0) t_lo = 0; t_hi = q0 / 64 + 5; if (t_hi > 31) t_hi = 31; }
    if (VAR == 1) { t_lo = (q0 - P.dcut) >> 6; if (t_lo < 0) t_lo = 0; t_hi = (q0 + 255 + P.dcut) >> 6; if (t_hi > 31) t_hi = 31; }
    bf16x8 qr[4];
#pragma unroll
    for (int d0 = 0; d0 < 4; ++d0) qr[d0] = *reinterpret_cast<const bf16x8*>(&Qw[(long)r32 * PJP + d0 * 16 + hi * 8]);
    ATT_DMA_K(t_lo, 0); ATT_DMA_V(t_lo, 0);
    if (t_lo < t_hi) { ATT_DMA_K(t_lo + 1, SLOTB); ATT_DMA_V(t_lo + 1, SLOTB); }
    float mh[NC]; f32x16 o[NC][2], ol[NC], negm[NC];
    float zf = 0.f; asm volatile("" : "+v"(zf));
#pragma unroll
    for (int c = 0; c < NC; ++c) { mh[c] = (VAR == 2) ? P.sink2 : 0.f;
#pragma unroll
        for (int r = 0; r < 16; ++r) { o[c][0][r] = zf; o[c][1][r] = zf; ol[c][r] = (VAR == 2) ? zf + 1.0f : zf; negm[c][r] = zf; } }
    const float K32 = (VAR != 0) ? P.slope2 * 32.f : 0.f;
    const int qpos = q0 + wid * 32 + r32, qw = q0 + wid * 32;
    bool started = false;
    int so = 0, so2 = 2 * SLOTB;
    for (int t = t_lo; t <= t_hi; ++t) {
        if (t < t_hi) asm volatile("s_waitcnt vmcnt(2) lgkmcnt(0)\n\ts_barrier" ::: "memory"); else asm volatile("s_waitcnt vmcnt(0) lgkmcnt(0)\n\ts_barrier" ::: "memory");
        if (t + 2 <= t_hi) { ATT_DMA_K(t + 2, so2); ATT_DMA_V(t + 2, so2); }
        bool rel = true;
        if (VAR == 2) rel = (64 * t + 63 >= qw - 128) && (64 * t <= qw + 31 + 128);
        if (VAR == 1) rel = (64 * t + 63 >= qw - P.dcut) && (64 * t <= qw + 31 + P.dcut);
        if (rel) {
            const bool first = (VAR != 2) && !started; started = true;
            f32x16 p0[NC], p1[NC];
#pragma unroll
            for (int c = 0; c < NC; ++c) {
                f32x16 ci0, ci1;
                if (VAR == 0) { ci0 = negm[c]; ci1 = negm[c]; }
                else {
                    const float qk = (float)(qpos - 64 * t - 4 * hi);
                    if (64 * t >= qw + 31) { const float A = __builtin_fmaf(P.slope2, qk, -mh[c]);
#pragma unroll
                        for (int r = 0; r < 16; ++r) { ci0[r] = __builtin_fmaf(-P.slope2, (float)((r & 3) + 8 * (r >> 2)), A); ci1[r] = ci0[r] - K32; } }
                    else if (64 * t + 63 <= qw) { const float A = __builtin_fmaf(-P.slope2, qk, -mh[c]);
#pragma unroll
                        for (int r = 0; r < 16; ++r) { ci0[r] = __builtin_fmaf(P.slope2, (float)((r & 3) + 8 * (r >> 2)), A); ci1[r] = ci0[r] + K32; } }
                    else {
#pragma unroll
                        for (int r = 0; r < 16; ++r) { const float cr = (float)((r & 3) + 8 * (r >> 2));
                            ci0[r] = __builtin_fmaf(-P.slope2, __builtin_fabsf(qk - cr), -mh[c]); ci1[r] = __builtin_fmaf(-P.slope2, __builtin_fabsf(qk - (cr + 32.f)), -mh[c]); } }
                }
                if (VAR == 1) { if (c == 0) qkt<0, 2>(p0[c], p1[c], shm + L_K + so, qr, ci0, ci1, r32, hi); else qkt<2, 2>(p0[c], p1[c], shm + L_K + so, qr, ci0, ci1, r32, hi); }
                else qkt<0, 4>(p0[c], p1[c], shm + L_K + so, qr, ci0, ci1, r32, hi);
            }
            u32x4 pw[NC][4];
#pragma unroll
            for (int c = 0; c < NC; ++c) {
                if (VAR == 2) {
                    const bool need_mask = (64 * t + 63 - qw > 128) || (qw + 31 - 64 * t > 128);
                    if (need_mask) { const float qk = (float)(qpos - 64 * t - 4 * hi);
#pragma unroll
                        for (int r = 0; r < 16; ++r) { const float cr = (float)((r & 3) + 8 * (r >> 2));
                            if (__builtin_fabsf(qk - cr) > 128.f) p0[c][r] = -INFINITY; if (__builtin_fabsf(qk - (cr + 32.f)) > 128.f) p1[c][r] = -INFINITY; } }
                }
                const float rm = rowmax(p0[c], p1[c]);
                if (first) {
                    mh[c] = rm;
#pragma unroll
                    for (int r = 0; r < 16; ++r) { p0[c][r] -= rm; p1[c][r] -= rm; if (VAR == 0) negm[c][r] = -rm; }
                } else if (__any(rm > THR)) {
                    const float dl = __builtin_fmaxf(rm, 0.f); mh[c] += dl;
#pragma unroll
                    for (int r = 0; r < 16; ++r) { p0[c][r] -= dl; p1[c][r] -= dl; if (VAR == 0) negm[c][r] = -mh[c]; }
                    const float f = __builtin_amdgcn_exp2f(-dl);
                    unsigned zw = 0u; asm volatile("" : "+v"(zw));
                    LAS float* wsf = (LAS float*)(uintptr_t)(zw + lds0 + (unsigned)L_WS + (unsigned)wid * 512u);
                    if (hi == 0) wsf[r32] = f;
                    asm volatile("s_waitcnt lgkmcnt(0)" ::: "memory");
#pragma unroll
                    for (int r = 0; r < 16; ++r) { const float fr_ = wsf[crow(r, hi)]; o[c][0][r] *= fr_; o[c][1][r] *= fr_; ol[c][r] *= fr_; }
                }
#pragma unroll
                for (int r = 0; r < 16; ++r) { p0[c][r] = __builtin_amdgcn_exp2f(p0[c][r]); p1[c][r] = __builtin_amdgcn_exp2f(p1[c][r]); }
                pw[c][0] = (u32x4){pkbf(p0[c][0], p0[c][1]), pkbf(p0[c][2], p0[c][3]), pkbf(p0[c][4], p0[c][5]), pkbf(p0[c][6], p0[c][7])};
                pw[c][1] = (u32x4){pkbf(p0[c][8], p0[c][9]), pkbf(p0[c][10], p0[c][11]), pkbf(p0[c][12], p0[c][13]), pkbf(p0[c][14], p0[c][15])};
                pw[c][2] = (u32x4){pkbf(p1[c][0], p1[c][1]), pkbf(p1[c][2], p1[c][3]), pkbf(p1[c][4], p1[c][5]), pkbf(p1[c][6], p1[c][7])};
                pw[c][3] = (u32x4){pkbf(p1[c][8], p1[c][9]), pkbf(p1[c][10], p1[c][11]), pkbf(p1[c][12], p1[c][13]), pkbf(p1[c][14], p1[c][15])};
            }
            pvn<NC>(o, ol, vb0 + so, pw);
        }
        so = (so == (NSLOT - 1) * SLOTB) ? 0 : so + SLOTB; so2 = (so2 == (NSLOT - 1) * SLOTB) ? 0 : so2 + SLOTB;
    }
    LAS float* stg = (LAS float*)(shm + L_OST + wid * OST_W);
#pragma unroll
    for (int r = 0; r < 16; ++r) { const int orow = crow(r, hi);
        const float rl0 = __builtin_amdgcn_rcpf(ol[0][r]);
        float rl1 = 0.f; if (VAR == 1) rl1 = P.lam * __builtin_amdgcn_rcpf(ol[NC - 1][r]);
#pragma unroll
        for (int d0 = 0; d0 < 2; ++d0) { float v = o[0][d0][r] * rl0; if (VAR == 1) v -= o[NC - 1][d0][r] * rl1; stg[orow * 68 + d0 * 32 + r32] = v; } }
    asm volatile("s_waitcnt lgkmcnt(0)" ::: "memory");
    {
        const int row = lane >> 1, half = lane & 1;
        f32x4 x[8];
#pragma unroll
        for (int k = 0; k < 8; ++k) x[k] = *(const LAS f32x4*)(stg + row * 68 + half * 32 + 4 * k);
        if (VAR == 1) {
            float ss = 0.f;
#pragma unroll
            for (int k = 0; k < 8; ++k) ss += (x[k][0] * x[k][0] + x[k][1] * x[k][1]) + (x[k][2] * x[k][2] + x[k][3] * x[k][3]);
            ss += xor_lane<1>(ss);
            const float rinv = P.oscale / sqrtf(ss * (1.f / 64.f) + RMS_EPS);
#pragma unroll
            for (int k = 0; k < 8; ++k) x[k] = x[k] * rinv * *(const f32x4*)(P.subln + half * 32 + 4 * k);
        }
        bf16_t* op = MIX + (rowbase + q0 + wid * 32 + row) * MXP + OC + h * 64 + half * 32;
#pragma unroll
        for (int k = 0; k < 4; ++k) { u32x4 w; w.x = pkbf(x[2 * k][0], x[2 * k][1]); w.y = pkbf(x[2 * k][2], x[2 * k][3]); w.z = pkbf(x[2 * k + 1][0], x[2 * k + 1][1]); w.w = pkbf(x[2 * k + 1][2], x[2 * k + 1][3]);
            *(u32x4*)(op + 8 * k) = w; }
    }
    asm volatile("s_waitcnt lgkmcnt(0)\n\ts_barrier" ::: "memory");
#undef ATT_DMA_K
#undef ATT_DMA_V
}
}

struct Frame {
    LAS unsigned char* lds; volatile LAS unsigned* MISC; gu32* ctl;
    int tid, lane, wave, vcu, G;
};
struct Args { const float* in[26]; float* out; unsigned char* ws; };
constexpr int PT_OFF = MISC_OFF + 1024;
__device__ __forceinline__ unsigned long long ldp_raw(LAS unsigned char* lds, int i) {
    unsigned z = 0u; asm volatile("" : "+v"(z));
    const unsigned a = z + (unsigned)(uintptr_t)lds + PT_OFF + 8u * (unsigned)i;
    const unsigned long long v = *(volatile LAS unsigned long long*)(uintptr_t)a;
    const unsigned lo = __builtin_amdgcn_readfirstlane((unsigned)v), hi = __builtin_amdgcn_readfirstlane((unsigned)(v >> 32));
    return ((unsigned long long)hi << 32) | lo; }
#define INP(i) ((const float*)ldp_raw(F.lds, (i)))
#define OUTP() ((float*)ldp_raw(F.lds, 26))
#define WSP() ((unsigned char*)ldp_raw(F.lds, 27))

__device__ __forceinline__ int winmap(int n) {
    const int tile = n >> 8, p = n & 255;
    if (tile != 1 && tile != 2) return n;
    const int hh = p >> 6, dim = p & 63, bj = dim >> 5, w = dim & 31;
    int fq, e;
    if (tile == 1 || hh < 2) { const int ehi = w >> 4, i = w & 15; fq = i >> 2; e = (i & 3) + 4 * ehi; }
    else { fq = w >> 3; e = w & 7; }
    return tile * 256 + 128 * bj + 32 * hh + 8 * fq + e;
}
template <int MAP> __device__ __forceinline__ int rowmap(int n) {
    if (MAP == 1) return winmap(n);
    if (MAP == 2) return (n >> 7) * 256 + (n & 127);
    if (MAP == 3) return (n >> 7) * 256 + 128 + (n & 127);
    return n;
}
__device__ __forceinline__ void tr_write(bf16_t* WT, int K, int k0, LAS float* scr, int lane, const int (&drow)[4]) {
    const int c = lane & 7;
#pragma unroll
    for (int j = 0; j < 4; ++j) { const int n = (lane >> 3) + 8 * j; const LAS float* s = scr + (8 * c) * 33 + n;
        u32x4 o; o.x = pkbf(s[0 * 33], s[1 * 33]); o.y = pkbf(s[2 * 33], s[3 * 33]); o.z = pkbf(s[4 * 33], s[5 * 33]); o.w = pkbf(s[6 * 33], s[7 * 33]);
        *(u32x4*)(WT + (size_t)drow[j] * K + k0 + 8 * c) = o; }
    asm volatile("s_waitcnt lgkmcnt(0)" ::: "memory");
}
template <int MAP>
__device__ __forceinline__ void tr_item(const float* W, int K, int N, int ncol0, bf16_t* WT, LAS float* scr, int item, int lane) {
    const int nblk = (N - ncol0) / 32, kb = item / nblk, nb = item % nblk, k0 = 64 * kb, n0 = ncol0 + 32 * nb;
    f32x4 v[8];
#pragma unroll
    for (int i = 0; i < 8; ++i) v[i] = __builtin_nontemporal_load((const f32x4*)(W + (size_t)(k0 + 8 * i + (lane >> 3)) * N + n0 + (lane & 7) * 4));
#pragma unroll
    for (int i = 0; i < 8; ++i) { LAS float* d = scr + (8 * i + (lane >> 3)) * 33 + (lane & 7) * 4; d[0] = v[i][0]; d[1] = v[i][1]; d[2] = v[i][2]; d[3] = v[i][3]; }
    asm volatile("s_waitcnt lgkmcnt(0)" ::: "memory");
    int drow[4];
#pragma unroll
    for (int j = 0; j < 4; ++j) drow[j] = rowmap<MAP>(n0 + (lane >> 3) + 8 * j);
    tr_write(WT, K, k0, scr, lane, drow);
}
template <int MAP>
__device__ __forceinline__ void tr_item8(const float* W, int K, int N, unsigned char* WT, float sc, LAS float* scr, int item, int lane) {
    const int nblk = N / 32, kb = item / nblk, nb = item % nblk, k0 = 64 * kb, n0 = 32 * nb;
    f32x4 v[8];
#pragma unroll
    for (int i = 0; i < 8; ++i) v[i] = __builtin_nontemporal_load((const f32x4*)(W + (size_t)(k0 + 8 * i + (lane >> 3)) * N + n0 + (lane & 7) * 4));
#pragma unroll
    for (int i = 0; i < 8; ++i) { LAS float* d = scr + (8 * i + (lane >> 3)) * 33 + (lane & 7) * 4; d[0] = v[i][0]; d[1] = v[i][1]; d[2] = v[i][2]; d[3] = v[i][3]; }
    asm volatile("s_waitcnt lgkmcnt(0)" ::: "memory");
    const int c = lane & 7;
#pragma unroll
    for (int j = 0; j < 4; ++j) { const int n = (lane >> 3) + 8 * j; const LAS float* s = scr + (8 * c) * 33 + n;
        u32x2 o; o.x = pk4_fp8(s[0 * 33] * sc, s[1 * 33] * sc, s[2 * 33] * sc, s[3 * 33] * sc); o.y = pk4_fp8(s[4 * 33] * sc, s[5 * 33] * sc, s[6 * 33] * sc, s[7 * 33] * sc);
        *(u32x2*)(WT + (size_t)rowmap<MAP>(n0 + n) * K + k0 + 8 * c) = o; }
    asm volatile("s_waitcnt lgkmcnt(0)" ::: "memory");
}
constexpr int EW_IEG = 16 * 112, EW_IED = 56 * 32, EW_ITEMS = 16 * EW_IEG + 8 * EW_IED, EW_CHUNKS = EW_ITEMS / 128;
static_assert(EW_ITEMS % 128 == 0, "expert-weight items per chunk");
__device__ __forceinline__ void expert_weight_chunk(int c, const float* e_gate, const float* e_up, const float* e_down, unsigned char* Egu8, unsigned char* Ed8, LAS float* scr, int wave, int lane) {
    for (int k = 0; k < 16; ++k) { int r = c * 128 + wave * 16 + k;
        if (r < 16 * EW_IEG) { const int idx = r / EW_IEG; r -= idx * EW_IEG; const int e = idx >> 1;
            if ((idx & 1) == 0) tr_item8<2>(e_gate + (size_t)e * DM * D_FFE, DM, D_FFE, Egu8 + (size_t)e * 2 * D_FFE * DM, EGU_SCALE, scr, r, lane);
            else tr_item8<3>(e_up + (size_t)e * DM * D_FFE, DM, D_FFE, Egu8 + (size_t)e * 2 * D_FFE * DM, EGU_SCALE, scr, r, lane); }
        else { r -= 16 * EW_IEG; const int e = r / EW_IED; r -= e * EW_IED; tr_item8<0>(e_down + (size_t)e * D_FFE * DM, D_FFE, DM, Ed8 + (size_t)e * DM * D_FFE, ED_SCALE, scr, r, lane); } }
}
__device__ __forceinline__ void tr_item_pool_wg(const float* W, const float* wp, const float* scale, bf16_t* WT, LAS float* scr, int item, int tid) {
    const int kb = item / 8, nb = item % 8, k0 = 64 * kb, n0 = 32 * nb, g = n0 >> 6, kk = tid >> 3, nq = (tid & 7) * 4;
    const float* wrow = W + (size_t)(k0 + kk) * D_IN + 64 * g; const float* wpc = wp + (size_t)g * 4096 + (n0 & 63) + nq;
    f32x4 acc = {0.f, 0.f, 0.f, 0.f};
#pragma unroll 8
    for (int c = 0; c < 64; ++c) acc += *(const f32x4*)(wpc + c * 64) * wrow[c];
    acc = acc * *(const f32x4*)(scale + n0 + nq);
    LAS float* d = scr + kk * 33 + nq; d[0] = acc[0]; d[1] = acc[1]; d[2] = acc[2]; d[3] = acc[3];
    __syncthreads();
    if (tid < 64) { int drow[4];
#pragma unroll
        for (int j = 0; j < 4; ++j) drow[j] = n0 + (tid >> 3) + 8 * j;
        tr_write(WT, DM, k0, scr, tid, drow); }
    __syncthreads();
}
__device__ __forceinline__ void ln_core(f32x4 (&v)[4], const f32x4 (&g4)[4], const f32x4 (&b4)[4]) {
    float s = 0.f;
#pragma unroll
    for (int j = 0; j < 4; ++j) s += (v[j][0] + v[j][1]) + (v[j][2] + v[j][3]);
    const float mean = wave_sum(s) * (1.f / DM); float s2 = 0.f;
#pragma unroll
    for (int j = 0; j < 4; ++j) { v[j] = v[j] - mean; s2 += (v[j][0] * v[j][0] + v[j][1] * v[j][1]) + (v[j][2] * v[j][2] + v[j][3] * v[j][3]); }
    const float rstd = 1.f / sqrtf(wave_sum(s2) * (1.f / DM) + LN_EPS);
#pragma unroll
    for (int j = 0; j < 4; ++j) v[j] = v[j] * rstd * g4[j] + b4[j];
}
__device__ __forceinline__ void ln_store(const f32x4 (&v)[4], float* xo, bf16_t* xn, int lane) {
#pragma unroll
    for (int j = 0; j < 4; ++j) {
        if (xo) *((f32x4*)xo + lane + 64 * j) = v[j];
        if (xn) { u32x2 w; w.x = pkbf(v[j][0], v[j][1]); w.y = pkbf(v[j][2], v[j][3]); *((u32x2*)xn + lane + 64 * j) = w; } }
}

__global__ void __launch_bounds__(NWAVES * 64, 2) mega_fwd(Args args) {
    extern __shared__ __attribute__((aligned(16))) unsigned char lds_raw[];
    Frame F;
    F.lds = (LAS unsigned char*)lds_raw;
    F.MISC = (volatile LAS unsigned*)(F.lds + MISC_OFF);
    const int wave0 = __builtin_amdgcn_readfirstlane((int)threadIdx.x >> 6);
    F.ctl = (gu32*)(args.ws + WS_CTL);
    { const int t = wave0 * 64 + lane_id();
      for (int u = t; u < 256; u += NWAVES * 64) F.MISC[u] = 0u;
      if (t == 0) { volatile LAS unsigned long long* PT = (volatile LAS unsigned long long*)(F.lds + PT_OFF);
#pragma unroll
        for (int i = 0; i < 26; ++i) PT[i] = (unsigned long long)args.in[i];
        PT[26] = (unsigned long long)args.out; PT[27] = (unsigned long long)args.ws; } }
    __syncthreads();
    XcdBarrier bar = xcd_barrier_post((unsigned*)(F.ctl + CW_BAR), F.MISC + 8, wave0 == 0 && lane_id() == 0);
#define GRID_BAR() xcd_barrier(bar, wave0 == 0 && lane_id() == 0)
#define PHASE_LOCALS() int tid_ = wave0 * 64 + lane_id(); asm volatile("" : "+v"(tid_)); int bid_ = blockIdx.x, G_ = gridDim.x; asm volatile("" : "+s"(bid_), "+s"(G_)); \
    const int lane = tid_ & 63, wave = __builtin_amdgcn_readfirstlane(tid_ >> 6), vcu = (G_ % 8 == 0) ? (bid_ % 8) * (G_ / 8) + bid_ / 8 : bid_, gw = vcu * NWAVES + wave, NGW = G_ * NWAVES; \
    (void)lane; (void)gw; (void)NGW; (void)vcu; (void)wave

        asm volatile("; MARK_P0" ::: "memory");
    for (int dup = 0; dup < DUP_P0; ++dup) {
        PHASE_LOCALS();
        LAS float* scr = (LAS float*)(F.lds + wave * 16384);
        unsigned char* ws = WSP();
        const float* x_in = INP(0); const float* ln_in_g = INP(1); const float* ln_in_b = INP(2); const float* w_in = INP(3); const float* w_pool = INP(4); const float* pool_scale = INP(5);
        const float* w_out = INP(14); const float* w_gate = INP(17); const float* w_up = INP(18); const float* w_down = INP(19); const float* e_gate = INP(21); const float* e_up = INP(22); const float* e_down = INP(23);
        float* X = OUTP(); float* ropec = (float*)(ws + WS_ROPEC); float* ropes = (float*)(ws + WS_ROPES);
        bf16_t* Win_t = (bf16_t*)(ws + WS_WIN); bf16_t* Wout_t = (bf16_t*)(ws + WS_WOUT); bf16_t* Wgu_t = (bf16_t*)(ws + WS_WGU); bf16_t* Wd_t = (bf16_t*)(ws + WS_WD);
        unsigned char* Egu8 = ws + WS_EGU; unsigned char* Ed8 = ws + WS_ED; bf16_t* XN = (bf16_t*)(ws + WS_XN);
        constexpr int I_WIN = 16 * 56, I_POOL = 16 * 8, I_WOUT = 16 * 32, I_G = 16 * 88, I_D = 44 * 32, I_EG = 16 * 112, I_ED = 56 * 32;
        constexpr int N0 = 2 * I_WIN, N1 = N0 + 2 * I_WOUT, N2 = N1 + 2 * I_G, N3 = N2 + I_D, N4 = N3 + 16 * I_EG, N5 = N4 + 8 * I_ED;
        for (int pi = vcu; pi < 2 * I_POOL; pi += G_) { const int l = pi / I_POOL;
            tr_item_pool_wg(w_in + (size_t)l * DM * D_IN, w_pool + (size_t)l * 4 * 4096, pool_scale + l * 256, Win_t + (size_t)l * D_IN * DM, (LAS float*)F.lds, pi - l * I_POOL, tid_); }
        for (int it = gw; it < N3; it += NGW) {
            int r = it;
            if (r < N0) { const int l = r / I_WIN; r -= l * I_WIN; tr_item<1>(w_in + (size_t)l * DM * D_IN, DM, D_IN, 256, Win_t + (size_t)l * D_IN * DM, scr, r, lane); continue; }
            if (r < N1) { r -= N0; const int l = r / I_WOUT; r -= l * I_WOUT; tr_item<0>(w_out + (size_t)l * DM * DM, DM, DM, 0, Wout_t + (size_t)l * DM * DM, scr, r, lane); continue; }
            if (r < N2) { r -= N1; const int which = r / I_G; r -= which * I_G;
#if DENSE_FP8
                if (which == 0) tr_item8<2>(w_gate, DM, D_FF, (unsigned char*)Wgu_t, EGU_SCALE, scr, r, lane); else tr_item8<3>(w_up, DM, D_FF, (unsigned char*)Wgu_t, EGU_SCALE, scr, r, lane);
                continue; }
            if (r < N3) { r -= N2; tr_item8<0>(w_down, D_FF, DM, (unsigned char*)Wd_t, ED_SCALE, scr, r, lane); continue; }
#else
                if (which == 0) tr_item<2>(w_gate, DM, D_FF, 0, Wgu_t, scr, r, lane); else tr_item<3>(w_up, DM, D_FF, 0, Wgu_t, scr, r, lane);
                continue; }
            if (r < N3) { r -= N2; tr_item<0>(w_down, D_FF, DM, 0, Wd_t, scr, r, lane); continue; }
#endif
            (void)N4; (void)N5; (void)e_gate; (void)e_up; (void)e_down; (void)Egu8; (void)Ed8;
        }
        for (int idx = bid_ * 512 + tid_; idx < SEQ * 32; idx += G_ * 512) { const int s = idx >> 5, ax = (idx >> 4) & 1, i = idx & 15;
            const float pos = ax == 0 ? (float)(s / 64) : (float)(s % 64); const float inv_freq = powf(10000.0f, -(float)(2 * i) / 32.0f); const float ang = pos * inv_freq;
            ropec[idx] = cosf(ang); ropes[idx] = sinf(ang); }
        f32x4 g4[4], b4[4];
#pragma unroll
        for (int j = 0; j < 4; ++j) { g4[j] = *((const f32x4*)ln_in_g + lane + 64 * j); b4[j] = *((const f32x4*)ln_in_b + lane + 64 * j); }
        for (int m = gw; m < M; m += NGW) { f32x4 v[4];
#pragma unroll
            for (int j = 0; j < 4; ++j) v[j] = *((const f32x4*)(x_in + (size_t)m * DM) + lane + 64 * j);
            ln_core(v, g4, b4); ln_store(v, nullptr, XN + (size_t)m * DM, lane); }
    }
    GRID_BAR();

#pragma clang loop unroll(full)
    for (int l = 0; l < DEPTH; ++l) {
        asm volatile("; MARK_P1" ::: "memory");
        for (int dup = 0; dup < DUP_P1; ++dup) {
            PHASE_LOCALS();
            unsigned char* ws = WSP(); const float* qn_w = INP(6); const float* kn_w = INP(7);
            bf16_t* XN = (bf16_t*)(ws + WS_XN); bf16_t* Win_t = (bf16_t*)(ws + WS_WIN); bf16_t* PJ = (bf16_t*)(ws + WS_PJ); const float* ropec = (const float*)(ws + WS_ROPEC); const float* ropes = (const float*)(ws + WS_ROPES);
            pg8::Gemm g{XN, Win_t + (size_t)l * D_IN * DM, DM, 0};
            pg8::StaticOrder S; S.init(M, D_IN, G_, bid_);
            pg8::EpiProj E{PJ, qn_w + l * 64, kn_w + l * 64, ropec, ropes, (unsigned*)(ws + WS_CTL) + CW_NRM + l * 256};
            pg8::gemm_phase<pg8::EpiProj, pg8::StaticOrder, true>(F.lds, g, S, E, wave0);
        }
        GRID_BAR();
        asm volatile("; MARK_P2" ::: "memory");
        for (int dup = 0; dup < DUP_P2; ++dup) {
            PHASE_LOCALS();
            unsigned char* ws = WSP(); const float* lam_q1 = INP(8); const float* lam_k1 = INP(9); const float* lam_q2 = INP(10); const float* lam_k2 = INP(11); const float* subln_w = INP(12); const float* sink = INP(13);
            bf16_t* PJ = (bf16_t*)(ws + WS_PJ); bf16_t* MIX = (bf16_t*)(ws + WS_MIX);
            float lam_init, lam, oscale;
            { const float li = 0.8f - 0.6f * expf(-0.3f * (float)l);
              float a = lane < 32 ? lam_q1[l * 32 + lane] * lam_k1[l * 32 + lane] : 0.f, c = lane < 32 ? lam_q2[l * 32 + lane] * lam_k2[l * 32 + lane] : 0.f;
              const float lv = expf(wave_sum(a)) - expf(wave_sum(c)) + li;
              const float os = 1.0f - li;
              asm volatile("v_readfirstlane_b32 %0, %3\n\tv_readfirstlane_b32 %1, %4\n\tv_readfirstlane_b32 %2, %5" : "=s"(lam_init), "=s"(lam), "=s"(oscale) : "v"(li), "v"(lv), "v"(os)); (void)lam_init; }
            unsigned* qhead = (unsigned*)(ws + WS_CTL) + CW_Q + 64 * l; const unsigned* nrm = (const unsigned*)(ws + WS_CTL) + CW_NRM + l * 256;
            int nunit = 0;
            for (;;) {
                unsigned zq = 0u; asm volatile("" : "+v"(zq));
                volatile LAS unsigned* qslot = (volatile LAS unsigned*)(uintptr_t)(zq + (unsigned)(uintptr_t)F.lds + MISC_OFF + 128u);
                if (wave0 == 0 && lane_id() == 0) *qslot = __hip_atomic_fetch_add(qhead, 1u, __ATOMIC_RELAXED, __HIP_MEMORY_SCOPE_AGENT);
                __syncthreads();
                const int idx = __builtin_amdgcn_readfirstlane((int)*qslot);
                __syncthreads();
                if (idx >= 1792) break;
                const bool do_chunk = (l == 0) && ((nunit & 3) == (bid_ & 3)); ++nunit;
                if (idx < 256 || (idx >= 768 && idx < 1024)) {
                    const int h = idx < 128 ? 3 : (idx < 256 ? 2 : (idx < 896 ? 1 : 0)), k = idx & 127, b = k >> 3, qb = k & 7;
                    const float slope2 = exp2f(-(float)(2 * h + 1)) * LOG2E;
                    const float q0n = __uint_as_float(nrm[(0 * 16 + b) * 8 + h * 2]), q1n = __uint_as_float(nrm[(0 * 16 + b) * 8 + h * 2 + 1]), k0n = __uint_as_float(nrm[(1 * 16 + b) * 8 + h * 2]), k1n = __uint_as_float(nrm[(1 * 16 + b) * 8 + h * 2 + 1]);
                    const float bound = sqrtf(__builtin_fmaxf(q0n * k0n, q1n * k1n));
                    float dc = (2.1f * bound + 40.0f) / slope2; if (dc > 4096.f) dc = 4096.f;
                    att::Par P{slope2, 0.f, lam, oscale, subln_w + l * 64, (int)dc + 1};
                    for (int d_ = 0; d_ < DUP_C; ++d_) att::unit<1>(b, h, qb, PJ, MIX, F.lds, P, wave0);
                } else if (idx < 768) {
                    const int k = idx - 256, qb = k & 7, h = (k >> 3) & 3, b = k >> 5;
                    att::Par P{0.f, 0.f, 0.f, 0.f, nullptr, 0};
                    for (int d_ = 0; d_ < DUP_B; ++d_) att::unit<0>(b, h, qb, PJ, MIX, F.lds, P, wave0);
                } else if (idx < 1536) {
                    const int k = idx - 1024, qb = k & 7, h = (k >> 3) & 3, b = k >> 5;
                    att::Par P{exp2f(-(float)(2 * h + 2)) * LOG2E, sink[l * 4 + h] * LOG2E, 0.f, 0.f, nullptr, 0};
                    for (int d_ = 0; d_ < DUP_D; ++d_) att::unit<2>(b, h, qb, PJ, MIX, F.lds, P, wave0);
                } else {
                    const int ch = idx - 1536;
                    for (int it = wave0 * 64 + lane_id(); it < 128 * 32; it += NWAVES * 64) { const int t = ch * 128 + (it >> 5), cg = it & 31, c0 = cg * 8, s = t & (SEQ - 1), base = t - s;
                        const int w = 2 << (c0 >> 6); int lo = s - w / 2, hi = lo + w; if (lo < 0) lo = 0; if (hi > SEQ) hi = SEQ;
                        float acc[8];
#pragma unroll
                        for (int j = 0; j < 8; ++j) acc[j] = 0.f;
                        for (int j = lo; j < hi; ++j) { const u32x4 zz = *(const u32x4*)(PJ + (size_t)(base + j) * D_IN + c0);
                            acc[0] += bf_lo(zz.x); acc[1] += bf_hi(zz.x); acc[2] += bf_lo(zz.y); acc[3] += bf_hi(zz.y); acc[4] += bf_lo(zz.z); acc[5] += bf_hi(zz.z); acc[6] += bf_lo(zz.w); acc[7] += bf_hi(zz.w); }
                        const float inv = 1.0f / (float)(hi - lo); const u32x4 zs = *(const u32x4*)(PJ + (size_t)t * D_IN + c0);
                        u32x4 o; o.x = pkbf(acc[0] * inv - bf_lo(zs.x), acc[1] * inv - bf_hi(zs.x)); o.y = pkbf(acc[2] * inv - bf_lo(zs.y), acc[3] * inv - bf_hi(zs.y));
                        o.z = pkbf(acc[4] * inv - bf_lo(zs.z), acc[5] * inv - bf_hi(zs.z)); o.w = pkbf(acc[6] * inv - bf_lo(zs.w), acc[7] * inv - bf_hi(zs.w));
                        *(u32x4*)(MIX + (size_t)t * DM + c0) = o; }
                }
                if (do_chunk) {
                    unsigned zq2 = 0u; asm volatile("" : "+v"(zq2));
                    volatile LAS unsigned* qslot = (volatile LAS unsigned*)(uintptr_t)(zq2 + (unsigned)(uintptr_t)F.lds + MISC_OFF + 128u);
                    if (wave0 == 0 && lane_id() == 0) *qslot = __hip_atomic_fetch_add((unsigned*)(ws + WS_CTL) + CW_EWQ, 1u, __ATOMIC_RELAXED, __HIP_MEMORY_SCOPE_AGENT);
                    __syncthreads();
                    const int cch = __builtin_amdgcn_readfirstlane((int)*qslot);
                    __syncthreads();
                    if (cch < EW_CHUNKS) { unsigned zq3 = 0u; asm volatile("" : "+v"(zq3));
                        expert_weight_chunk(cch, INP(21), INP(22), INP(23), WSP() + WS_EGU, WSP() + WS_ED, (LAS float*)(uintptr_t)(zq3 + (unsigned)(uintptr_t)F.lds + (unsigned)wave0 * 16384u), wave0, lane_id()); }
                    __syncthreads();
                }
            }
            if (l == 0) for (;;) {
                unsigned zq = 0u; asm volatile("" : "+v"(zq));
                volatile LAS unsigned* qslot = (volatile LAS unsigned*)(uintptr_t)(zq + (unsigned)(uintptr_t)F.lds + MISC_OFF + 128u);
                if (wave0 == 0 && lane_id() == 0) *qslot = __hip_atomic_fetch_add((unsigned*)(ws + WS_CTL) + CW_EWQ, 1u, __ATOMIC_RELAXED, __HIP_MEMORY_SCOPE_AGENT);
                __syncthreads();
                const int cch = __builtin_amdgcn_readfirstlane((int)*qslot);
                __syncthreads();
                if (cch >= EW_CHUNKS) break;
                expert_weight_chunk(cch, INP(21), INP(22), INP(23), ws + WS_EGU, ws + WS_ED, (LAS float*)(F.lds + wave0 * 16384), wave0, lane_id());
                __syncthreads();
            }
        }
        GRID_BAR();
        asm volatile("; MARK_P3" ::: "memory");
        {
            PHASE_LOCALS();
            unsigned char* ws = WSP(); bf16_t* MIX = (bf16_t*)(ws + WS_MIX); bf16_t* Wout_t = (bf16_t*)(ws + WS_WOUT); bf16_t* MO = (bf16_t*)(ws + WS_PJ);
            pg8::Gemm g{MIX, Wout_t + (size_t)l * DM * DM, DM, 0};
            pg8::StaticOrder S; S.init(M, DM, G_, bid_);
            pg8::EpiBf16 E{MO, DM, 1.0f};
            pg8::gemm_phase<pg8::EpiBf16, pg8::StaticOrder, true>(F.lds, g, S, E, wave0);
        }
        GRID_BAR();
        asm volatile("; MARK_LN1" ::: "memory");
        {
            PHASE_LOCALS();
            unsigned char* ws = WSP(); float* X = OUTP(); const float* ln1_g = INP(15); const float* ln1_b = INP(16); const float* w_router = INP(20);
            bf16_t* XN = (bf16_t*)(ws + WS_XN); int* ltok = (int*)(ws + WS_LTOK); int* tpos = (int*)(ws + WS_TPOS); float* tgate = (float*)(ws + WS_TGATE); const bf16_t* MO = (const bf16_t*)(ws + WS_PJ);
            f32x4 g4[4], b4[4];
#pragma unroll
            for (int j = 0; j < 4; ++j) { g4[j] = *((const f32x4*)(ln1_g + l * DM) + lane + 64 * j); b4[j] = *((const f32x4*)(ln1_b + l * DM) + lane + 64 * j); }
            int me1 = -1, me2 = -1; float mg1 = 0.f, mg2 = 0.f;
            const int rows_per_wave = M / NGW;
            for (int ri = 0; ri < rows_per_wave; ++ri) { const int m = gw * rows_per_wave + ri; f32x4 v[4];
#pragma unroll
                for (int j = 0; j < 4; ++j) { const u32x2 xv = *((const u32x2*)(XN + (size_t)m * DM) + lane + 64 * j); const u32x2 mo = *((const u32x2*)(MO + (size_t)m * DM) + lane + 64 * j);
                    v[j][0] = ALPHA * bf_lo(xv.x) + bf_lo(mo.x); v[j][1] = ALPHA * bf_hi(xv.x) + bf_hi(mo.x); v[j][2] = ALPHA * bf_lo(xv.y) + bf_lo(mo.y); v[j][3] = ALPHA * bf_hi(xv.y) + bf_hi(mo.y); }
                ln_core(v, g4, b4);
                if (l == 0 && !DENSE_FP8) ln_store(v, nullptr, XN + (size_t)m * DM, lane);
                else { ln_store(v, nullptr, (bf16_t*)(X + (size_t)m * DM) + DM, lane);
#pragma unroll
                    for (int j = 0; j < 4; ++j) *((unsigned*)(ws + (DENSE_FP8 && l == 0 ? WS_XN : WS_XN8) + (size_t)m * DM) + lane + 64 * j) = pk4_fp8(v[j][0], v[j][1], v[j][2], v[j][3]); }
                if (l == 1) {
                    float lg[8];
#pragma unroll
                    for (int e = 0; e < 8; ++e) lg[e] = 0.f;
#pragma unroll
                    for (int j = 0; j < 4; ++j)
#pragma unroll
                        for (int q = 0; q < 4; ++q) { const int c = 4 * lane + 256 * j + q; const f32x4 wa = *(const f32x4*)(w_router + c * 8), wb = *(const f32x4*)(w_router + c * 8 + 4); const float xv = v[j][q];
                            lg[0] += xv * wa[0]; lg[1] += xv * wa[1]; lg[2] += xv * wa[2]; lg[3] += xv * wa[3]; lg[4] += xv * wb[0]; lg[5] += xv * wb[1]; lg[6] += xv * wb[2]; lg[7] += xv * wb[3]; }
#pragma unroll
                    for (int e = 0; e < 8; ++e) lg[e] = wave_sum(lg[e]);
                    int i1 = 0; float v1 = lg[0];
#pragma unroll
                    for (int e = 1; e < 8; ++e) if (lg[e] > v1) { v1 = lg[e]; i1 = e; }
                    int i2 = 0; float v2 = -INFINITY;
#pragma unroll
                    for (int e = 0; e < 8; ++e) if (e != i1 && lg[e] > v2) { v2 = lg[e]; i2 = e; }
                    const float ex = expf(v2 - v1), ga = 1.f / (1.f + ex), gb = ex / (1.f + ex);
                    if (lane == ri) { me1 = i1; me2 = i2; mg1 = ga; mg2 = gb; }
                }
            }
            if (l == 1) {
                const int myrow = gw * rows_per_wave + lane;
#pragma unroll
                for (int e = 0; e < 8; ++e) {
                    const bool has = (lane < rows_per_wave) && (me1 == e || me2 == e);
                    const unsigned long long mask = __ballot(has);
                    const int n = __popcll(mask);
                    if (n) {
                        int base = 0;
                        if (lane == 0) base = (int)__hip_atomic_fetch_add((unsigned*)(ws + WS_CTL) + CW_CNT + 64 * e, (unsigned)n, __ATOMIC_RELAXED, __HIP_MEMORY_SCOPE_AGENT);
                        base = __builtin_amdgcn_readfirstlane(base);
                        if (has) { const int p = base + (int)__builtin_amdgcn_mbcnt_hi((unsigned)(mask >> 32), __builtin_amdgcn_mbcnt_lo((unsigned)mask, 0u)); const int k = (me1 == e) ? 0 : 1;
                            ltok[e * M + p] = myrow; tpos[myrow * 2 + k] = (e << 20) | p; tgate[myrow * 2 + k] = k == 0 ? mg1 : mg2; }
                    }
                }
            }
        }
        GRID_BAR();
        if (l == 0) {
        asm volatile("; MARK_DENSE" ::: "memory");
            for (int dup = 0; dup < DUP_GU; ++dup) {
                PHASE_LOCALS();
                unsigned char* ws = WSP(); bf16_t* XN = (bf16_t*)(ws + WS_XN); bf16_t* Wgu_t = (bf16_t*)(ws + WS_WGU); bf16_t* Hd = (bf16_t*)(ws + WS_H);
                pg8::Gemm g{XN, Wgu_t, DM, 0};
                pg8::StaticOrder S; S.init(M, 2 * D_FF, G_, bid_);
#if DENSE_FP8
                pg8::EpiSwiGLU<true> E{Hd, D_FF, 0};
                pg8::gemm_phase<pg8::EpiSwiGLU<true>, pg8::StaticOrder, true, false, 1>(F.lds, g, S, E, wave0);
#else
                pg8::EpiSwiGLU<false> E{Hd, D_FF, 0};
                pg8::gemm_phase<pg8::EpiSwiGLU<false>, pg8::StaticOrder, true>(F.lds, g, S, E, wave0);
#endif
            }
            GRID_BAR();
            {
                PHASE_LOCALS();
                unsigned char* ws = WSP(); bf16_t* Wd_t = (bf16_t*)(ws + WS_WD); bf16_t* Hd = (bf16_t*)(ws + WS_H); bf16_t* MO = (bf16_t*)(ws + WS_FO);
                pg8::Gemm g{Hd, Wd_t, D_FF, 0};
                pg8::StaticOrder S; S.init(M, DM, G_, bid_);
#if DENSE_FP8
                pg8::EpiBf16 E{MO, DM, 1.0f / ED_SCALE};
                pg8::gemm_phase<pg8::EpiBf16, pg8::StaticOrder, true, false, 1>(F.lds, g, S, E, wave0);
#else
                pg8::EpiBf16 E{MO, DM, 1.0f};
                pg8::gemm_phase<pg8::EpiBf16, pg8::StaticOrder, true>(F.lds, g, S, E, wave0);
#endif
            }
            GRID_BAR();
        asm volatile("; MARK_LN2" ::: "memory");
            {
                PHASE_LOCALS();
                unsigned char* ws = WSP(); const float* ln2_g = INP(24); const float* ln2_b = INP(25); bf16_t* XN = (bf16_t*)(ws + WS_XN); const bf16_t* MO = (const bf16_t*)(ws + WS_FO);
                f32x4 g4[4], b4[4];
#pragma unroll
                for (int j = 0; j < 4; ++j) { g4[j] = *((const f32x4*)(ln2_g + l * DM) + lane + 64 * j); b4[j] = *((const f32x4*)(ln2_b + l * DM) + lane + 64 * j); }
                for (int m = gw; m < M; m += NGW) { f32x4 v[4];
#pragma unroll
                    for (int j = 0; j < 4; ++j) { const u32x2 xv = *((const u32x2*)(XN + (size_t)m * DM) + lane + 64 * j); const u32x2 mo = *((const u32x2*)(MO + (size_t)m * DM) + lane + 64 * j);
                        v[j][0] = ALPHA * bf_lo(xv.x) + bf_lo(mo.x); v[j][1] = ALPHA * bf_hi(xv.x) + bf_hi(mo.x); v[j][2] = ALPHA * bf_lo(xv.y) + bf_lo(mo.y); v[j][3] = ALPHA * bf_hi(xv.y) + bf_hi(mo.y); }
                    ln_core(v, g4, b4); ln_store(v, nullptr, XN + (size_t)m * DM, lane); }
            }
            GRID_BAR();
        } else {
        asm volatile("; MARK_MOE" ::: "memory");
            volatile LAS int* T = (volatile LAS int*)(F.MISC + 64);
            if (wave0 == 0 && lane_id() == 0) { int acc = 0; unsigned* ctlw = (unsigned*)(WSP() + WS_CTL);
                for (int e = 0; e < 8; ++e) { const int c = (int)__hip_atomic_load(ctlw + CW_CNT + 64 * e, __ATOMIC_RELAXED, __HIP_MEMORY_SCOPE_AGENT); T[e] = acc; T[16 + e] = c; acc += (c + 255) >> 8; }
                T[8] = acc; }
            __syncthreads();
            MoeTable tab{T};
            const int total_tiles = __builtin_amdgcn_readfirstlane(T[8]);
            for (int dup = 0; dup < DUP_MOE; ++dup)
            for (int rt_lo = 0; rt_lo < total_tiles; rt_lo += CHUNK_TILES) {
                const int nrt = (total_tiles - rt_lo) < CHUNK_TILES ? (total_tiles - rt_lo) : CHUNK_TILES;
                {
                    PHASE_LOCALS();
                    unsigned char* ws = WSP(); unsigned char* XN8 = ws + WS_XN8; unsigned char* Egu8 = ws + WS_EGU; unsigned char* HC = ws + WS_HC; const int* ltok = (const int*)(ws + WS_LTOK);
                    pg8::Gemm g{XN8, Egu8, DM, (size_t)2 * D_FFE * DM};
                    MoeOrder S{tab, rt_lo, nrt, 2 * D_FFE / 256, G_, bid_, ltok, true};
                    pg8::EpiSwiGLU<true> E{HC, D_FFE, rt_lo};
                    pg8::gemm_phase<pg8::EpiSwiGLU<true>, MoeOrder, true, true, 1>(F.lds, g, S, E, wave0);
                }
                GRID_BAR();
                {
                    PHASE_LOCALS();
                    unsigned char* ws = WSP(); unsigned char* Ed8 = ws + WS_ED; unsigned char* HC = ws + WS_HC; bf16_t* Y = (bf16_t*)(ws + WS_Y); const int* ltok = (const int*)(ws + WS_LTOK);
                    pg8::Gemm g{HC, Ed8, D_FFE, (size_t)DM * D_FFE};
                    MoeOrder S{tab, rt_lo, nrt, DM / 256, G_, bid_, ltok, false};
                    pg8::EpiBf16 E{Y, DM, 1.0f / ED_SCALE};
                    pg8::gemm_phase<pg8::EpiBf16, MoeOrder, true, false, 1>(F.lds, g, S, E, wave0);
                }
                GRID_BAR();
            }
        asm volatile("; MARK_COMB" ::: "memory");
            {
                PHASE_LOCALS();
                unsigned char* ws = WSP(); float* X = OUTP(); const float* ln2_g = INP(24); const float* ln2_b = INP(25);
                const bf16_t* Y = (const bf16_t*)(ws + WS_Y); const int* tpos = (const int*)(ws + WS_TPOS); const float* tgate = (const float*)(ws + WS_TGATE);
                f32x4 g4[4], b4[4];
#pragma unroll
                for (int j = 0; j < 4; ++j) { g4[j] = *((const f32x4*)(ln2_g + l * DM) + lane + 64 * j); b4[j] = *((const f32x4*)(ln2_b + l * DM) + lane + 64 * j); }
                for (int m = gw; m < M; m += NGW) {
                    const int pa = tpos[m * 2], pb = tpos[m * 2 + 1]; const float ga = tgate[m * 2], gb = tgate[m * 2 + 1];
                    const size_t ra = (size_t)T[pa >> 20] * 256 + (pa & 0xfffff), rb = (size_t)T[pb >> 20] * 256 + (pb & 0xfffff);
                    f32x4 v[4];
#pragma unroll
                    for (int j = 0; j < 4; ++j) { const u32x2 ya = *((const u32x2*)(Y + ra * DM) + lane + 64 * j), yb = *((const u32x2*)(Y + rb * DM) + lane + 64 * j);
                        const u32x2 xv = *((const u32x2*)((const bf16_t*)(X + (size_t)m * DM) + DM) + lane + 64 * j);
                        v[j][0] = ALPHA * bf_lo(xv.x) + ga * bf_lo(ya.x) + gb * bf_lo(yb.x); v[j][1] = ALPHA * bf_hi(xv.x) + ga * bf_hi(ya.x) + gb * bf_hi(yb.x);
                        v[j][2] = ALPHA * bf_lo(xv.y) + ga * bf_lo(ya.y) + gb * bf_lo(yb.y); v[j][3] = ALPHA * bf_hi(xv.y) + ga * bf_hi(ya.y) + gb * bf_hi(yb.y); }
                    ln_core(v, g4, b4); ln_store(v, X + (size_t)m * DM, nullptr, lane); }
            }
        }
    }
}

extern "C" void kernel_launch(void* const* d_in, const int* in_sizes, int n_in, void* d_out, int out_size, void* d_ws, size_t ws_size, hipStream_t stream) {
    static int grid = 0;
    if (grid == 0) {
        if (n_in != 26 || in_sizes[0] != M * DM || out_size != M * DM || ws_size < WS_END) { fprintf(stderr, "kernel_launch: unexpected shapes (n_in %d, ws %zu < %zu)\n", n_in, ws_size, (size_t)WS_END); grid = -1; return; }
        int dev = 0, cus = 0, per_cu = 0;
        if (hipGetDevice(&dev) != hipSuccess || hipDeviceGetAttribute(&cus, hipDeviceAttributeMultiprocessorCount, dev) != hipSuccess) { grid = -1; return; }
        if (hipFuncSetAttribute((const void*)mega_fwd, hipFuncAttributeMaxDynamicSharedMemorySize, LDS_BYTES) != hipSuccess) { fprintf(stderr, "kernel_launch: hipFuncSetAttribute failed\n"); grid = -1; return; }
        if (hipOccupancyMaxActiveBlocksPerMultiprocessor(&per_cu, (const void*)mega_fwd, NWAVES * 64, LDS_BYTES) != hipSuccess || per_cu < 1) { fprintf(stderr, "kernel_launch: occupancy query says %d\n", per_cu); }
        (void)hipGetLastError();
        grid = cus;
    }
    if (grid < 0) return;
    if (hipMemsetAsync((char*)d_ws + WS_CTL, 0, CTL_ZERO_BYTES, stream) != hipSuccess) return;
    Args a{};
    for (int i = 0; i < 26; ++i) a.in[i] = (const float*)d_in[i];
    a.out = (float*)d_out; a.ws = (unsigned char*)d_ws;
    hipLaunchKernelGGL(mega_fwd, dim3(grid), dim3(NWAVES * 64), LDS_BYTES, stream, a);
}
```
